# Optimizing an MI355X kernel written in HIP

```python
import math
import jax, jax.numpy as jnp
from jax import lax
import numpy as np

D_MODEL = 2048
BATCH = 2
SEQ = 4096
DEPTH = 2

CTX_LEN = 256
GRID_W = 64
W_CONV = 1024
CONV_K = 3
SSM_H = 16
SSM_P = 64
W_SSM = 1024
SSM_G = W_SSM // SSM_H
W_FFT = 1024
FFT_GROUPS = 4
FFT_GW = W_FFT // FFT_GROUPS
N_BRANCH = 3
RMS_EPS = 1e-6
U_OFF = 4 * W_CONV
IN_WIDTH = 4 * W_CONV + 2 * W_SSM + 2 * W_FFT + N_BRANCH * D_MODEL

kernel_name = "hybrid_conv_s5_fnet_parallel_dit_block"


def _split_proj(p):
    idx = [W_CONV, 2 * W_CONV, 3 * W_CONV, 4 * W_CONV,
           4 * W_CONV + W_SSM, 4 * W_CONV + 2 * W_SSM,
           4 * W_CONV + 2 * W_SSM + W_FFT, 4 * W_CONV + 2 * W_SSM + 2 * W_FFT]
    return jnp.split(p, idx, axis=-1)


def _rmsnorm(x, g):
    x32 = x.astype(jnp.float32)
    y = x32 * lax.rsqrt(jnp.mean(x32 * x32, axis=-1, keepdims=True) + RMS_EPS)
    return (y * g.astype(jnp.float32)).astype(x.dtype)


def _short_conv(v, w):
    ch = v.shape[-1]
    return lax.conv_general_dilated(
        v, w[:, None, :].astype(v.dtype), window_strides=(1,), padding=((1, 1),),
        dimension_numbers=('NWC', 'WIO', 'NWC'), feature_group_count=ch)


def _conv_branch(xa, ba, ca, za, w, on_grid):
    v = ca * xa
    if on_grid:
        bn, t, ch = v.shape
        rows = t // GRID_W
        y = _short_conv(v.reshape(bn * rows, GRID_W, ch), w).reshape(bn, t, ch)
    else:
        y = _short_conv(v, w)
    return ba * y * jax.nn.silu(za)


def _fourier_mix(f):
    bn, t, _ = f.shape
    fg = f.astype(jnp.float32).reshape(bn, t, FFT_GROUPS, FFT_GW)
    y = jnp.fft.fft2(fg, axes=(1, 3), norm='ortho').real
    return y.reshape(bn, t, W_FFT).astype(f.dtype)


def _zoh(lam_re, lam_im, log_dt, b_re, b_im):
    lam_re = lam_re.astype(jnp.float32)
    lam_im = lam_im.astype(jnp.float32)
    b_re = b_re.astype(jnp.float32)
    b_im = b_im.astype(jnp.float32)
    dt = jnp.exp(log_dt.astype(jnp.float32))[:, None]
    mag = jnp.exp(lam_re * dt)
    ang = lam_im * dt
    a_re = mag * jnp.cos(ang)
    a_im = mag * jnp.sin(ang)
    n_re = a_re - 1.0
    n_im = a_im
    den = lam_re * lam_re + lam_im * lam_im
    q_re = (n_re * lam_re + n_im * lam_im) / den
    q_im = (n_im * lam_re - n_re * lam_im) / den
    bb_re = q_re[..., None] * b_re - q_im[..., None] * b_im
    bb_im = q_re[..., None] * b_im + q_im[..., None] * b_re
    return a_re, a_im, bb_re, bb_im


def _combine(e1, e2):
    a1r, a1i, b1r, b1i = e1
    a2r, a2i, b2r, b2i = e2
    return (a2r * a1r - a2i * a1i,
            a2r * a1i + a2i * a1r,
            a2r * b1r - a2i * b1i + b2r,
            a2r * b1i + a2i * b1r + b2i)


def _scan_states(u_g, a_re, a_im, bb_re, bb_im, h0, reverse):
    s_re = jnp.einsum('btgh,gph->btgp', u_g, bb_re)
    s_im = jnp.einsum('btgh,gph->btgp', u_g, bb_im)
    if h0 is not None:
        h_re, h_im = h0
        edge = -1 if reverse else 0
        s_re = s_re.at[:, edge].add(a_re * h_re - a_im * h_im)
        s_im = s_im.at[:, edge].add(a_re * h_im + a_im * h_re)
    t = u_g.shape[1]
    ar = jnp.broadcast_to(a_re, (1, t) + a_re.shape)
    ai = jnp.broadcast_to(a_im, (1, t) + a_im.shape)
    _, _, x_re, x_im = lax.associative_scan(_combine, (ar, ai, s_re, s_im), reverse=reverse, axis=1)
    return x_re, x_im


def _readout(x_re, x_im, c_re, c_im):
    y = (jnp.einsum('btgp,ghp->btgh', x_re, c_re.astype(jnp.float32))
         - jnp.einsum('btgp,ghp->btgh', x_im, c_im.astype(jnp.float32)))
    return y.reshape(y.shape[0], y.shape[1], W_SSM)


def _branches_out(s, parts, y_ssm, on_grid, gate, conv_w, ssm_d, glu_wa, glu_wb,
                  fourier_w, proj_a, proj_b, proj_c, w_out, g_post):
    xa, ba, ca, za, u, zb, f, zc, gl = parts
    ya = _conv_branch(xa, ba, ca, za, conv_w, on_grid) @ proj_a
    y = y_ssm.astype(u.dtype) + ssm_d * u
    y = jax.nn.gelu(y)
    y = (y @ glu_wa) * jax.nn.sigmoid(y @ glu_wb) * jax.nn.silu(zb)
    yb = y @ proj_b
    yc = ((_fourier_mix(f) @ fourier_w) * jax.nn.silu(zc)) @ proj_c
    g = jax.nn.sigmoid(gl).reshape(gl.shape[:-1] + (N_BRANCH, D_MODEL))
    m = g[..., 0, :] * ya + g[..., 1, :] * yb + g[..., 2, :] * yc
    o = m @ w_out
    return s + gate * _rmsnorm(o, g_post)


def setup_inputs(seed: int = 0) -> dict:
    key = jax.random.key(seed)
    ks = jax.random.split(key, 26)
    f32 = jnp.float32
    nrm = lambda k, shape, std: jax.random.normal(k, shape, f32) * std
    inp = {}
    inp['x'] = nrm(ks[0], (BATCH, SEQ, D_MODEL), 1.0)
    inp['c'] = nrm(ks[1], (BATCH, D_MODEL), 1.0)
    inp['ctx'] = nrm(ks[2], (BATCH, CTX_LEN, D_MODEL), 1.0)
    inp['c_ctx'] = nrm(ks[3], (D_MODEL,), 1.0)
    inp['w_ada'] = nrm(ks[4], (DEPTH, D_MODEL, 3 * D_MODEL), 0.5 * D_MODEL ** -0.5)
    inp['b_ada'] = nrm(ks[5], (DEPTH, 3 * D_MODEL), 0.01)
    inp['g_pre'] = 1.0 + nrm(ks[6], (DEPTH, D_MODEL), 0.02)
    inp['g_post'] = 1.0 + nrm(ks[7], (DEPTH, D_MODEL), 0.02)
    inp['w_in'] = nrm(ks[8], (DEPTH, D_MODEL, IN_WIDTH), D_MODEL ** -0.5)
    inp['conv_w'] = nrm(ks[9], (DEPTH, CONV_K, W_CONV), CONV_K ** -0.5)
    inp['ssm_lam_re'] = -0.5 + nrm(ks[10], (DEPTH, 2, SSM_G, SSM_P), 0.01)
    inp['ssm_lam_im'] = (math.pi * jnp.arange(SSM_P, dtype=f32)
                         + nrm(ks[11], (DEPTH, 2, SSM_G, SSM_P), 0.01))
    inp['ssm_log_dt'] = jax.random.uniform(ks[12], (DEPTH, 2, SSM_G), f32,
                                           minval=math.log(1e-3), maxval=math.log(1e-1))
    inp['ssm_b_re'] = nrm(ks[13], (DEPTH, 2, SSM_G, SSM_P, SSM_H), (2 * SSM_H) ** -0.5)
    inp['ssm_b_im'] = nrm(ks[14], (DEPTH, 2, SSM_G, SSM_P, SSM_H), (2 * SSM_H) ** -0.5)
    inp['ssm_c_re'] = nrm(ks[15], (DEPTH, 2, SSM_G, SSM_H, SSM_P), SSM_P ** -0.5)
    inp['ssm_c_im'] = nrm(ks[16], (DEPTH, 2, SSM_G, SSM_H, SSM_P), SSM_P ** -0.5)
    inp['ssm_d'] = nrm(ks[17], (DEPTH, W_SSM), 1.0)
    inp['glu_wa'] = nrm(ks[18], (DEPTH, W_SSM, W_SSM), W_SSM ** -0.5)
    inp['glu_wb'] = nrm(ks[19], (DEPTH, W_SSM, W_SSM), W_SSM ** -0.5)
    inp['fourier_w'] = nrm(ks[20], (DEPTH, W_FFT, W_FFT), W_FFT ** -0.5)
    inp['proj_a'] = nrm(ks[21], (DEPTH, W_CONV, D_MODEL), W_CONV ** -0.5)
    inp['proj_b'] = nrm(ks[22], (DEPTH, W_SSM, D_MODEL), W_SSM ** -0.5)
    inp['proj_c'] = nrm(ks[23], (DEPTH, W_FFT, D_MODEL), W_FFT ** -0.5)
    inp['w_out'] = nrm(ks[24], (DEPTH, D_MODEL, D_MODEL), D_MODEL ** -0.5)
    return inp


def reference(x, c, ctx, c_ctx, w_ada, b_ada, g_pre, g_post, w_in, conv_w,
              ssm_lam_re, ssm_lam_im, ssm_log_dt, ssm_b_re, ssm_b_im, ssm_c_re, ssm_c_im,
              ssm_d, glu_wa, glu_wb, fourier_w, proj_a, proj_b, proj_c, w_out):
    bn, t, _ = x.shape
    lc = ctx.shape[1]
    for l in range(DEPTH):
        last = l == DEPTH - 1
        mod_x = jax.nn.silu(c) @ w_ada[l] + b_ada[l]
        sh_x, sc_x, gt_x = jnp.split(mod_x[:, None, :], 3, axis=-1)
        mod_c = jax.nn.silu(c_ctx) @ w_ada[l] + b_ada[l]
        sh_c, sc_c, gt_c = jnp.split(mod_c, 3)
        h_x = _rmsnorm(x, g_pre[l]) * (1 + sc_x) + sh_x
        h_c = _rmsnorm(ctx, g_pre[l]) * (1 + sc_c) + sh_c
        parts_x = _split_proj(h_x @ w_in[l])
        if last:
            parts_c = None
            u_c = h_c @ w_in[l][:, U_OFF:U_OFF + W_SSM]
        else:
            parts_c = _split_proj(h_c @ w_in[l])
            u_c = parts_c[4]
        u_c_g = u_c.astype(jnp.float32).reshape(bn, lc, SSM_G, SSM_H)
        u_x_g = parts_x[4].astype(jnp.float32).reshape(bn, t, SSM_G, SSM_H)
        ys_x = []
        ys_c = []
        for d in range(2):
            rev = d == 1
            disc = _zoh(ssm_lam_re[l, d], ssm_lam_im[l, d], ssm_log_dt[l, d],
                        ssm_b_re[l, d], ssm_b_im[l, d])
            cr, ci = _scan_states(u_c_g, *disc, None, rev)
            edge = 0 if rev else -1
            h0 = (cr[:, edge], ci[:, edge])
            xr, xi = _scan_states(u_x_g, *disc, h0, rev)
            ys_x.append(_readout(xr, xi, ssm_c_re[l, d], ssm_c_im[l, d]))
            if not last:
                ys_c.append(_readout(cr, ci, ssm_c_re[l, d], ssm_c_im[l, d]))
        new_x = _branches_out(x, parts_x, ys_x[0] + ys_x[1], True, gt_x, conv_w[l], ssm_d[l],
                              glu_wa[l], glu_wb[l], fourier_w[l], proj_a[l], proj_b[l],
                              proj_c[l], w_out[l], g_post[l])
        if not last:
            ctx = _branches_out(ctx, parts_c, ys_c[0] + ys_c[1], False, gt_c, conv_w[l], ssm_d[l],
                                glu_wa[l], glu_wb[l], fourier_w[l], proj_a[l], proj_b[l],
                                proj_c[l], w_out[l], g_post[l])
        x = new_x
    return x
```

```cpp
#include <hip/hip_runtime.h>
#include <hip/hip_cooperative_groups.h>
#include <cstdio>
namespace cg = cooperative_groups;

#define LAS __attribute__((address_space(3)))
typedef unsigned short bf16_t;
typedef short bf16x8 __attribute__((ext_vector_type(8)));
typedef float f32x4 __attribute__((ext_vector_type(4)));
typedef unsigned u32x4 __attribute__((ext_vector_type(4)));
typedef unsigned u32x2 __attribute__((ext_vector_type(2)));

constexpr int DM = 2048, NB = 2, SEQ = 4096, LCX = 256, MX = NB * SEQ, MCT = NB * LCX, MTOT = MX + MCT;
constexpr int INW = 14336;
constexpr int C_XA = 0, C_BA = 1024, C_CA = 2048, C_ZA = 3072, C_U = 4096, C_ZB = 5120, C_F = 6144, C_ZC = 7168, C_GL = 8192;
constexpr size_t E_PC = 0, E_PU = (size_t)8704 * 4096, E_PZB = E_PU + (size_t)8704 * 1024, E_PF = E_PZB + (size_t)8704 * 1024, E_PZC = E_PF + (size_t)8704 * 1024, E_PGL = E_PZC + (size_t)8704 * 1024;
constexpr int NCOL = 544;
constexpr float RMS_EPS = 1e-6f;

constexpr size_t AL(size_t x) { return (x + 255) & ~(size_t)255; }
constexpr size_t SZ_WIN = (size_t)INW * DM * 2, SZ_P = (size_t)DM * 1024 * 2, SZ_GLU = (size_t)2048 * 1024 * 2, SZ_FW = (size_t)1024 * 1024 * 2,
                 SZ_WP = (size_t)1024 * 2048 * 2, SZ_WO = (size_t)DM * DM * 2, SZ_M1 = (size_t)64 * 256 * 256 * 2, SZ_M2 = (size_t)64 * 256 * 512 * 2,
                 SZ_A16 = (size_t)2 * 64 * 64 * 2 * 4, SZ_MOD = (size_t)3 * 6144 * 4;
constexpr size_t LO_WIN = 0, LO_PA = LO_WIN + SZ_WIN, LO_PB = LO_PA + SZ_P, LO_PC = LO_PB + SZ_P, LO_GLU = LO_PC + SZ_P, LO_FW = LO_GLU + SZ_GLU,
                 LO_WP = LO_FW + SZ_FW, LO_WO = LO_WP + SZ_WP, LO_M1 = LO_WO + SZ_WO, LO_M2 = LO_M1 + SZ_M1, LO_A16 = LO_M2 + SZ_M2, LO_MOD = LO_A16 + SZ_A16,
                 SZ_LAYER = AL(LO_MOD + SZ_MOD);
constexpr size_t O_TAB = 2 * SZ_LAYER;
constexpr size_t T_CS = 0, T_D1 = T_CS + 512 * 256 * 2, T_D2 = T_D1 + 128 * 64 * 2, T_DCTX = T_D2 + 128 * 128 * 2, T_TW = T_DCTX + 512 * 256 * 2, SZ_TAB = AL(T_TW + 64 * 64 * 8);
constexpr size_t O_X1 = O_TAB + SZ_TAB, SZ_X1 = (size_t)MTOT * DM * 4;
constexpr size_t O_HB = O_X1 + SZ_X1, SZ_HB = (size_t)MTOT * DM * 2;
constexpr size_t O_PARTS = O_HB + SZ_HB, SZ_PARTS = (size_t)MTOT * INW * 2;
constexpr size_t O_AB = O_PARTS + SZ_PARTS, SZ_BR = (size_t)MTOT * 1024 * 2;
constexpr size_t O_BB = O_AB + SZ_BR, O_CB = O_BB + SZ_BR, O_GB = O_CB + SZ_BR;
constexpr size_t O_ZB = O_GB + SZ_BR, SZ_ZB = (size_t)2 * 64 * 128 * 1024 * 2;
constexpr size_t O_YB = O_ZB + SZ_ZB, SZ_YB = (size_t)MTOT * 2048 * 2;
constexpr size_t O_EB = O_YB + SZ_YB, SZ_EB = (size_t)64 * NCOL * 256 * 4;
constexpr size_t O_HS = O_EB + SZ_EB, SZ_HS = (size_t)64 * NCOL * 256 * 2;
constexpr size_t O_MP = O_ZB;
constexpr size_t O_BAR = O_HS + SZ_HS, SZ_BAR = 16384;
constexpr size_t WS_END = O_BAR + SZ_BAR;
static_assert(SZ_ZB + SZ_YB + SZ_EB >= (size_t)MTOT * DM * 4, "alias");
static_assert(SZ_PARTS >= (size_t)MTOT * DM * 4, "alias");

struct Params {
    const float *x, *c, *ctx, *c_ctx, *w_ada, *b_ada, *g_pre, *g_post, *w_in, *conv_w, *lam_re, *lam_im, *log_dt, *b_re, *b_im, *c_re, *c_im,
        *ssm_d, *glu_wa, *glu_wb, *fourier_w, *proj_a, *proj_b, *proj_c, *w_out;
    float* out; unsigned char* ws;
};
typedef const __attribute__((address_space(4))) Params* KPtr;
#define PREF const __attribute__((address_space(4))) Params&

__device__ __forceinline__ int tid_opaque() { int t = threadIdx.x; asm volatile("" : "+v"(t)); return t; }
__device__ __forceinline__ int bid_opaque() { int b = blockIdx.x; asm volatile("" : "+s"(b)); return b; }
__device__ __forceinline__ float bf2f(unsigned v) { return __uint_as_float(v << 16); }
__device__ __forceinline__ unsigned cvt_pk_bf16(float lo, float hi) { unsigned r; asm volatile("v_cvt_pk_bf16_f32 %0, %1, %2" : "=v"(r) : "v"(lo), "v"(hi)); return r; }
__device__ __forceinline__ float lo_f(unsigned u) { return __uint_as_float(u << 16); }
__device__ __forceinline__ float hi_f(unsigned u) { return __uint_as_float(u & 0xffff0000u); }
__device__ __forceinline__ float sigmoidf_(float x) { return 1.0f / (1.0f + __expf(-x)); }
__device__ __forceinline__ float siluf_(float x) { return x / (1.0f + __expf(-x)); }
__device__ __forceinline__ float gelu_tanh(float x) { const float z = 0.7978845608028654f * (x + 0.044715f * x * x * x); const float t = 1.0f - 2.0f / (__expf(2.0f * z) + 1.0f); return 0.5f * x * (1.0f + t); }
__device__ __forceinline__ float wave_sum(float v, const int lane) {
#pragma unroll
    for (int o = 32; o; o >>= 1) v += __int_as_float(__builtin_amdgcn_ds_bpermute((lane ^ o) << 2, __float_as_int(v)));
    return v;
}
__device__ __forceinline__ void unpack8(const u32x4 u, float (&f)[8]) {
    f[0] = lo_f(u[0]); f[1] = hi_f(u[0]); f[2] = lo_f(u[1]); f[3] = hi_f(u[1]); f[4] = lo_f(u[2]); f[5] = hi_f(u[2]); f[6] = lo_f(u[3]); f[7] = hi_f(u[3]);
}
__device__ __forceinline__ u32x4 pack8(const float (&f)[8]) { u32x4 r; r[0] = cvt_pk_bf16(f[0], f[1]); r[1] = cvt_pk_bf16(f[2], f[3]); r[2] = cvt_pk_bf16(f[4], f[5]); r[3] = cvt_pk_bf16(f[6], f[7]); return r; }

constexpr int BM = 256, BK = 64, HALF = 128, HTB = HALF * BK * 2, STAGE_BYTES = 8 * HTB;
__device__ __forceinline__ int lds_byte(int r, int c) { const int st = (r >> 4) * 2 + (c >> 5), rr = r & 15, cc = c & 31, ob = rr * 64 + cc * 2; return st * 1024 + (ob ^ (((ob >> 9) & 1) << 5)); }
__device__ __forceinline__ void stage_rc(int b, int& R, int& C) { const int st = b / 1024, sb = b % 1024, swz = sb ^ (((sb >> 9) & 1) << 5); R = (st >> 1) * 16 + swz / 64; C = (st & 1) * 32 + (swz % 64) / 2; }
__device__ __forceinline__ int perm32(int rho) { const int n = rho >> 4, i = rho & 15; return 8 * (i >> 2) + 4 * n + (i & 3); }

struct Unit { const char* A; const char* B; int row0, pn, z, half; };

__device__ __forceinline__ void tile_of(int L, int nM, int nN, int& pm, int& pn) {
    const int nwg = nM * nN; int wgid = L;
    { const int q = nwg / 8, r = nwg % 8, xcd = wgid % 8, off = wgid / 8; wgid = (xcd < r ? xcd * (q + 1) : r * (q + 1) + (xcd - r) * q) + off; }
    const int nig = 8 * nN, gid = wgid / nig, fm = gid * 8, gsz = (nM - fm) < 8 ? (nM - fm) : 8;
    pm = fm + ((wgid % nig) % gsz); pn = (wgid % nig) / gsz;
}

template <class Sched, class Epi>
__device__ __forceinline__ void gemm_phase(LAS unsigned char* lds, const Sched& S, const Epi& E, const int K, const int lda, const int ldb) {
    const int tid = tid_opaque(), wid = __builtin_amdgcn_readfirstlane(tid >> 6), lane = tid & 63, wr = wid >> 2, wc = wid & 3, fr = lane & 15, fq = lane >> 4;
    const int nt = K / BK;
    unsigned voffA[2], voffB[2];
#pragma unroll
    for (int i = 0; i < 2; ++i) { int R, C; stage_rc(tid * 16 + i * 8192, R, C); const int Rb = (R & ~31) + perm32(R & 31);
        voffA[i] = (unsigned)(R * lda + C) * 2u; voffB[i] = (unsigned)(Rb * ldb + C) * 2u; }
    const size_t kstep = (size_t)(BK * 2);
    const size_t hstepA = (size_t)HALF * lda * 2, hstepB = (size_t)HALF * ldb * 2;
    const unsigned ldsw = (unsigned)wid * 1024u;
    const int aoff = lds_byte(wr * 64 + fr, fq * 8), boff = lds_byte(wc * 32 + fr, fq * 8);
#define PG8_SA(b, h) (((b) * 2 + (h)) * HTB)
#define PG8_SB(b, h) ((4 + (b) * 2 + (h)) * HTB)
#define PG8_STAGE(bufoff, gbase, voff) do { _Pragma("unroll") for (int _i = 0; _i < 2; ++_i) \
        __builtin_amdgcn_global_load_lds((const unsigned*)((const char*)(gbase) + (voff)[_i]), (LAS unsigned*)(lds + (bufoff) + ldsw + _i * 8192), 16, 0, 0); } while (0)
#define PG8_LDA(dst, b, h) do { _Pragma("unroll") for (int m = 0; m < 4; ++m) _Pragma("unroll") for (int k = 0; k < 2; ++k) dst[m][k] = *(const LAS bf16x8*)(lds + PG8_SA(b, h) + aoff + m * 2048 + k * 1024); } while (0)
#define PG8_LDB(dst, b, h) do { _Pragma("unroll") for (int n = 0; n < 2; ++n) _Pragma("unroll") for (int k = 0; k < 2; ++k) dst[n][k] = *(const LAS bf16x8*)(lds + PG8_SB(b, h) + boff + n * 2048 + k * 1024); } while (0)
#define PG8_MMA(ai, bj, At, Bt) do { __builtin_amdgcn_s_setprio(1); _Pragma("unroll") for (int m = 0; m < 4; ++m) _Pragma("unroll") for (int n = 0; n < 2; ++n) _Pragma("unroll") for (int k = 0; k < 2; ++k) \
        acc[ai][bj][m][n] = __builtin_amdgcn_mfma_f32_16x16x32_bf16(Bt[n][k], At[m][k], acc[ai][bj][m][n], 0, 0, 0); __builtin_amdgcn_s_setprio(0); } while (0)
#define PG8_WAIT_V(n) asm volatile("s_waitcnt vmcnt(" #n ")" ::: "memory")
#define PG8_WAIT_L(n) asm volatile("s_waitcnt lgkmcnt(" #n ")" ::: "memory")
#define PG8_BAR __builtin_amdgcn_s_barrier()
#define PG8_SCHED __builtin_amdgcn_sched_barrier(0)
    Unit cur, nxt; int ui = 0;
    if (!S.next(0, cur)) return;
    f32x4 acc[2][2][4][2];
#pragma unroll
    for (int a = 0; a < 2; ++a)
#pragma unroll
        for (int b = 0; b < 2; ++b)
#pragma unroll
            for (int m = 0; m < 4; ++m)
#pragma unroll
                for (int n = 0; n < 2; ++n) acc[a][b][m][n] = (f32x4){0.f, 0.f, 0.f, 0.f};
    bf16x8 At[4][2], B0[2][2], B1[2][2];
    const char* cA = cur.A; const char* cB = cur.B;
    PG8_STAGE(PG8_SB(0, 0), cB, voffB); PG8_STAGE(PG8_SA(0, 0), cA, voffA); PG8_STAGE(PG8_SB(0, 1), cB + hstepB, voffB); PG8_STAGE(PG8_SA(0, 1), cA + hstepA, voffA);
    if (wr == 1) PG8_BAR;
    PG8_WAIT_V(4); PG8_BAR;
    PG8_STAGE(PG8_SB(1, 0), cB + kstep, voffB); PG8_STAGE(PG8_SA(1, 0), cA + kstep, voffA); PG8_STAGE(PG8_SB(1, 1), cB + hstepB + kstep, voffB);
    PG8_WAIT_V(6); PG8_BAR;
    for (;;) {
        const bool has_next = S.next(ui + 1, nxt);
        const char* nA = has_next ? nxt.A : cA; const char* nB = has_next ? nxt.B : cB;
        const bool chalf = cur.half != 0;
        for (int t = 0; t < nt; t += 2) {
            const bool last = (t == nt - 2);
            const char* a1 = cA + (size_t)(t + 1) * kstep;
            const char* a2 = last ? nA : cA + (size_t)(t + 2) * kstep; const char* b2 = last ? nB : cB + (size_t)(t + 2) * kstep;
            const char* a3 = a2 + kstep; const char* b3 = b2 + kstep;
            PG8_LDB(B0, 0, 0); PG8_SCHED; PG8_LDA(At, 0, 0); PG8_STAGE(PG8_SA(1, 1), a1 + hstepA, voffA);
            PG8_WAIT_L(8); PG8_BAR; PG8_WAIT_L(0); PG8_MMA(0, 0, At, B0); PG8_BAR; PG8_SCHED;
            PG8_LDB(B1, 0, 1); PG8_STAGE(PG8_SB(0, 0), b2, voffB);
            PG8_BAR; PG8_WAIT_L(0); PG8_MMA(0, 1, At, B1); PG8_BAR;
            PG8_LDA(At, 0, 1); PG8_STAGE(PG8_SA(0, 0), a2, voffA);
            PG8_BAR; PG8_WAIT_L(0); if (!chalf) PG8_MMA(1, 0, At, B0); PG8_BAR; PG8_SCHED;
            PG8_STAGE(PG8_SB(0, 1), b2 + hstepB, voffB);
            PG8_WAIT_V(6); PG8_BAR; if (!chalf) PG8_MMA(1, 1, At, B1); PG8_BAR;
            PG8_LDB(B0, 1, 0); PG8_SCHED; PG8_LDA(At, 1, 0); PG8_STAGE(PG8_SA(0, 1), a2 + hstepA, voffA);
            PG8_WAIT_L(8); PG8_BAR; PG8_WAIT_L(0); PG8_MMA(0, 0, At, B0); PG8_BAR; PG8_SCHED;
            PG8_LDB(B1, 1, 1); PG8_STAGE(PG8_SB(1, 0), b3, voffB);
            PG8_BAR; PG8_WAIT_L(0); PG8_MMA(0, 1, At, B1); PG8_BAR;
            PG8_LDA(At, 1, 1); PG8_STAGE(PG8_SA(1, 0), a3, voffA);
            PG8_BAR; PG8_WAIT_L(0); if (!chalf) PG8_MMA(1, 0, At, B0); PG8_BAR; PG8_SCHED;
            PG8_STAGE(PG8_SB(1, 1), b3 + hstepB, voffB);
            PG8_WAIT_V(6); PG8_BAR; if (!chalf) PG8_MMA(1, 1, At, B1); PG8_BAR;
        }
        E(acc, cur, wr, wc, fr, fq);
        if (!has_next) break;
#pragma unroll
        for (int a = 0; a < 2; ++a)
#pragma unroll
            for (int b = 0; b < 2; ++b)
#pragma unroll
                for (int m = 0; m < 4; ++m)
#pragma unroll
                    for (int n = 0; n < 2; ++n) acc[a][b][m][n] = (f32x4){0.f, 0.f, 0.f, 0.f};
        cur = nxt; cA = nA; cB = nB; ++ui;
    }
    PG8_WAIT_V(0);
    if (wr == 0) PG8_BAR;
    PG8_BAR;
#undef PG8_SA
#undef PG8_SB
#undef PG8_STAGE
#undef PG8_LDA
#undef PG8_LDB
#undef PG8_MMA
#undef PG8_WAIT_V
#undef PG8_WAIT_L
#undef PG8_BAR
#undef PG8_SCHED
}

typedef f32x4 AccT[2][2][4][2];
#define EPI_ARGS const AccT& acc, const Unit& u, int wr, int wc, int fr, int fq
#define EPI_FOR_ROWS _Pragma("unroll") for (int ai = 0; ai < 2; ++ai) if (ai == 0 || !u.half) _Pragma("unroll") for (int m = 0; m < 4; ++m)
#define EPI_ROW (u.row0 + wr * 64 + fr + ai * 128 + m * 16)
#define EPI_COL(bj) (u.pn * 256 + wc * 32 + 8 * fq + (bj) * 128)

struct SchedGrid {
    const char* A; const char* B; int nM, nN, lda, ldb, G, c, nh, hrow0, cnt;
    __device__ __forceinline__ bool next(int i, Unit& u) const {
        const long L = (long)i * G + c; const int nfull = nM * nN; if (i >= cnt || L >= (long)nfull + nh * nN) return false;
        int pm;
        if (L < nfull) { tile_of((int)L, nM, nN, pm, u.pn); u.row0 = pm * 256; u.half = 0; }
        else { const int e = (int)L - nfull; u.pn = e % nN; u.row0 = hrow0 + (e / nN) * 128; u.half = 1; }
        u.z = 0; u.A = A + (size_t)u.row0 * lda * 2; u.B = B + (size_t)u.pn * 256 * ldb * 2; return true;
    }
};
struct SchedMerge {
    const char* A0; const char* B0; int nM, G, c, nh, hrow0;
    __device__ __forceinline__ bool next(int i, Unit& u) const {
        const int j = i / 3, br = i - 3 * j; const long L = (long)j * G + c; const int nfull = nM * 8; if (L >= (long)nfull + nh * 8) return false;
        int pm;
        if (L < nfull) { tile_of((int)L, nM, 8, pm, u.pn); u.row0 = pm * 256; u.half = 0; }
        else { const int e = (int)L - nfull; u.pn = e & 7; u.row0 = hrow0 + (e >> 3) * 128; u.half = 1; }
        u.z = br;
        u.A = A0 + (size_t)br * SZ_BR + (size_t)u.row0 * 1024 * 2; u.B = B0 + (size_t)br * SZ_P + (size_t)u.pn * 256 * 1024 * 2; return true;
    }
};
struct SchedWp {
    const unsigned char* ws; int G, c;
    __device__ __forceinline__ bool next(int i, Unit& u) const {
        const long L = (long)i * G + c; if (L >= 64) return false;
        const int l = (int)L >> 5, grp = ((int)L >> 3) & 3, pm = ((int)L >> 1) & 3; u.row0 = pm * 256; u.half = 0; u.pn = (int)L & 1; u.z = l * 4 + grp;
        u.A = (const char*)ws + l * SZ_LAYER + LO_FW + ((size_t)pm * 256 * 1024 + grp * 256) * 2;
        u.B = (const char*)ws + O_TAB + T_CS + (size_t)u.pn * 256 * 256 * 2; return true;
    }
};

struct EpiStoreBf16 { bf16_t* O; int ldc;
    __device__ __forceinline__ void operator()(EPI_ARGS) const {
        EPI_FOR_ROWS { bf16_t* rp = O + (size_t)EPI_ROW * ldc;
#pragma unroll
            for (int bj = 0; bj < 2; ++bj) { const f32x4 v0 = acc[ai][bj][m][0], v1 = acc[ai][bj][m][1]; u32x4 o;
                o[0] = cvt_pk_bf16(v0[0], v0[1]); o[1] = cvt_pk_bf16(v0[2], v0[3]); o[2] = cvt_pk_bf16(v1[0], v1[1]); o[3] = cvt_pk_bf16(v1[2], v1[3]);
                *(u32x4*)(rp + EPI_COL(bj)) = o; } }
    }
};
struct EpiParts { bf16_t* O;
    __device__ __forceinline__ void operator()(EPI_ARGS) const {
        const int c0 = u.pn * 256; size_t eb; int pitch, cl;
        if (c0 < C_U) { eb = E_PC; pitch = 4096; cl = c0; } else if (c0 < C_ZB) { eb = E_PU; pitch = 1024; cl = c0 - C_U; } else if (c0 < C_F) { eb = E_PZB; pitch = 1024; cl = c0 - C_ZB; }
        else if (c0 < C_ZC) { eb = E_PF; pitch = 1024; cl = c0 - C_F; } else if (c0 < C_GL) { eb = E_PZC; pitch = 1024; cl = c0 - C_ZC; } else { eb = E_PGL; pitch = 6144; cl = c0 - C_GL; }
        bf16_t* base = O + eb + cl + wc * 32 + 8 * fq;
        EPI_FOR_ROWS { bf16_t* rp = base + (size_t)EPI_ROW * pitch;
#pragma unroll
            for (int bj = 0; bj < 2; ++bj) { const f32x4 v0 = acc[ai][bj][m][0], v1 = acc[ai][bj][m][1]; u32x4 o;
                o[0] = cvt_pk_bf16(v0[0], v0[1]); o[1] = cvt_pk_bf16(v0[2], v0[3]); o[2] = cvt_pk_bf16(v1[0], v1[1]); o[3] = cvt_pk_bf16(v1[2], v1[3]);
                *(u32x4*)(rp + bj * 128) = o; } }
    }
};
struct EpiStoreF32 { float* O; int ldc;
    __device__ __forceinline__ void operator()(EPI_ARGS) const {
        EPI_FOR_ROWS { float* rp = O + (size_t)EPI_ROW * ldc;
#pragma unroll
            for (int bj = 0; bj < 2; ++bj) { *(f32x4*)(rp + EPI_COL(bj)) = acc[ai][bj][m][0]; *(f32x4*)(rp + EPI_COL(bj) + 4) = acc[ai][bj][m][1]; } }
    }
};
struct EpiWp { unsigned char* ws;
    __device__ __forceinline__ void operator()(EPI_ARGS) const {
        const int l = u.z >> 2, grp = u.z & 3; bf16_t* O = (bf16_t*)(ws + l * SZ_LAYER + LO_WP);
        EPI_FOR_ROWS { bf16_t* rp = O + (size_t)EPI_ROW * 2048 + u.pn * 1024 + grp * 256;
#pragma unroll
            for (int bj = 0; bj < 2; ++bj) { const f32x4 v0 = acc[ai][bj][m][0], v1 = acc[ai][bj][m][1]; u32x4 o;
                o[0] = cvt_pk_bf16(v0[0], v0[1]); o[1] = cvt_pk_bf16(v0[2], v0[3]); o[2] = cvt_pk_bf16(v1[0], v1[1]); o[3] = cvt_pk_bf16(v1[2], v1[3]);
                *(u32x4*)(rp + wc * 32 + 8 * fq + bj * 128) = o; } }
    }
};
struct EpiFourier { const bf16_t* parts; bf16_t* O;
    __device__ __forceinline__ void operator()(EPI_ARGS) const {
#pragma unroll
        for (int ai = 0; ai < 2; ++ai) if (ai == 0 || !u.half) { u32x4 zz[4][2];
#pragma unroll
            for (int m = 0; m < 4; ++m)
#pragma unroll
                for (int bj = 0; bj < 2; ++bj) zz[m][bj] = *(const u32x4*)(parts + E_PZC + (size_t)EPI_ROW * 1024 + EPI_COL(bj));
#pragma unroll
            for (int m = 0; m < 4; ++m)
#pragma unroll
                for (int bj = 0; bj < 2; ++bj) { const f32x4 v0 = acc[ai][bj][m][0], v1 = acc[ai][bj][m][1]; float z[8]; unpack8(zz[m][bj], z); float o[8];
#pragma unroll
                    for (int j = 0; j < 4; ++j) { o[j] = v0[j] * siluf_(z[j]); o[4 + j] = v1[j] * siluf_(z[4 + j]); }
                    *(u32x4*)(O + (size_t)EPI_ROW * 1024 + EPI_COL(bj)) = pack8(o); } }
    }
};
struct EpiGlu { const bf16_t* parts; bf16_t* O;
    __device__ __forceinline__ void operator()(EPI_ARGS) const {
        const int col = u.pn * 128 + wc * 32 + 8 * fq;
#pragma unroll
        for (int ai = 0; ai < 2; ++ai) if (ai == 0 || !u.half) { u32x4 zz[4];
#pragma unroll
            for (int m = 0; m < 4; ++m) zz[m] = *(const u32x4*)(parts + E_PZB + (size_t)EPI_ROW * 1024 + col);
#pragma unroll
            for (int m = 0; m < 4; ++m) { float z[8]; unpack8(zz[m], z);
                const f32x4 a0 = acc[ai][0][m][0], a1 = acc[ai][0][m][1], b0 = acc[ai][1][m][0], b1 = acc[ai][1][m][1]; float o[8];
#pragma unroll
                for (int j = 0; j < 4; ++j) { o[j] = a0[j] * sigmoidf_(b0[j]) * siluf_(z[j]); o[4 + j] = a1[j] * sigmoidf_(b1[j]) * siluf_(z[4 + j]); }
                *(u32x4*)(O + (size_t)EPI_ROW * 1024 + col) = pack8(o); } }
    }
};
struct EpiMerge { const bf16_t* parts; bf16_t* MB;
    __device__ __forceinline__ void operator()(EPI_ARGS) const {
        const int br = u.z; const int nb = u.half ? 2 : 4;
        u32x4 gg[2][4], pp[2][4];
#define MRG_LOAD(slot, bidx_) { const int ai = (bidx_) >> 1, bj = (bidx_) & 1; _Pragma("unroll") for (int m = 0; m < 4; ++m) { \
            gg[slot][m] = *(const u32x4*)(parts + E_PGL + (size_t)EPI_ROW * 6144 + br * DM + EPI_COL(bj)); \
            pp[slot][m] = br > 0 ? *(const u32x4*)(MB + (size_t)EPI_ROW * DM + EPI_COL(bj)) : (u32x4){0u, 0u, 0u, 0u}; } }
#define MRG_EMIT(slot, bidx_) { const int ai = (bidx_) >> 1, bj = (bidx_) & 1; _Pragma("unroll") for (int m = 0; m < 4; ++m) { \
            const f32x4 v0 = acc[ai][bj][m][0], v1 = acc[ai][bj][m][1]; float g[8], pv[8], o[8]; unpack8(gg[slot][m], g); unpack8(pp[slot][m], pv); \
            _Pragma("unroll") for (int j = 0; j < 4; ++j) { o[j] = v0[j] * sigmoidf_(g[j]) + pv[j]; o[4 + j] = v1[j] * sigmoidf_(g[4 + j]) + pv[4 + j]; } \
            *(u32x4*)(MB + (size_t)EPI_ROW * DM + EPI_COL(bj)) = pack8(o); } }
        MRG_LOAD(0, 0)
        MRG_LOAD(1, 1)
        MRG_EMIT(0, 0)
        if (nb > 2) MRG_LOAD(0, 2)
        MRG_EMIT(1, 1)
        if (nb > 2) { MRG_LOAD(1, 3) MRG_EMIT(0, 2) MRG_EMIT(1, 3) }
#undef MRG_LOAD
#undef MRG_EMIT
    }
};

template <int MTL, int NT, class BL>
__device__ __forceinline__ void lmul_core(const bf16_t* __restrict__ D, const int ldd, const int ksteps, const BL& bl, f32x4 (&acc)[MTL][NT], const int lane) {
    const int r = lane & 15, q = lane >> 4;
    const bf16_t* dp = D + (size_t)r * ldd + q * 8;
#pragma unroll
    for (int a = 0; a < MTL; ++a)
#pragma unroll
        for (int b = 0; b < NT; ++b) acc[a][b] = (f32x4){0.f, 0.f, 0.f, 0.f};
#pragma unroll 1
    for (int ks = 0; ks < ksteps; ++ks) {
        bf16x8 bf[NT];
#pragma unroll
        for (int b = 0; b < NT; ++b) bf[b] = bl(ks, b);
#pragma unroll
        for (int a = 0; a < MTL; ++a) { const bf16x8 af = *(const bf16x8*)(dp + (size_t)a * 16 * ldd + ks * 32);
#pragma unroll
            for (int b = 0; b < NT; ++b) acc[a][b] = __builtin_amdgcn_mfma_f32_16x16x32_bf16(af, bf[b], acc[a][b], 0, 0, 0); }
    }
}
template <int MTL>
__device__ __forceinline__ void lmul_g4(const bf16_t* __restrict__ D, const int ldd, const int ksteps, const bf16_t* __restrict__ base, const size_t rs, f32x4 (&acc)[MTL][4], const int lane) {
    const int r = lane & 15, q = lane >> 4;
    const bf16_t* dp = D + (size_t)r * ldd + q * 8;
#pragma unroll
    for (int a = 0; a < MTL; ++a)
#pragma unroll
        for (int b = 0; b < 4; ++b) acc[a][b] = (f32x4){0.f, 0.f, 0.f, 0.f};
    u32x2 w[8];
    { const bf16_t* p = base + (size_t)(q * 8) * rs;
#pragma unroll
      for (int j = 0; j < 8; ++j) w[j] = *(const u32x2*)(p + (size_t)j * rs); }
#pragma unroll 1
    for (int ks = 0; ks < ksteps; ++ks) {
        u32x2 wn[8];
        if (ks + 1 < ksteps) { const bf16_t* p = base + (size_t)((ks + 1) * 32 + q * 8) * rs;
#pragma unroll
            for (int j = 0; j < 8; ++j) wn[j] = *(const u32x2*)(p + (size_t)j * rs); }
        else {
#pragma unroll
            for (int j = 0; j < 8; ++j) wn[j] = w[j]; }
        union { bf16x8 v; unsigned d[4]; } f0, f1, f2, f3;
#pragma unroll
        for (int d = 0; d < 4; ++d) { const unsigned a0 = w[2 * d][0], a1 = w[2 * d + 1][0], c0 = w[2 * d][1], c1 = w[2 * d + 1][1];
            f0.d[d] = (a0 & 0xffffu) | (a1 << 16); f1.d[d] = (a0 >> 16) | (a1 & 0xffff0000u); f2.d[d] = (c0 & 0xffffu) | (c1 << 16); f3.d[d] = (c0 >> 16) | (c1 & 0xffff0000u); }
#pragma unroll
        for (int a = 0; a < MTL; ++a) { const bf16x8 af = *(const bf16x8*)(dp + (size_t)a * 16 * ldd + ks * 32);
            acc[a][0] = __builtin_amdgcn_mfma_f32_16x16x32_bf16(af, f0.v, acc[a][0], 0, 0, 0); acc[a][1] = __builtin_amdgcn_mfma_f32_16x16x32_bf16(af, f1.v, acc[a][1], 0, 0, 0);
            acc[a][2] = __builtin_amdgcn_mfma_f32_16x16x32_bf16(af, f2.v, acc[a][2], 0, 0, 0); acc[a][3] = __builtin_amdgcn_mfma_f32_16x16x32_bf16(af, f3.v, acc[a][3], 0, 0, 0); }
#pragma unroll
        for (int j = 0; j < 8; ++j) w[j] = wn[j];
    }
}
struct BLGather { const bf16_t* base; size_t rs; int lane;
    __device__ __forceinline__ bf16x8 operator()(int ks, int b) const {
        const int q = lane >> 4; const bf16_t* p = base + (size_t)(ks * 32 + q * 8) * rs + b * 16; bf16x8 v;
#pragma unroll
        for (int j = 0; j < 8; ++j) v[j] = (short)p[(size_t)j * rs];
        return v; }
};
__device__ __forceinline__ int ssm_row(int col, int s) { return col < 512 ? ((col >> 8) * SEQ + (col & 255) * 16 + s) : (MX + ((col - 512) >> 4) * LCX + ((col - 512) & 15) * 16 + s); }
template <int KW, bool YST>
__device__ __forceinline__ void ssm_stage_lds(PREF P, const int l, const int wi, unsigned char* shm, const int tid, const bool full = false) {
    const int lane = tid & 63, wv = tid >> 6, r = lane & 15, q = lane >> 4;
    const int g = wi >> 2, mh = (wi >> 1) & 1, half = wi & 1;
    unsigned char* wl = P.ws + l * SZ_LAYER; const bf16_t* parts = (const bf16_t*)(P.ws + O_PARTS);
    const bf16_t* D = (const bf16_t*)(wl + (YST ? LO_M2 : LO_M1)) + ((size_t)g * 256 + mh * 128) * KW;
    LAS unsigned char* lds = (LAS unsigned char*)shm;
    constexpr int CPR = KW / 8, KS = KW / 32;
    for (int ch = tid; ch < 128 * CPR; ch += 512) { const int row = ch / CPR, c = ch % CPR; const u32x4 v = *(const u32x4*)(D + (size_t)row * KW + c * 8);
        *(LAS u32x4*)(lds + row * (KW * 2) + ((c ^ (row & 15)) << 4)) = v; }
    __syncthreads();
    const int nct = (YST && l == 1) ? 16 : 17, hsplit = (nct + 1) / 2;
    const int t0 = (full || half == 0) ? 0 : hsplit, t1 = (full || half != 0) ? nct : hsplit;
    const bf16_t* HS = (const bf16_t*)(P.ws + O_HS);
    for (int ct = t0 + wv; ct < t1; ct += 8) {
        f32x4 acc[8][2];
#pragma unroll
        for (int a = 0; a < 8; ++a) { acc[a][0] = (f32x4){0.f, 0.f, 0.f, 0.f}; acc[a][1] = (f32x4){0.f, 0.f, 0.f, 0.f}; }
        const int colA = ct * 32 + r, colB = colA + 16;
        const bf16_t* pu0 = parts + E_PU + (size_t)(ssm_row(colA, 0) + (q >> 1)) * 1024 + g * 16 + (q & 1) * 8;
        const bf16_t* pu1 = parts + E_PU + (size_t)(ssm_row(colB, 0) + (q >> 1)) * 1024 + g * 16 + (q & 1) * 8;
        const bf16_t* ph0 = HS + ((size_t)g * NCOL + colA) * 256 + q * 8; const bf16_t* ph1 = HS + ((size_t)g * NCOL + colB) * 256 + q * 8;
#pragma unroll
        for (int kh = 0; kh < KS / 8; ++kh) {
            bf16x8 bq[8][2];
#pragma unroll
            for (int k8 = 0; k8 < 8; ++k8) {
                if (kh == 0) { bq[k8][0] = *(const bf16x8*)(pu0 + (size_t)k8 * 2 * 1024); bq[k8][1] = *(const bf16x8*)(pu1 + (size_t)k8 * 2 * 1024); }
                else { bq[k8][0] = *(const bf16x8*)(ph0 + k8 * 32); bq[k8][1] = *(const bf16x8*)(ph1 + k8 * 32); } }
#pragma unroll
            for (int k8 = 0; k8 < 8; ++k8) { const int ks = kh * 8 + k8;
                __builtin_amdgcn_sched_barrier(0);
#pragma unroll
                for (int a = 0; a < 8; ++a) { const bf16x8 af = *(const LAS bf16x8*)(lds + (a * 16 + r) * (KW * 2) + (((ks * 4 + q) ^ r) << 4));
                    acc[a][0] = __builtin_amdgcn_mfma_f32_16x16x32_bf16(af, bq[k8][0], acc[a][0], 0, 0, 0); acc[a][1] = __builtin_amdgcn_mfma_f32_16x16x32_bf16(af, bq[k8][1], acc[a][1], 0, 0, 0); }
            }
            __builtin_amdgcn_sched_barrier(0);
        }
        if (!YST) { float* EB = (float*)(P.ws + O_EB);
#pragma unroll
            for (int a = 0; a < 8; ++a)
#pragma unroll
                for (int b = 0; b < 2; ++b) { const int col = ct * 32 + b * 16 + r; *(f32x4*)(EB + ((size_t)g * NCOL + col) * 256 + mh * 128 + a * 16 + q * 4) = acc[a][b]; }
        } else { bf16_t* GB = (bf16_t*)(P.ws + O_GB); const f32x4 dv = *(const f32x4*)(P.ssm_d + l * 1024 + g * 16 + q * 4);
#pragma unroll
            for (int a = 0; a < 8; ++a)
#pragma unroll
                for (int b = 0; b < 2; ++b) { const int col = ct * 32 + b * 16 + r, t = mh * 8 + a, row = ssm_row(col, t);
                    const u32x2 uu = *(const u32x2*)(parts + E_PU + (size_t)row * 1024 + g * 16 + q * 4);
                    const float y0 = gelu_tanh(acc[a][b][0] + dv[0] * lo_f(uu[0])), y1 = gelu_tanh(acc[a][b][1] + dv[1] * hi_f(uu[0])), y2 = gelu_tanh(acc[a][b][2] + dv[2] * lo_f(uu[1])), y3 = gelu_tanh(acc[a][b][3] + dv[3] * hi_f(uu[1]));
                    u32x2 o; o[0] = cvt_pk_bf16(y0, y1); o[1] = cvt_pk_bf16(y2, y3); *(u32x2*)(GB + (size_t)row * 1024 + g * 16 + q * 4) = o; }
        }
    }
    __syncthreads();
}


template <int MODE>
__device__ __forceinline__ void ctx_small_gemm(PREF P, unsigned char* shm) {
    constexpr int K = MODE >= 2 ? 2048 : 1024, ROWS = MODE >= 2 ? 32 : 64, CPR = K / 8, KS = K / 32, NBR = MODE == 1 ? 3 : 1;
    const int tid = tid_opaque(), bidx = bid_opaque(), lane = tid & 63, w = tid >> 6, r = lane & 15, q = lane >> 4;
    unsigned char* wl = P.ws; const bf16_t* parts = (const bf16_t*)(P.ws + O_PARTS); LAS unsigned char* lds = (LAS unsigned char*)shm;
    for (int it = bidx; it < 256; it += gridDim.x) {
        const int rb = MODE >= 2 ? (it >> 4) : (it >> 5), cb = MODE >= 2 ? (it & 15) : (it & 31);
        const int row_base = MX + rb * ROWS;
        const int rt0 = MODE == 0 ? (w >> 1) : (MODE == 1 ? 2 * (w >> 2) : (MODE == 2 ? 0 : (w >> 2))), rt1 = (MODE == 0 || MODE == 3) ? rt0 : rt0 + 1;
        const int col0 = MODE == 0 ? cb * 32 + (w & 1) * 16 : (MODE == 1 ? cb * 64 + (w & 3) * 16 : (MODE == 2 ? cb * 128 + w * 16 : cb * 64 + (w & 3) * 16));
        float msum[2][4];
#pragma unroll
        for (int t = 0; t < 2; ++t)
#pragma unroll
            for (int i = 0; i < 4; ++i) msum[t][i] = 0.f;
#pragma unroll 1
        for (int br = 0; br < NBR; ++br) {
            const bf16_t* Asrc = MODE == 0 ? (const bf16_t*)(P.ws + O_GB) : (MODE == 1 ? (const bf16_t*)(P.ws + O_AB + (size_t)br * SZ_BR) : (MODE == 2 ? (const bf16_t*)(P.ws + O_HB) : (const bf16_t*)(P.ws + O_YB)));
            for (int ch = tid; ch < ROWS * CPR; ch += 512) { const int row = ch / CPR, c = ch % CPR; const u32x4 v = *(const u32x4*)(Asrc + (size_t)(row_base + row) * K + c * 8);
                *(LAS u32x4*)(lds + row * (K * 2) + ((c ^ (row & 15)) << 4)) = v; }
            __syncthreads();
            const bf16_t* W0; const bf16_t* W1;
            if (MODE == 0) { const int oc = col0 + r; W0 = (const bf16_t*)(wl + LO_GLU) + (size_t)((oc >> 7) * 256 + (oc & 127)) * K + q * 8; W1 = W0 + (size_t)128 * K; }
            else if (MODE == 1) { W0 = (const bf16_t*)(wl + LO_PA + (size_t)br * SZ_P) + (size_t)(col0 + r) * K + q * 8; W1 = W0; }
            else if (MODE == 2) { W0 = (const bf16_t*)(wl + LO_WO) + (size_t)(col0 + r) * K + q * 8; W1 = W0; }
            else { W0 = (const bf16_t*)(wl + LO_WP) + (size_t)(col0 + r) * K + q * 8; W1 = W0; }
            f32x4 acc0 = (f32x4){0.f, 0.f, 0.f, 0.f}, acc1 = (f32x4){0.f, 0.f, 0.f, 0.f};
#pragma unroll 4
            for (int ks = 0; ks < KS; ++ks) {
                const bf16x8 a0 = *(const LAS bf16x8*)(lds + (rt0 * 16 + r) * (K * 2) + (((ks * 4 + q) ^ r) << 4));
                const bf16x8 b0 = *(const bf16x8*)(W0 + ks * 32);
                if (MODE == 0) { const bf16x8 b1 = *(const bf16x8*)(W1 + ks * 32);
                    acc0 = __builtin_amdgcn_mfma_f32_16x16x32_bf16(a0, b0, acc0, 0, 0, 0); acc1 = __builtin_amdgcn_mfma_f32_16x16x32_bf16(a0, b1, acc1, 0, 0, 0); }
                else if (MODE == 3) { acc0 = __builtin_amdgcn_mfma_f32_16x16x32_bf16(a0, b0, acc0, 0, 0, 0); }
                else { const bf16x8 a1 = *(const LAS bf16x8*)(lds + (rt1 * 16 + r) * (K * 2) + (((ks * 4 + q) ^ r) << 4));
                    acc0 = __builtin_amdgcn_mfma_f32_16x16x32_bf16(a0, b0, acc0, 0, 0, 0); acc1 = __builtin_amdgcn_mfma_f32_16x16x32_bf16(a1, b0, acc1, 0, 0, 0); }
            }
            const int col = col0 + r;
            if (MODE == 0) { bf16_t* BBo = (bf16_t*)(P.ws + O_BB);
#pragma unroll
                for (int i = 0; i < 4; ++i) { const int row = row_base + rt0 * 16 + q * 4 + i; const float z = bf2f(parts[E_PZB + (size_t)row * 1024 + col]);
                    BBo[(size_t)row * 1024 + col] = (bf16_t)(cvt_pk_bf16(acc0[i] * sigmoidf_(acc1[i]) * siluf_(z), 0.f) & 0xffffu); }
            } else if (MODE == 1) {
#pragma unroll
                for (int i = 0; i < 4; ++i) { const int rowa = row_base + rt0 * 16 + q * 4 + i, rowb = row_base + rt1 * 16 + q * 4 + i;
                    msum[0][i] += acc0[i] * sigmoidf_(bf2f(parts[E_PGL + (size_t)rowa * 6144 + br * DM + col])); msum[1][i] += acc1[i] * sigmoidf_(bf2f(parts[E_PGL + (size_t)rowb * 6144 + br * DM + col])); }
            } else if (MODE == 3) { bf16_t* CBo = (bf16_t*)(P.ws + O_CB);
#pragma unroll
                for (int i = 0; i < 4; ++i) { const int row = row_base + rt0 * 16 + q * 4 + i; const float z = bf2f(parts[E_PZC + (size_t)row * 1024 + col]);
                    CBo[(size_t)row * 1024 + col] = (bf16_t)(cvt_pk_bf16(acc0[i] * siluf_(z), 0.f) & 0xffffu); }
            } else { bf16_t* OBo = (bf16_t*)(P.ws + O_PARTS);
#pragma unroll
                for (int i = 0; i < 4; ++i) { const int rowa = row_base + rt0 * 16 + q * 4 + i, rowb = row_base + rt1 * 16 + q * 4 + i;
                    OBo[(size_t)rowa * DM + col] = (bf16_t)(cvt_pk_bf16(acc0[i], 0.f) & 0xffffu); OBo[(size_t)rowb * DM + col] = (bf16_t)(cvt_pk_bf16(acc1[i], 0.f) & 0xffffu); }
            }
            __syncthreads();
        }
        if (MODE == 1) { bf16_t* MBo = (bf16_t*)(P.ws + O_HB); const int col = col0 + r;
#pragma unroll
            for (int i = 0; i < 4; ++i) { const int rowa = row_base + rt0 * 16 + q * 4 + i, rowb = row_base + rt1 * 16 + q * 4 + i;
                MBo[(size_t)rowa * DM + col] = (bf16_t)(cvt_pk_bf16(msum[0][i], 0.f) & 0xffffu); MBo[(size_t)rowb * DM + col] = (bf16_t)(cvt_pk_bf16(msum[1][i], 0.f) & 0xffffu); }
        }
    }
}

struct TileJob { const float* src; bf16_t* dst; int N, K, k0, n0, drow0; };
constexpr int TILES_PER_LAYER = 4736 + 512;
__device__ __forceinline__ TileJob tile_job(PREF P, int gt) {
    const int l = gt / TILES_PER_LAYER, tt = gt - l * TILES_PER_LAYER; unsigned char* wl = P.ws + l * SZ_LAYER; TileJob J; int kt, nt;
    if (tt < 3584) { J.src = P.w_in + (size_t)l * DM * INW; J.dst = (bf16_t*)(wl + LO_WIN); J.K = DM; J.N = INW; kt = tt & 15; nt = tt >> 4; J.drow0 = nt * 64; }
    else if (tt < 3584 + 768) { const int e = tt - 3584, w = e >> 8, f = e & 255; J.src = (w == 0 ? P.proj_a : (w == 1 ? P.proj_b : P.proj_c)) + (size_t)l * 1024 * DM;
        J.dst = (bf16_t*)(wl + LO_PA + (size_t)w * SZ_P); J.K = 1024; J.N = DM; kt = f & 7; nt = f >> 3; J.drow0 = nt * 64; }
    else if (tt < 4352 + 256) { const int e = tt - 4352, w = e >> 7, f = e & 127; J.src = (w == 0 ? P.glu_wa : P.glu_wb) + (size_t)l * 1024 * 1024; J.dst = (bf16_t*)(wl + LO_GLU);
        J.K = 1024; J.N = 1024; kt = f & 7; nt = f >> 3; const int n0 = nt * 64; J.drow0 = (n0 >> 7) * 256 + (n0 & 127) + w * 128; }
    else if (tt < 4608 + 128) { const int f = tt - 4608; J.src = P.fourier_w + (size_t)l * 1024 * 1024; J.dst = (bf16_t*)(wl + LO_FW); J.K = 1024; J.N = 1024; kt = f & 7; nt = f >> 3; J.drow0 = nt * 64; }
    else { const int f = tt - 4736; J.src = P.w_out + (size_t)l * DM * DM; J.dst = (bf16_t*)(wl + LO_WO); J.K = DM; J.N = DM; kt = f & 15; nt = f >> 4; J.drow0 = nt * 64; }
    J.k0 = kt * 128; J.n0 = nt * 64; return J;
}


__device__ __forceinline__ void mod_item(PREF P, int l, int nt, float* sm) {
    const int tid = tid_opaque(); float* sc = sm; float* red = sm + 3 * 2048;
    for (int i = tid; i < 3 * 2048; i += 512) { const int r = i >> 11, k = i & 2047; const float v = r < 2 ? P.c[r * 2048 + k] : P.c_ctx[k]; sc[i] = siluf_(v); }
    __syncthreads();
    const int col = tid & 63, kg = tid >> 6; const float* w = P.w_ada + (size_t)l * DM * 6144 + nt * 64 + col;
    float a0 = 0.f, a1 = 0.f, a2 = 0.f;
#pragma unroll 16
    for (int k = kg * 256; k < kg * 256 + 256; ++k) { const float wv = w[(size_t)k * 6144]; a0 += sc[k] * wv; a1 += sc[2048 + k] * wv; a2 += sc[4096 + k] * wv; }
    red[(kg * 3 + 0) * 64 + col] = a0; red[(kg * 3 + 1) * 64 + col] = a1; red[(kg * 3 + 2) * 64 + col] = a2;
    __syncthreads();
    if (tid < 192) { const int r = tid >> 6, c = tid & 63; float s = 0.f;
#pragma unroll
        for (int k = 0; k < 8; ++k) s += red[(k * 3 + r) * 64 + c];
        float* MOD = (float*)(P.ws + l * SZ_LAYER + LO_MOD); MOD[r * 6144 + nt * 64 + c] = s + P.b_ada[l * 6144 + nt * 64 + c]; }
    __syncthreads();
}

__device__ __forceinline__ void tables_item(PREF P, int it) {
    const int tid = tid_opaque(); unsigned char* tb = P.ws + O_TAB;
    if (it < 8) {
        bf16_t* T = (bf16_t*)(tb + T_CS);
        for (int e = tid; e < 64 * 256; e += 512) { const int row = it * 64 + (e >> 8), kc = e & 255, cs = row >> 8, j = row & 255; const int mm = (j * kc) & 255;
            float s, c; sincospif((float)mm * (1.0f / 128.0f), &s, &c); T[row * 256 + kc] = (bf16_t)(cvt_pk_bf16((cs ? s : c) * 0.0625f, 0.f) & 0xffffu); }
    } else if (it < 16) {
        bf16_t* T = (bf16_t*)(tb + T_DCTX); const int i8 = it - 8;
        for (int e = tid; e < 64 * 256; e += 512) { const int row = i8 * 64 + (e >> 8), t = e & 255, cs = row >> 8, k = row & 255; const int mm = (k * t) & 255;
            float s, c; sincospif((float)mm * (1.0f / 128.0f), &s, &c); T[row * 256 + t] = (bf16_t)(cvt_pk_bf16((cs ? -s : c) * 0.0625f, 0.f) & 0xffffu); }
    } else {
        bf16_t* D1 = (bf16_t*)(tb + T_D1); bf16_t* D2 = (bf16_t*)(tb + T_D2); float* TW = (float*)(tb + T_TW);
        for (int e = tid; e < 128 * 64; e += 512) { const int row = e >> 6, t1 = e & 63, cs = row >> 6, k1 = row & 63; const int mm = (k1 * t1) & 63;
            float s, c; sincospif((float)mm * (1.0f / 32.0f), &s, &c); D1[e] = (bf16_t)(cvt_pk_bf16((cs ? -s : c) * 0.125f, 0.f) & 0xffffu); }
        for (int e = tid; e < 128 * 128; e += 512) { const int row = e >> 7, col = e & 127, cso = row >> 6, k2 = row & 63, csi = col >> 6, t2 = col & 63; const int mm = (k2 * t2) & 63;
            float s, c; sincospif((float)mm * (1.0f / 32.0f), &s, &c); const float v = (cso == csi) ? c : (cso == 0 ? s : -s);
            D2[e] = (bf16_t)(cvt_pk_bf16(v * 0.125f, 0.f) & 0xffffu); }
        for (int e = tid; e < 64 * 64; e += 512) { const int k1 = e >> 6, t2 = e & 63; float s, c; sincospif((float)(k1 * t2) * (1.0f / 2048.0f), &s, &c); TW[2 * e] = c; TW[2 * e + 1] = -s; }
    }
}

__device__ __forceinline__ void ssm_build(PREF P, int l, int g, float* sm) {
    float* ap_re = sm; float* ap_im = ap_re + 2 * 17 * 64; float* bb_re = ap_im + 2 * 17 * 64; float* bb_im = bb_re + 2 * 64 * 16;
    float* cc_re = bb_im + 2 * 64 * 16; float* cc_im = cc_re + 2 * 16 * 64; float* Kk = cc_im + 2 * 16 * 64;
    const int tid = tid_opaque(); unsigned char* wl = P.ws + l * SZ_LAYER;
    if (tid < 128) {
        const int d = tid >> 6, p = tid & 63; const size_t gi = (size_t)(l * 2 + d) * 64 + g;
        const double lr = (double)P.lam_re[gi * 64 + p], li = (double)P.lam_im[gi * 64 + p], dt = exp((double)P.log_dt[gi]);
        const double a_re = exp(lr * dt) * cos(li * dt), a_im = exp(lr * dt) * sin(li * dt);
        { double pr = 1.0, pi = 0.0;
          for (int tau = 0; tau <= 16; ++tau) { ap_re[(d * 17 + tau) * 64 + p] = (float)pr; ap_im[(d * 17 + tau) * 64 + p] = (float)pi;
              if (tau == 16) { float* A16 = (float*)(wl + LO_A16); A16[((d * 64 + g) * 64 + p) * 2] = (float)pr; A16[((d * 64 + g) * 64 + p) * 2 + 1] = (float)pi; }
              const double nr = pr * a_re - pi * a_im, ni = pr * a_im + pi * a_re; pr = nr; pi = ni; } }
        const double n_re = a_re - 1.0, n_im = a_im, den = lr * lr + li * li;
        const double q_re = (n_re * lr + n_im * li) / den, q_im = (n_im * lr - n_re * li) / den;
        for (int h = 0; h < 16; ++h) { const double br = (double)P.b_re[(gi * 64 + p) * 16 + h], bi = (double)P.b_im[(gi * 64 + p) * 16 + h];
            bb_re[(d * 64 + p) * 16 + h] = (float)(q_re * br - q_im * bi); bb_im[(d * 64 + p) * 16 + h] = (float)(q_re * bi + q_im * br); }
    }
    for (int i = tid; i < 2048; i += 512) { const int d = i >> 10, rem = i & 1023; const size_t s = ((size_t)(l * 2 + d) * 64 + g) * 1024 + rem; cc_re[i] = P.c_re[s]; cc_im[i] = P.c_im[s]; }
    __syncthreads();
    { const int d = tid >> 8, tau = (tid >> 4) & 15, ho = tid & 15; float sacc[16];
#pragma unroll
      for (int hi = 0; hi < 16; ++hi) sacc[hi] = 0.f;
      for (int p = 0; p < 64; ++p) { const float cr = cc_re[(d * 16 + ho) * 64 + p], ci = cc_im[(d * 16 + ho) * 64 + p], ar = ap_re[(d * 17 + tau) * 64 + p], ai = ap_im[(d * 17 + tau) * 64 + p];
          const float wr = cr * ar - ci * ai, wi = cr * ai + ci * ar; const float* br = bb_re + (d * 64 + p) * 16; const float* bi = bb_im + (d * 64 + p) * 16;
#pragma unroll
          for (int hi = 0; hi < 16; ++hi) sacc[hi] += wr * br[hi] - wi * bi[hi]; }
#pragma unroll
      for (int hi = 0; hi < 16; ++hi) Kk[((d * 16 + tau) * 16 + ho) * 16 + hi] = sacc[hi]; }
    __syncthreads();
    bf16_t* M1 = (bf16_t*)(wl + LO_M1) + (size_t)g * 256 * 256; bf16_t* M2 = (bf16_t*)(wl + LO_M2) + (size_t)g * 256 * 512;
    for (int v = tid; v < 8192; v += 512) { const int mrow = v >> 5, k0 = (v & 31) * 8; const int d = mrow >> 7, reim = (mrow >> 6) & 1, p = mrow & 63, s = k0 >> 4, hi0 = k0 & 15;
        const int tau = d == 0 ? 15 - s : s; const float ar = ap_re[(d * 17 + tau) * 64 + p], ai = ap_im[(d * 17 + tau) * 64 + p]; float f[8];
#pragma unroll
        for (int j = 0; j < 8; ++j) { const float br = bb_re[(d * 64 + p) * 16 + hi0 + j], bi = bb_im[(d * 64 + p) * 16 + hi0 + j]; f[j] = reim == 0 ? ar * br - ai * bi : ar * bi + ai * br; }
        *(u32x4*)(M1 + (size_t)mrow * 256 + k0) = pack8(f); }
    for (int v = tid; v < 16384; v += 512) { const int r = v >> 6, k0 = (v & 63) * 8, t = r >> 4, ho = r & 15; float f[8];
        if (k0 < 256) { const int s = k0 >> 4, hi0 = k0 & 15;
#pragma unroll
            for (int j = 0; j < 8; ++j) f[j] = s < t ? Kk[(t - s) * 256 + ho * 16 + hi0 + j] : (s > t ? Kk[(16 + (s - t)) * 256 + ho * 16 + hi0 + j] : Kk[ho * 16 + hi0 + j] + Kk[16 * 256 + ho * 16 + hi0 + j]);
        } else { const int kk = k0 - 256, d = kk >> 7, reim = (kk >> 6) & 1, p0 = kk & 63, tau = d == 0 ? t + 1 : 16 - t;
#pragma unroll
            for (int j = 0; j < 8; ++j) { const int p = p0 + j; const float cr = cc_re[(d * 16 + ho) * 64 + p], ci = cc_im[(d * 16 + ho) * 64 + p], ar = ap_re[(d * 17 + tau) * 64 + p], ai = ap_im[(d * 17 + tau) * 64 + p];
                f[j] = reim == 0 ? cr * ar - ci * ai : -(cr * ai + ci * ar); } }
        *(u32x4*)(M2 + (size_t)r * 512 + k0) = pack8(f); }
    __syncthreads();
}

__device__ __forceinline__ void phase_prep(PREF P, unsigned char* shm) {
    float* sm = (float*)shm; const int b = bid_opaque(), G = gridDim.x;
    for (int it = b; it < 337; it += G) {
        if (it < 128) ssm_build(P, it >> 6, it & 63, sm);
        else if (it < 320) { const int e = it - 128; mod_item(P, e / 96, e % 96, sm); }
        else tables_item(P, it - 320);
    }
    const int total = 2 * TILES_PER_LAYER; int start, cnt;
    if (G == 256) { if (b < 64) { start = b * 38; cnt = 38; } else if (b < 81) { start = 2432 + (b - 64) * 42; cnt = 42; } else { start = 2432 + 17 * 42 + (b - 81) * 43; cnt = 43; } }
    else { cnt = (total + G - 1) / G; start = b * cnt; }
    const int end = (start + cnt) < total ? (start + cnt) : total;
    const int tid = tid_opaque(), lr = tid >> 4, lc = (tid & 15) * 4;
    if (start < end) {
        int cur = start; TileJob J = tile_job(P, cur); f32x4 v[4];
#pragma unroll
        for (int i = 0; i < 4; ++i) v[i] = *(const f32x4*)(J.src + (size_t)(J.k0 + lr + 32 * i) * J.N + J.n0 + lc);
        for (;;) {
#pragma unroll
            for (int i = 0; i < 4; ++i)
#pragma unroll
                for (int j = 0; j < 4; ++j) sm[(lr + 32 * i) * 65 + lc + j] = v[i][j];
            __syncthreads();
            const TileJob C = J; const bool more = cur + 1 < end;
            if (more) { J = tile_job(P, cur + 1);
#pragma unroll
                for (int i = 0; i < 4; ++i) v[i] = *(const f32x4*)(J.src + (size_t)(J.k0 + lr + 32 * i) * J.N + J.n0 + lc); }
            const int n = tid >> 3, kg = tid & 7;
#pragma unroll
            for (int h = 0; h < 2; ++h) { float f[8];
#pragma unroll
                for (int j = 0; j < 8; ++j) f[j] = sm[(kg * 16 + h * 8 + j) * 65 + n];
                *(u32x4*)(C.dst + (size_t)(C.drow0 + n) * C.K + C.k0 + kg * 16 + h * 8) = pack8(f); }
            __syncthreads();
            if (!more) break;
            ++cur;
        }
    }
}

__device__ __forceinline__ void phase_prenorm0(PREF P) {
    const int tidx = tid_opaque(); const int lane = tidx & 63, gw = bid_opaque() * 8 + (tidx >> 6), nw = gridDim.x * 8;
    const float* MOD = (const float*)(P.ws + LO_MOD); bf16_t* HB = (bf16_t*)(P.ws + O_HB);
    for (int row = gw; row < MTOT; row += nw) {
        const float* src = row < MX ? P.x + (size_t)row * DM : P.ctx + (size_t)(row - MX) * DM; const float* md = MOD + (row < MX ? (row >> 12) : 2) * 6144;
        f32x4 v[8]; float ss = 0.f;
#pragma unroll
        for (int i = 0; i < 8; ++i) { v[i] = *(const f32x4*)(src + (i * 64 + lane) * 4); ss += v[i][0] * v[i][0] + v[i][1] * v[i][1] + v[i][2] * v[i][2] + v[i][3] * v[i][3]; }
        ss = wave_sum(ss, lane); const float rinv = rsqrtf(ss * (1.0f / DM) + RMS_EPS);
#pragma unroll
        for (int i = 0; i < 8; ++i) { const int c = (i * 64 + lane) * 4; const f32x4 g = *(const f32x4*)(P.g_pre + c), sh = *(const f32x4*)(md + c), sc = *(const f32x4*)(md + 2048 + c); float h[4];
#pragma unroll
            for (int j = 0; j < 4; ++j) h[j] = v[i][j] * rinv * g[j] * (1.0f + sc[j]) + sh[j];
            u32x2 o; o[0] = cvt_pk_bf16(h[0], h[1]); o[1] = cvt_pk_bf16(h[2], h[3]); *(u32x2*)(HB + (size_t)row * DM + c) = o; }
    }
}
__device__ __forceinline__ void phase_postnorm(PREF P, int l) {
    const int tidx = tid_opaque(); const int lane = tidx & 63, gw = bid_opaque() * 8 + (tidx >> 6), nw = gridDim.x * 8;
    const float* MOD = (const float*)(P.ws + l * SZ_LAYER + LO_MOD); const float* MOD1 = (const float*)(P.ws + SZ_LAYER + LO_MOD);
    bf16_t* HB = (bf16_t*)(P.ws + O_HB); const bf16_t* OB = (const bf16_t*)(P.ws + O_PARTS); float* X1 = (float*)(P.ws + O_X1);
    const int rows = l == 0 ? MTOT : MX;
    for (int row = gw; row < rows; row += nw) {
        const int mr = row < MX ? (row >> 12) : 2; const float* md = MOD + mr * 6144;
        const float* xo = l == 0 ? (row < MX ? P.x + (size_t)row * DM : P.ctx + (size_t)(row - MX) * DM) : X1 + (size_t)row * DM;
        const bf16_t* op = OB + (size_t)row * DM;
        f32x4 o[8], xv[8]; float ss = 0.f;
#pragma unroll
        for (int i = 0; i < 8; ++i) { const u32x2 ob = *(const u32x2*)(op + (i * 64 + lane) * 4); o[i] = (f32x4){lo_f(ob[0]), hi_f(ob[0]), lo_f(ob[1]), hi_f(ob[1])}; xv[i] = *(const f32x4*)(xo + (i * 64 + lane) * 4); ss += o[i][0] * o[i][0] + o[i][1] * o[i][1] + o[i][2] * o[i][2] + o[i][3] * o[i][3]; }
        ss = wave_sum(ss, lane); const float rinv = rsqrtf(ss * (1.0f / DM) + RMS_EPS); float s2 = 0.f;
#pragma unroll
        for (int i = 0; i < 8; ++i) { const int c = (i * 64 + lane) * 4; const f32x4 gp = *(const f32x4*)(P.g_post + l * DM + c), gt = *(const f32x4*)(md + 4096 + c);
#pragma unroll
            for (int j = 0; j < 4; ++j) { xv[i][j] = xv[i][j] + gt[j] * (o[i][j] * rinv * gp[j]); s2 += xv[i][j] * xv[i][j]; }
            if (l == 0) *(f32x4*)(X1 + (size_t)row * DM + c) = xv[i]; else *(f32x4*)(P.out + (size_t)row * DM + c) = xv[i]; }
        if (l == 0) { s2 = wave_sum(s2, lane); const float r2 = rsqrtf(s2 * (1.0f / DM) + RMS_EPS); const float* m1 = MOD1 + mr * 6144;
#pragma unroll
            for (int i = 0; i < 8; ++i) { const int c = (i * 64 + lane) * 4; const f32x4 g = *(const f32x4*)(P.g_pre + DM + c), sh = *(const f32x4*)(m1 + c), sc = *(const f32x4*)(m1 + 2048 + c); float h[4];
#pragma unroll
                for (int j = 0; j < 4; ++j) h[j] = xv[i][j] * r2 * g[j] * (1.0f + sc[j]) + sh[j];
                u32x2 ov; ov[0] = cvt_pk_bf16(h[0], h[1]); ov[1] = cvt_pk_bf16(h[2], h[3]); *(u32x2*)(HB + (size_t)row * DM + c) = ov; } }
    }
}


__device__ __forceinline__ void conv_rows(PREF P, const int l, const int bsub, const int nblk, const int tidx) {
    const bf16_t* parts = (const bf16_t*)(P.ws + O_PARTS); bf16_t* AB = (bf16_t*)(P.ws + O_AB);
    const int rows = l == 0 ? MTOT : MX; const float* cw = P.conv_w + (size_t)l * 3 * 1024;
    for (int idx = bsub * 512 + tidx; idx < (rows >> 2) * 128; idx += nblk * 512) {
        const int r0 = (idx >> 7) * 4, c0 = (idx & 127) * 8; bool lv, rv;
        if (r0 < MX) { const int cp = r0 & 63; lv = cp > 0; rv = cp < 60; } else { const int t = (r0 - MX) & 255; lv = t > 0; rv = t < 252; }
        const bf16_t* pr = parts + E_PC + (size_t)r0 * 4096 + c0;
        u32x4 xr[6], cr[6], br[4], zr[4];
#pragma unroll
        for (int k = 0; k < 6; ++k) { const bool ok = (k == 0) ? lv : ((k == 5) ? rv : true);
            if (ok) { xr[k] = *(const u32x4*)(pr + (ptrdiff_t)(k - 1) * 4096 + C_XA); cr[k] = *(const u32x4*)(pr + (ptrdiff_t)(k - 1) * 4096 + C_CA); }
            else { xr[k] = (u32x4){0u, 0u, 0u, 0u}; cr[k] = (u32x4){0u, 0u, 0u, 0u}; } }
#pragma unroll
        for (int k = 0; k < 4; ++k) { br[k] = *(const u32x4*)(pr + (size_t)k * 4096 + C_BA); zr[k] = *(const u32x4*)(pr + (size_t)k * 4096 + C_ZA); }
        float w0[8], w1[8], w2[8];
#pragma unroll
        for (int j = 0; j < 8; ++j) { w0[j] = cw[c0 + j]; w1[j] = cw[1024 + c0 + j]; w2[j] = cw[2048 + c0 + j]; }
        float v[6][8];
#pragma unroll
        for (int k = 0; k < 6; ++k) { float xa[8], ca[8]; unpack8(xr[k], xa); unpack8(cr[k], ca);
#pragma unroll
            for (int j = 0; j < 8; ++j) v[k][j] = xa[j] * ca[j]; }
#pragma unroll
        for (int k = 0; k < 4; ++k) { float ba[8], za[8], o[8]; unpack8(br[k], ba); unpack8(zr[k], za);
#pragma unroll
            for (int j = 0; j < 8; ++j) { const float y = w0[j] * v[k][j] + w1[j] * v[k + 1][j] + w2[j] * v[k + 2][j]; o[j] = ba[j] * y * siluf_(za[j]); }
            *(u32x4*)(AB + (size_t)(r0 + k) * 1024 + c0) = pack8(o); }
    }
}

__device__ __forceinline__ void phase_mix1(PREF P, int l, unsigned char* shm) {
    const bf16_t* parts = (const bf16_t*)(P.ws + O_PARTS); unsigned char* wl = P.ws + l * SZ_LAYER;
    const int tidx = tid_opaque(), bidx = bid_opaque(); const int lane = tidx & 63, wv = tidx >> 6, r = lane & 15, q = lane >> 4;
    const int gw = bidx * 8 + wv, nw = gridDim.x * 8;
    for (int wi = bidx; wi < 256; wi += gridDim.x) ssm_stage_lds<256, false>(P, l, wi, shm, tidx);
    {
        bf16_t* ZB = (bf16_t*)(P.ws + O_ZB); const bf16_t* D1 = (const bf16_t*)(P.ws + O_TAB + T_D1); const float* TW = (const float*)(P.ws + O_TAB + T_TW);
        for (int it = gw; it < 2048; it += nw) {
            const int cg = it & 15, t2 = (it >> 4) & 63, b = it >> 10;
            f32x4 acc[8][4];
            lmul_g4<8>(D1, 64, 2, parts + E_PF + (size_t)(b * SEQ + t2) * 1024 + cg * 64 + r * 4, (size_t)64 * 1024, acc, lane);
#pragma unroll
            for (int a = 0; a < 4; ++a)
#pragma unroll
                for (int i = 0; i < 4; ++i) { const int k1 = a * 16 + q * 4 + i; const float twr = TW[(k1 * 64 + t2) * 2], twi = TW[(k1 * 64 + t2) * 2 + 1];
                    bf16_t* zr = ZB + ((size_t)((b * 64 + k1) * 128 + t2)) * 1024 + cg * 64 + r * 4; bf16_t* zi = zr + (size_t)64 * 1024; float vr[4], vi[4];
#pragma unroll
                    for (int nb = 0; nb < 4; ++nb) { const float re = acc[a][nb][i], im = acc[a + 4][nb][i]; vr[nb] = re * twr - im * twi; vi[nb] = re * twi + im * twr; }
                    u32x2 o; o[0] = cvt_pk_bf16(vr[0], vr[1]); o[1] = cvt_pk_bf16(vr[2], vr[3]); *(u32x2*)zr = o; o[0] = cvt_pk_bf16(vi[0], vi[1]); o[1] = cvt_pk_bf16(vi[2], vi[3]); *(u32x2*)zi = o; }
        }
    }
}


__device__ __forceinline__ void ctx_dft_item(PREF P, const int it, const int lane) {
    const int r = lane & 15, q = lane >> 4; const bf16_t* parts = (const bf16_t*)(P.ws + O_PARTS);
    bf16_t* YB = (bf16_t*)(P.ws + O_YB); const bf16_t* DC = (const bf16_t*)(P.ws + O_TAB + T_DCTX);
    const int cg = it & 15, mc = (it >> 4) & 3, b = it >> 6;
    f32x4 acc[8][4];
    lmul_g4<8>(DC + (size_t)mc * 128 * 256, 256, 8, parts + E_PF + (size_t)(MX + b * LCX) * 1024 + cg * 64 + r * 4, (size_t)1024, acc, lane);
#pragma unroll
    for (int a = 0; a < 8; ++a)
#pragma unroll
        for (int i = 0; i < 4; ++i) { const int mrow = mc * 128 + a * 16 + q * 4 + i, cs = mrow >> 8, k = mrow & 255;
            bf16_t* yp = YB + (size_t)(MX + b * LCX + k) * 2048 + cs * 1024 + cg * 64 + r * 4;
            u32x2 o; o[0] = cvt_pk_bf16(acc[a][0][i], acc[a][1][i]); o[1] = cvt_pk_bf16(acc[a][2][i], acc[a][3][i]); *(u32x2*)yp = o; }
}

__device__ __forceinline__ void scan_one(PREF P, const int l, int g, int b, int d, const int p) {
    asm volatile("" : "+s"(g), "+s"(b), "+s"(d));
    const float* EB = (const float*)(P.ws + O_EB); bf16_t* HS = (bf16_t*)(P.ws + O_HS); const float* A16 = (const float*)(P.ws + l * SZ_LAYER + LO_A16);
    const float ar = A16[((d * 64 + g) * 64 + p) * 2], ai = A16[((d * 64 + g) * 64 + p) * 2 + 1];
    float hr = 0.f, hi = 0.f;
    const ptrdiff_t st = d ? -256 : 256;
    const size_t cc = (size_t)g * NCOL + 512 + b * 16 + (d ? 15 : 0), cx = (size_t)g * NCOL + b * 256 + (d ? 255 : 0);
    const float* ec = EB + cc * 256 + d * 128 + p; bf16_t* hc = HS + cc * 256 + d * 128 + p;
    const float* ex = EB + cx * 256 + d * 128 + p; bf16_t* hx = HS + cx * 256 + d * 128 + p;
#define SCAN_LOAD(er, ei, ep) { const float* _e = (ep); _Pragma("unroll") for (int jj = 0; jj < 16; ++jj) { er[jj] = _e[jj * st]; ei[jj] = _e[jj * st + 64]; } }
#define SCAN_STEP(er, ei, hp0) { bf16_t* _h = (hp0); _Pragma("unroll") for (int jj = 0; jj < 16; ++jj) { const unsigned pk = cvt_pk_bf16(hr, hi); _h[jj * st] = (bf16_t)(pk & 0xffffu); _h[jj * st + 64] = (bf16_t)(pk >> 16); \
        const float nr = ar * hr - ai * hi + er[jj], ni = ar * hi + ai * hr + ei[jj]; hr = nr; hi = ni; } }
    float era[16], eia[16], erb[16], eib[16];
    SCAN_LOAD(era, eia, ec)
    SCAN_LOAD(erb, eib, ex)
    SCAN_STEP(era, eia, hc)
#pragma unroll 1
    for (int it2 = 0; it2 < 8; ++it2) {
        SCAN_LOAD(era, eia, ex + (ptrdiff_t)(2 * it2 + 1) * 16 * st)
        SCAN_STEP(erb, eib, hx + (ptrdiff_t)(2 * it2) * 16 * st)
        if (it2 < 7) SCAN_LOAD(erb, eib, ex + (ptrdiff_t)(2 * it2 + 2) * 16 * st)
        SCAN_STEP(era, eia, hx + (ptrdiff_t)(2 * it2 + 1) * 16 * st)
    }
#undef SCAN_LOAD
#undef SCAN_STEP
}
__device__ __forceinline__ void fft2_items(PREF P, int gw, const int nw, const int lane) {
    asm volatile("" : "+s"(gw));
    const int r = lane & 15, q = lane >> 4;
    const bf16_t* ZB = (const bf16_t*)(P.ws + O_ZB); bf16_t* YB = (bf16_t*)(P.ws + O_YB); const bf16_t* D2 = (const bf16_t*)(P.ws + O_TAB + T_D2);
    for (int it = gw; it < 2048; it += nw) {
        const int cg = it & 15, k1 = (it >> 4) & 63, b = it >> 10;
        f32x4 acc[8][4];
        lmul_g4<8>(D2, 128, 4, ZB + (size_t)(b * 64 + k1) * 128 * 1024 + cg * 64 + r * 4, (size_t)1024, acc, lane);
#pragma unroll
        for (int a = 0; a < 8; ++a)
#pragma unroll
            for (int i = 0; i < 4; ++i) { const int mrow = a * 16 + q * 4 + i, cs = mrow >> 6, k2 = mrow & 63;
                bf16_t* yp = YB + (size_t)(b * SEQ + k1 + 64 * k2) * 2048 + cs * 1024 + cg * 64 + r * 4;
                u32x2 o; o[0] = cvt_pk_bf16(acc[a][0][i], acc[a][1][i]); o[1] = cvt_pk_bf16(acc[a][2][i], acc[a][3][i]); *(u32x2*)yp = o; }
    }
}

__device__ __forceinline__ void phase_mix2(PREF P, int l, unsigned char* shm) {
    const int bidx = bid_opaque(), G = gridDim.x; const int wv = __builtin_amdgcn_readfirstlane(tid_opaque() >> 6);
    const int nA = G >= 256 ? 128 : (G >= 2 ? G / 2 : 1), nB = G > nA ? G - nA : 0;
    if (bidx < nA || nB == 0) {
        bool dft_done = false;
        for (int it = bidx; it < 128; it += nA) {
            const int g = it >> 1, mh = it & 1;
            if (wv < 4) scan_one(P, l, g, wv >> 1, wv & 1, tid_opaque() & 63);
            else if (l == 0 && !dft_done) { for (int ci = bidx * 4 + (wv - 4); ci < 128; ci += nA * 4) ctx_dft_item(P, ci, tid_opaque() & 63); dft_done = true; }
            asm volatile("s_waitcnt vmcnt(0)" ::: "memory");
            ssm_stage_lds<512, true>(P, l, g * 4 + mh * 2, shm, tid_opaque(), true);
        }
    }
    if (bidx >= nA || nB == 0) {
        const int bs = nB == 0 ? bidx : bidx - nA, nb = nB == 0 ? G : nB;
        fft2_items(P, bs * 8 + wv, nb * 8, tid_opaque() & 63);
        conv_rows(P, l, bs, nb, tid_opaque());
    }
}

template <int ph>
__device__ __forceinline__ void run_phase(KPtr kp, unsigned char* shm) {
    asm volatile("" : "+s"(kp)); PREF P = *kp;
    LAS unsigned char* lds = (LAS unsigned char*)shm; const int G = gridDim.x, c = bid_opaque();
    if constexpr (ph == 0) { phase_prep(P, shm); return; }
    if constexpr (ph == 1) {
        phase_prenorm0(P);
        return;
    }
    constexpr int l = ph >= 2 ? ((ph - 2) >> 3) : 0, sp = ph >= 2 ? ((ph - 2) & 7) : 0; unsigned char* wl = P.ws + l * SZ_LAYER; constexpr int nM = 32, nh = l == 0 ? 4 : 0;
    const bf16_t* parts = (const bf16_t*)(P.ws + O_PARTS);
    switch (sp) {
    case 0: { EpiParts E{(bf16_t*)(P.ws + O_PARTS)};
        if (l == 0) { SchedGrid S{(const char*)(P.ws + O_HB), (const char*)(wl + LO_WIN), 32, 56, DM, DM, G, c, 4, MX, 1 << 20}; gemm_phase(lds, S, E, DM, DM, DM);
            { const int c3 = bid_opaque(); const int first = G > 224 ? 224 : 0; if (c3 >= first) { SchedWp SW{P.ws, G - first, c3 - first}; EpiWp EW{P.ws}; gemm_phase(lds, SW, EW, 256, 1024, 256); } } }
        else {
            {
                const int tq = tid_opaque(), lane = tq & 63, r = lane & 15, q = lane >> 4; const bf16_t* HB = (const bf16_t*)(P.ws + O_HB); const bf16_t* WT = (const bf16_t*)(wl + LO_WIN); bf16_t* po = (bf16_t*)(P.ws + O_PARTS);
                for (int it = c * 8 + (tq >> 6); it < 2048; it += G * 8) { const int tr = it >> 6, tc = it & 63;
                    const bf16_t* ap = HB + (size_t)(MX + tr * 16 + r) * DM + q * 8; const bf16_t* bp = WT + (size_t)(C_U + tc * 16 + r) * DM + q * 8; f32x4 a4 = (f32x4){0.f, 0.f, 0.f, 0.f};
#pragma unroll 8
                    for (int ks = 0; ks < 64; ++ks) a4 = __builtin_amdgcn_mfma_f32_16x16x32_bf16(*(const bf16x8*)(ap + ks * 32), *(const bf16x8*)(bp + ks * 32), a4, 0, 0, 0);
#pragma unroll
                    for (int i = 0; i < 4; ++i) po[E_PU + (size_t)(MX + tr * 16 + q * 4 + i) * 1024 + tc * 16 + r] = (bf16_t)(cvt_pk_bf16(a4[i], 0.f) & 0xffffu); }
            }
            SchedGrid S{(const char*)(P.ws + O_HB), (const char*)(wl + LO_WIN), 32, 56, DM, DM, G, c, 0, MX, 1 << 20}; gemm_phase(lds, S, E, DM, DM, DM); }
    } break;
    case 1: phase_mix1(P, l, shm); break;
    case 2: phase_mix2(P, l, shm); break;
    case 3: break;
    case 4: {
        if (l == 0) { ctx_small_gemm<0>(P, shm); ctx_small_gemm<3>(P, shm); }
        const int nf = nM * 4;
        { const int c1 = bid_opaque(); SchedGrid S{(const char*)(P.ws + O_YB), (const char*)(wl + LO_WP), nM, 4, 2048, 2048, nf, c1, 0, MX, c1 < nf ? 1 : 0}; EpiFourier E{parts, (bf16_t*)(P.ws + O_CB)}; gemm_phase(lds, S, E, 2048, 2048, 2048); }
        { const int c2 = bid_opaque(); const int ng = nM * 8, two = 2 * (G - nf);
          int L0, dL, cn;
          if (G > nf && two <= ng) { if (c2 >= nf) { L0 = 2 * (c2 - nf); dL = 1; cn = 2; } else { L0 = two + c2; dL = nf; cn = (ng - two - c2 + nf - 1) / nf; if (cn < 0) cn = 0; } }
          else { L0 = c2; dL = G; cn = 1 << 20; }
          SchedGrid S{(const char*)(P.ws + O_GB), (const char*)(wl + LO_GLU), nM, 8, 1024, 1024, dL, L0, 0, MX, cn}; EpiGlu E{parts, (bf16_t*)(P.ws + O_BB)}; gemm_phase(lds, S, E, 1024, 1024, 1024); }
    } break;
    case 5: { if (l == 0) ctx_small_gemm<1>(P, shm);
        SchedMerge S{(const char*)(P.ws + O_AB), (const char*)(wl + LO_PA), nM, G, c, 0, MX};
        EpiMerge E{parts, (bf16_t*)(P.ws + O_HB)}; gemm_phase(lds, S, E, 1024, 1024, 1024); } break;
    case 6: { if (l == 0) ctx_small_gemm<2>(P, shm);
        SchedGrid S{(const char*)(P.ws + O_HB), (const char*)(wl + LO_WO), nM, 8, DM, DM, G, c, 0, MX, 1 << 20}; EpiStoreBf16 E{(bf16_t*)(P.ws + O_PARTS), DM}; gemm_phase(lds, S, E, DM, DM, DM); } break;
    default: phase_postnorm(P, l); break;
    }
}

#define XB_TMO      128
#define XB_XCNT(j)  (256  + 64 * (j))
#define XB_XSUB(j)  (1280 + 64 * (j))
#define XB_XGEN(j)  (2304 + 64 * (j))
#define XB_TOP      3328
#define XB_TOPGEN   3392
#define XCD_BAR_WORDS 3456
#define XB_SPIN_CAP (1u << 18)
__device__ __forceinline__ unsigned xb_ld(unsigned* p)              { return __hip_atomic_load(p, __ATOMIC_RELAXED, __HIP_MEMORY_SCOPE_AGENT); }
__device__ __forceinline__ unsigned xb_add(unsigned* p, unsigned v) { return __hip_atomic_fetch_add(p, v, __ATOMIC_RELAXED, __HIP_MEMORY_SCOPE_AGENT); }
__device__ __forceinline__ unsigned xb_xcc_id() { return (unsigned)__builtin_amdgcn_s_getreg((3 << 11) | 20) & 0xFu; }
#define XB_SPIN(cond, bar) do { unsigned _sp = 0; while (cond) { __builtin_amdgcn_s_sleep(1); \
    if ((++_sp & 255u) == 0u) { if (xb_ld(&(bar)[XB_TMO])) break; if (_sp > XB_SPIN_CAP) { atomicAdd(&(bar)[XB_TMO], 1u); break; } } } } while (0)
struct XcdBarrier { unsigned* bar; unsigned x; volatile LAS unsigned* st; };
__device__ __forceinline__ XcdBarrier xcd_barrier_post(unsigned* bar, volatile LAS unsigned* st) {
    XcdBarrier b; b.bar = bar; b.x = xb_xcc_id(); b.st = st;
    if (threadIdx.x == 0) (void)xb_add(&bar[XB_XCNT(b.x)], 1u);
    return b;
}
__device__ __forceinline__ void xcd_barrier_complete(unsigned* bar, unsigned x, unsigned& nloc, unsigned& nx) {
    const unsigned G = gridDim.x * gridDim.y * gridDim.z;
    unsigned sum, cnt, mine, sp = 0u;
    for (;;) {
        sum = 0u; cnt = 0u; mine = 0u;
#pragma unroll
        for (unsigned j = 0; j < 16; ++j) { const unsigned c = xb_ld(&bar[XB_XCNT(j)]); sum += c; cnt += (c > 0u) ? 1u : 0u; mine = (j == x) ? c : mine; }
        if (sum == G) break;
        __builtin_amdgcn_s_sleep(1);
        if ((++sp & 255u) == 0u) { if (xb_ld(&bar[XB_TMO])) break; if (sp > XB_SPIN_CAP) { atomicAdd(&bar[XB_TMO], 1u); break; } }
    }
    nloc = mine > 0u ? mine : 1u; nx = cnt > 0u ? cnt : 1u;
}
__device__ __forceinline__ void xcd_barrier(const XcdBarrier& b) {
    asm volatile("s_waitcnt vmcnt(0)" ::: "memory");
    __syncthreads();
    if (threadIdx.x == 0) {
        unsigned* bar = b.bar;
        __builtin_amdgcn_s_waitcnt(0);
        unsigned nloc = b.st[0], nx = b.st[1];
        if (nloc == 0u) { xcd_barrier_complete(bar, b.x, nloc, nx); b.st[0] = nloc; b.st[1] = nx; }
        const unsigned old = xb_add(&bar[XB_XSUB(b.x)], 1u);
        const unsigned gen = old / nloc;
        if (old + 1u == (gen + 1u) * nloc) {
            __builtin_amdgcn_fence(__ATOMIC_RELEASE, "agent");
            asm volatile("s_waitcnt vmcnt(0)" ::: "memory");
            const unsigned og = xb_add(&bar[XB_TOP], 1u);
            const unsigned tg = og / nx;
            if (og + 1u == (tg + 1u) * nx) xb_add(&bar[XB_TOPGEN], 1u);
            else XB_SPIN(xb_ld(&bar[XB_TOPGEN]) == tg, bar);
            __builtin_amdgcn_fence(__ATOMIC_ACQUIRE, "agent");
            xb_add(&bar[XB_XGEN(b.x)], 1u);
            asm volatile("s_waitcnt vmcnt(0)" ::: "memory");
        } else {
            XB_SPIN(xb_ld(&bar[XB_XGEN(b.x)]) == gen, bar);
            __builtin_amdgcn_fence(__ATOMIC_ACQUIRE, "agent");
            asm volatile("s_waitcnt vmcnt(0)" ::: "memory");
        }
    }
    __syncthreads();
}

constexpr int N_PHASES = 18;

__global__ void __launch_bounds__(512, 2) mega(Params P, int ph0, int ph1) {
    extern __shared__ __attribute__((aligned(16))) unsigned char shm[];
    __shared__ uint4 xb_words;
    if (threadIdx.x == 0) xb_words = make_uint4(0u, 0u, 0u, 0u);
    __syncthreads();
    const XcdBarrier xb = xcd_barrier_post((unsigned*)(P.ws + O_BAR), (volatile LAS unsigned*)&xb_words);
    const KPtr kp = (KPtr)__builtin_amdgcn_kernarg_segment_ptr();
#define RUN_PH(k) if (ph0 <= (k) && (k) < ph1) { if ((k) != ph0) xcd_barrier(xb); run_phase<(k)>(kp, shm); }
    RUN_PH(0) RUN_PH(1) RUN_PH(2) RUN_PH(3) RUN_PH(4) RUN_PH(6) RUN_PH(7) RUN_PH(8) RUN_PH(9)
    RUN_PH(10) RUN_PH(11) RUN_PH(12) RUN_PH(14) RUN_PH(15) RUN_PH(16) RUN_PH(17)
#undef RUN_PH
}

extern "C" void kernel_launch(void* const* d_in, const int* in_sizes, int n_in, void* d_out, int out_size, void* d_ws, size_t ws_size, hipStream_t stream) {
    static int grid_blocks = 0;
    if (!grid_blocks) {
        int dev = 0, cus = 0, per_cu = 0;
        hipGetDevice(&dev); hipDeviceGetAttribute(&cus, hipDeviceAttributeMultiprocessorCount, dev);
        hipFuncSetAttribute((const void*)mega, hipFuncAttributeMaxDynamicSharedMemorySize, STAGE_BYTES);
        hipOccupancyMaxActiveBlocksPerMultiprocessor(&per_cu, (const void*)mega, 512, STAGE_BYTES);
        if (per_cu < 1) { fprintf(stderr, "occupancy query says %d blocks/CU\n", per_cu); per_cu = 1; }
        grid_blocks = cus;
        if (ws_size < WS_END) { fprintf(stderr, "workspace too small: %zu < %zu\n", ws_size, (size_t)WS_END); grid_blocks = -1; }
    }
    if (grid_blocks < 0) return;
    if (hipMemsetAsync((char*)d_ws + O_BAR, 0, SZ_BAR, stream) != hipSuccess) { fprintf(stderr, "memset of barrier words failed\n"); return; }
    Params p{};
    const float** pp = (const float**)&p;
    for (int i = 0; i < 25; ++i) pp[i] = (const float*)d_in[i];
    p.out = (float*)d_out; p.ws = (unsigned char*)d_ws;
    int ph0 = 0, ph1 = N_PHASES;
    void* args[] = {&p, &ph0, &ph1};
    hipError_t e = hipLaunchCooperativeKernel((const void*)mega, dim3(grid_blocks), dim3(512), args, STAGE_BYTES, stream);
    if (e != hipSuccess) fprintf(stderr, "cooperative launch failed: %s (grid %d)\n", hipGetErrorString(e), grid_blocks);
}
```

```cpp
#include <hip/hip_runtime.h>
#include <hip/hip_cooperative_groups.h>
#include <cstdio>
namespace cg = cooperative_groups;

#define LAS __attribute__((address_space(3)))
typedef unsigned short bf16_t;
typedef short bf16x8 __attribute__((ext_vector_type(8)));
typedef float f32x4 __attribute__((ext_vector_type(4)));
typedef unsigned u32x4 __attribute__((ext_vector_type(4)));
typedef unsigned u32x2 __attribute__((ext_vector_type(2)));

constexpr int DM = 2048, NB = 2, SEQ = 4096, LCX = 256, MX = NB * SEQ, MCT = NB * LCX, MTOT = MX + MCT;
constexpr int INW = 14336;
constexpr int C_XA = 0, C_BA = 1024, C_CA = 2048, C_ZA = 3072, C_U = 4096, C_ZB = 5120, C_F = 6144, C_ZC = 7168, C_GL = 8192;
constexpr size_t E_PC = 0, E_PU = (size_t)8704 * 4096, E_PZB = E_PU + (size_t)8704 * 1024, E_PF = E_PZB + (size_t)8704 * 1024, E_PZC = E_PF + (size_t)8704 * 1024, E_PGL = E_PZC + (size_t)8704 * 1024;
constexpr int NCOL = 544;
constexpr float RMS_EPS = 1e-6f;

constexpr size_t AL(size_t x) { return (x + 255) & ~(size_t)255; }
constexpr size_t SZ_WIN = (size_t)INW * DM * 2, SZ_P = (size_t)DM * 1024 * 2, SZ_GLU = (size_t)2048 * 1024 * 2, SZ_FW = (size_t)1024 * 1024 * 2,
                 SZ_WP = (size_t)1024 * 2048 * 2, SZ_WO = (size_t)DM * DM * 2, SZ_M1 = (size_t)64 * 256 * 256 * 2, SZ_M2 = (size_t)64 * 256 * 512 * 2,
                 SZ_A16 = (size_t)2 * 64 * 64 * 2 * 4, SZ_MOD = (size_t)3 * 6144 * 4;
constexpr size_t LO_WIN = 0, LO_PA = LO_WIN + SZ_WIN, LO_PB = LO_PA + SZ_P, LO_PC = LO_PB + SZ_P, LO_GLU = LO_PC + SZ_P, LO_FW = LO_GLU + SZ_GLU,
                 LO_WP = LO_FW + SZ_FW, LO_WO = LO_WP + SZ_WP, LO_M1 = LO_WO + SZ_WO, LO_M2 = LO_M1 + SZ_M1, LO_A16 = LO_M2 + SZ_M2, LO_MOD = LO_A16 + SZ_A16,
                 SZ_LAYER = AL(LO_MOD + SZ_MOD);
constexpr size_t O_TAB = 2 * SZ_LAYER;
constexpr size_t T_CS = 0, T_D1 = T_CS + 512 * 256 * 2, T_D2 = T_D1 + 128 * 64 * 2, T_DCTX = T_D2 + 128 * 128 * 2, T_TW = T_DCTX + 512 * 256 * 2, SZ_TAB = AL(T_TW + 64 * 64 * 8);
constexpr size_t O_X1 = O_TAB + SZ_TAB, SZ_X1 = (size_t)MTOT * DM * 4;
constexpr size_t O_HB = O_X1 + SZ_X1, SZ_HB = (size_t)MTOT * DM * 2;
constexpr size_t O_PARTS = O_HB + SZ_HB, SZ_PARTS = (size_t)MTOT * INW * 2;
constexpr size_t O_AB = O_PARTS + SZ_PARTS, SZ_BR = (size_t)MTOT * 1024 * 2;
constexpr size_t O_BB = O_AB + SZ_BR, O_CB = O_BB + SZ_BR, O_GB = O_CB + SZ_BR;
constexpr size_t O_ZB = O_GB + SZ_BR, SZ_ZB = (size_t)2 * 64 * 128 * 1024 * 2;
constexpr size_t O_YB = O_ZB + SZ_ZB, SZ_YB = (size_t)MTOT * 2048 * 2;
constexpr size_t O_EB = O_YB + SZ_YB, SZ_EB = (size_t)64 * NCOL * 256 * 4;
constexpr size_t O_HS = O_EB + SZ_EB, SZ_HS = (size_t)64 * NCOL * 256 * 2;
constexpr size_t O_MP = O_ZB;
constexpr size_t O_BAR = O_HS + SZ_HS, SZ_BAR = 16384;
constexpr size_t WS_END = O_BAR + SZ_BAR;
static_assert(SZ_ZB + SZ_YB + SZ_EB >= (size_t)MTOT * DM * 4, "alias");
static_assert(SZ_PARTS >= (size_t)MTOT * DM * 4, "alias");

struct Params {
    const float *x, *c, *ctx, *c_ctx, *w_ada, *b_ada, *g_pre, *g_post, *w_in, *conv_w, *lam_re, *lam_im, *log_dt, *b_re, *b_im, *c_re, *c_im,
        *ssm_d, *glu_wa, *glu_wb, *fourier_w, *proj_a, *proj_b, *proj_c, *w_out;
    float* out; unsigned char* ws;
};
typedef const __attribute__((address_space(4))) Params* KPtr;
#define PREF const __attribute__((address_space(4))) Params&

__device__ __forceinline__ int tid_opaque() { int t = threadIdx.x; asm volatile("" : "+v"(t)); return t; }
__device__ __forceinline__ int bid_opaque() { int b = blockIdx.x; asm volatile("" : "+s"(b)); return b; }
__device__ __forceinline__ float bf2f(unsigned v) { return __uint_as_float(v << 16); }
__device__ __forceinline__ unsigned cvt_pk_bf16(float lo, float hi) { unsigned r; asm volatile("v_cvt_pk_bf16_f32 %0, %1, %2" : "=v"(r) : "v"(lo), "v"(hi)); return r; }
__device__ __forceinline__ float lo_f(unsigned u) { return __uint_as_float(u << 16); }
__device__ __forceinline__ float hi_f(unsigned u) { return __uint_as_float(u & 0xffff0000u); }
__device__ __forceinline__ float sigmoidf_(float x) { return __builtin_amdgcn_rcpf(1.0f + __expf(-x)); }
__device__ __forceinline__ float siluf_(float x) { return x * __builtin_amdgcn_rcpf(1.0f + __expf(-x)); }
__device__ __forceinline__ float gelu_tanh(float x) { const float z = 0.7978845608028654f * (x + 0.044715f * x * x * x); const float t = 1.0f - 2.0f * __builtin_amdgcn_rcpf(__expf(2.0f * z) + 1.0f); return 0.5f * x * (1.0f + t); }
__device__ __forceinline__ float wave_sum(float v, const int lane) {
#pragma unroll
    for (int o = 32; o; o >>= 1) v += __int_as_float(__builtin_amdgcn_ds_bpermute((lane ^ o) << 2, __float_as_int(v)));
    return v;
}
__device__ __forceinline__ void unpack8(const u32x4 u, float (&f)[8]) {
    f[0] = lo_f(u[0]); f[1] = hi_f(u[0]); f[2] = lo_f(u[1]); f[3] = hi_f(u[1]); f[4] = lo_f(u[2]); f[5] = hi_f(u[2]); f[6] = lo_f(u[3]); f[7] = hi_f(u[3]);
}
__device__ __forceinline__ u32x4 pack8(const float (&f)[8]) { u32x4 r; r[0] = cvt_pk_bf16(f[0], f[1]); r[1] = cvt_pk_bf16(f[2], f[3]); r[2] = cvt_pk_bf16(f[4], f[5]); r[3] = cvt_pk_bf16(f[6], f[7]); return r; }

constexpr int BM = 256, BK = 64, HALF = 128, HTB = HALF * BK * 2, STAGE_BYTES = 8 * HTB;
__device__ __forceinline__ int lds_byte(int r, int c) { const int st = (r >> 4) * 2 + (c >> 5), rr = r & 15, cc = c & 31, ob = rr * 64 + cc * 2; return st * 1024 + (ob ^ (((ob >> 9) & 1) << 5)); }
__device__ __forceinline__ void stage_rc(int b, int& R, int& C) { const int st = b / 1024, sb = b % 1024, swz = sb ^ (((sb >> 9) & 1) << 5); R = (st >> 1) * 16 + swz / 64; C = (st & 1) * 32 + (swz % 64) / 2; }
__device__ __forceinline__ int perm32(int rho) { const int n = rho >> 4, i = rho & 15; return 8 * (i >> 2) + 4 * n + (i & 3); }

struct Unit { const char* A; const char* B; int row0, pn, z, half; };

__device__ __forceinline__ void tile_of(int L, int nM, int nN, int& pm, int& pn) {
    const int nwg = nM * nN; int wgid = L;
    { const int q = nwg / 8, r = nwg % 8, xcd = wgid % 8, off = wgid / 8; wgid = (xcd < r ? xcd * (q + 1) : r * (q + 1) + (xcd - r) * q) + off; }
    const int nig = 8 * nN, gid = wgid / nig, fm = gid * 8, gsz = (nM - fm) < 8 ? (nM - fm) : 8;
    pm = fm + ((wgid % nig) % gsz); pn = (wgid % nig) / gsz;
}

template <class Sched, class Epi>
__device__ __forceinline__ void gemm_phase(LAS unsigned char* lds, const Sched& S, const Epi& E, const int K, const int lda, const int ldb) {
    const int tid = tid_opaque(), wid = __builtin_amdgcn_readfirstlane(tid >> 6), lane = tid & 63, wr = wid >> 2, wc = wid & 3, fr = lane & 15, fq = lane >> 4;
    const int nt = K / BK;
    unsigned voffA[2], voffB[2];
#pragma unroll
    for (int i = 0; i < 2; ++i) { int R, C; stage_rc(tid * 16 + i * 8192, R, C); const int Rb = (R & ~31) + perm32(R & 31);
        voffA[i] = (unsigned)(R * lda + C) * 2u; voffB[i] = (unsigned)(Rb * ldb + C) * 2u; }
    const size_t kstep = (size_t)(BK * 2);
    const size_t hstepA = (size_t)HALF * lda * 2, hstepB = (size_t)HALF * ldb * 2;
    const unsigned ldsw = (unsigned)wid * 1024u;
    const int aoff = lds_byte(wr * 64 + fr, fq * 8), boff = lds_byte(wc * 32 + fr, fq * 8);
#define PG8_SA(b, h) (((b) * 2 + (h)) * HTB)
#define PG8_SB(b, h) ((4 + (b) * 2 + (h)) * HTB)
#define PG8_STAGE(bufoff, gbase, voff) do { _Pragma("unroll") for (int _i = 0; _i < 2; ++_i) \
        __builtin_amdgcn_global_load_lds((const unsigned*)((const char*)(gbase) + (voff)[_i]), (LAS unsigned*)(lds + (bufoff) + ldsw + _i * 8192), 16, 0, 0); } while (0)
#define PG8_LDA(dst, b, h) do { _Pragma("unroll") for (int m = 0; m < 4; ++m) _Pragma("unroll") for (int k = 0; k < 2; ++k) dst[m][k] = *(const LAS bf16x8*)(lds + PG8_SA(b, h) + aoff + m * 2048 + k * 1024); } while (0)
#define PG8_LDB(dst, b, h) do { _Pragma("unroll") for (int n = 0; n < 2; ++n) _Pragma("unroll") for (int k = 0; k < 2; ++k) dst[n][k] = *(const LAS bf16x8*)(lds + PG8_SB(b, h) + boff + n * 2048 + k * 1024); } while (0)
#define PG8_MMA(ai, bj, At, Bt) do { __builtin_amdgcn_s_setprio(1); _Pragma("unroll") for (int m = 0; m < 4; ++m) _Pragma("unroll") for (int n = 0; n < 2; ++n) _Pragma("unroll") for (int k = 0; k < 2; ++k) \
        acc[ai][bj][m][n] = __builtin_amdgcn_mfma_f32_16x16x32_bf16(Bt[n][k], At[m][k], acc[ai][bj][m][n], 0, 0, 0); __builtin_amdgcn_s_setprio(0); } while (0)
#define PG8_WAIT_V(n) asm volatile("s_waitcnt vmcnt(" #n ")" ::: "memory")
#define PG8_WAIT_L(n) asm volatile("s_waitcnt lgkmcnt(" #n ")" ::: "memory")
#define PG8_BAR __builtin_amdgcn_s_barrier()
#define PG8_SCHED __builtin_amdgcn_sched_barrier(0)
    Unit cur, nxt; int ui = 0;
    if (!S.next(0, cur)) return;
    f32x4 acc[2][2][4][2];
#pragma unroll
    for (int a = 0; a < 2; ++a)
#pragma unroll
        for (int b = 0; b < 2; ++b)
#pragma unroll
            for (int m = 0; m < 4; ++m)
#pragma unroll
                for (int n = 0; n < 2; ++n) acc[a][b][m][n] = (f32x4){0.f, 0.f, 0.f, 0.f};
    bf16x8 At[4][2], B0[2][2], B1[2][2];
    const char* cA = cur.A; const char* cB = cur.B;
    PG8_STAGE(PG8_SB(0, 0), cB, voffB); PG8_STAGE(PG8_SA(0, 0), cA, voffA); PG8_STAGE(PG8_SB(0, 1), cB + hstepB, voffB); PG8_STAGE(PG8_SA(0, 1), cA + hstepA, voffA);
    if (wr == 1) PG8_BAR;
    PG8_WAIT_V(4); PG8_BAR;
    PG8_STAGE(PG8_SB(1, 0), cB + kstep, voffB); PG8_STAGE(PG8_SA(1, 0), cA + kstep, voffA); PG8_STAGE(PG8_SB(1, 1), cB + hstepB + kstep, voffB);
    PG8_WAIT_V(6); PG8_BAR;
    for (;;) {
        const bool has_next = S.next(ui + 1, nxt);
        const char* nA = has_next ? nxt.A : cA; const char* nB = has_next ? nxt.B : cB;
        const bool chalf = cur.half != 0;
        for (int t = 0; t < nt; t += 2) {
            const bool last = (t == nt - 2);
            const char* a1 = cA + (size_t)(t + 1) * kstep;
            const char* a2 = last ? nA : cA + (size_t)(t + 2) * kstep; const char* b2 = last ? nB : cB + (size_t)(t + 2) * kstep;
            const char* a3 = a2 + kstep; const char* b3 = b2 + kstep;
            PG8_LDB(B0, 0, 0); PG8_SCHED; PG8_LDA(At, 0, 0); PG8_STAGE(PG8_SA(1, 1), a1 + hstepA, voffA);
            PG8_WAIT_L(8); PG8_BAR; PG8_WAIT_L(0); PG8_MMA(0, 0, At, B0); PG8_BAR; PG8_SCHED;
            PG8_LDB(B1, 0, 1); PG8_STAGE(PG8_SB(0, 0), b2, voffB);
            PG8_BAR; PG8_WAIT_L(0); PG8_MMA(0, 1, At, B1); PG8_BAR;
            PG8_LDA(At, 0, 1); PG8_STAGE(PG8_SA(0, 0), a2, voffA);
            PG8_BAR; PG8_WAIT_L(0); if (!chalf) PG8_MMA(1, 0, At, B0); PG8_BAR; PG8_SCHED;
            PG8_STAGE(PG8_SB(0, 1), b2 + hstepB, voffB);
            PG8_WAIT_V(6); PG8_BAR; if (!chalf) PG8_MMA(1, 1, At, B1); PG8_BAR;
            PG8_LDB(B0, 1, 0); PG8_SCHED; PG8_LDA(At, 1, 0); PG8_STAGE(PG8_SA(0, 1), a2 + hstepA, voffA);
            PG8_WAIT_L(8); PG8_BAR; PG8_WAIT_L(0); PG8_MMA(0, 0, At, B0); PG8_BAR; PG8_SCHED;
            PG8_LDB(B1, 1, 1); PG8_STAGE(PG8_SB(1, 0), b3, voffB);
            PG8_BAR; PG8_WAIT_L(0); PG8_MMA(0, 1, At, B1); PG8_BAR;
            PG8_LDA(At, 1, 1); PG8_STAGE(PG8_SA(1, 0), a3, voffA);
            PG8_BAR; PG8_WAIT_L(0); if (!chalf) PG8_MMA(1, 0, At, B0); PG8_BAR; PG8_SCHED;
            PG8_STAGE(PG8_SB(1, 1), b3 + hstepB, voffB);
            PG8_WAIT_V(6); PG8_BAR; if (!chalf) PG8_MMA(1, 1, At, B1); PG8_BAR;
        }
        E(acc, cur, wr, wc, fr, fq);
        if (!has_next) break;
#pragma unroll
        for (int a = 0; a < 2; ++a)
#pragma unroll
            for (int b = 0; b < 2; ++b)
#pragma unroll
                for (int m = 0; m < 4; ++m)
#pragma unroll
                    for (int n = 0; n < 2; ++n) acc[a][b][m][n] = (f32x4){0.f, 0.f, 0.f, 0.f};
        cur = nxt; cA = nA; cB = nB; ++ui;
    }
    PG8_WAIT_V(0);
    if (wr == 0) PG8_BAR;
    PG8_BAR;
#undef PG8_SA
#undef PG8_SB
#undef PG8_STAGE
#undef PG8_LDA
#undef PG8_LDB
#undef PG8_MMA
#undef PG8_WAIT_V
#undef PG8_WAIT_L
#undef PG8_BAR
#undef PG8_SCHED
}

typedef f32x4 AccT[2][2][4][2];
#define EPI_ARGS const AccT& acc, const Unit& u, int wr, int wc, int fr, int fq
#define EPI_FOR_ROWS _Pragma("unroll") for (int ai = 0; ai < 2; ++ai) if (ai == 0 || !u.half) _Pragma("unroll") for (int m = 0; m < 4; ++m)
#define EPI_ROW (u.row0 + wr * 64 + fr + ai * 128 + m * 16)
#define EPI_COL(bj) (u.pn * 256 + wc * 32 + 8 * fq + (bj) * 128)

struct SchedGrid {
    const char* A; const char* B; int nM, nN, lda, ldb, G, c, nh, hrow0, cnt;
    __device__ __forceinline__ bool next(int i, Unit& u) const {
        const long L = (long)i * G + c; const int nfull = nM * nN; if (i >= cnt || L >= (long)nfull + nh * nN) return false;
        int pm;
        if (L < nfull) { tile_of((int)L, nM, nN, pm, u.pn); u.row0 = pm * 256; u.half = 0; }
        else { const int e = (int)L - nfull; u.pn = e % nN; u.row0 = hrow0 + (e / nN) * 128; u.half = 1; }
        u.z = 0; u.A = A + (size_t)u.row0 * lda * 2; u.B = B + (size_t)u.pn * 256 * ldb * 2; return true;
    }
};
struct SchedMerge {
    const char* A0; const char* B0; int nM, G, c, nh, hrow0;
    __device__ __forceinline__ bool next(int i, Unit& u) const {
        const int j = i / 3, br = i - 3 * j; const long L = (long)j * G + c; const int nfull = nM * 8; if (L >= (long)nfull + nh * 8) return false;
        int pm;
        if (L < nfull) { tile_of((int)L, nM, 8, pm, u.pn); u.row0 = pm * 256; u.half = 0; }
        else { const int e = (int)L - nfull; u.pn = e & 7; u.row0 = hrow0 + (e >> 3) * 128; u.half = 1; }
        u.z = br;
        u.A = A0 + (size_t)br * SZ_BR + (size_t)u.row0 * 1024 * 2; u.B = B0 + (size_t)br * SZ_P + (size_t)u.pn * 256 * 1024 * 2; return true;
    }
};
struct SchedWp {
    const unsigned char* ws; int G, c;
    __device__ __forceinline__ bool next(int i, Unit& u) const {
        const long L = (long)i * G + c; if (L >= 64) return false;
        const int l = (int)L >> 5, grp = ((int)L >> 3) & 3, pm = ((int)L >> 1) & 3; u.row0 = pm * 256; u.half = 0; u.pn = (int)L & 1; u.z = l * 4 + grp;
        u.A = (const char*)ws + l * SZ_LAYER + LO_FW + ((size_t)pm * 256 * 1024 + grp * 256) * 2;
        u.B = (const char*)ws + O_TAB + T_CS + (size_t)u.pn * 256 * 256 * 2; return true;
    }
};

struct EpiStoreBf16 { bf16_t* O; int ldc;
    __device__ __forceinline__ void operator()(EPI_ARGS) const {
        EPI_FOR_ROWS { bf16_t* rp = O + (size_t)EPI_ROW * ldc;
#pragma unroll
            for (int bj = 0; bj < 2; ++bj) { const f32x4 v0 = acc[ai][bj][m][0], v1 = acc[ai][bj][m][1]; u32x4 o;
                o[0] = cvt_pk_bf16(v0[0], v0[1]); o[1] = cvt_pk_bf16(v0[2], v0[3]); o[2] = cvt_pk_bf16(v1[0], v1[1]); o[3] = cvt_pk_bf16(v1[2], v1[3]);
                *(u32x4*)(rp + EPI_COL(bj)) = o; } }
    }
};
struct EpiParts { bf16_t* O;
    __device__ __forceinline__ void operator()(EPI_ARGS) const {
        const int c0 = u.pn * 256; size_t eb; int pitch, cl;
        if (c0 < C_U) { eb = E_PC; pitch = 4096; cl = c0; } else if (c0 < C_ZB) { eb = E_PU; pitch = 1024; cl = c0 - C_U; } else if (c0 < C_F) { eb = E_PZB; pitch = 1024; cl = c0 - C_ZB; }
        else if (c0 < C_ZC) { eb = E_PF; pitch = 1024; cl = c0 - C_F; } else if (c0 < C_GL) { eb = E_PZC; pitch = 1024; cl = c0 - C_ZC; } else { eb = E_PGL; pitch = 6144; cl = c0 - C_GL; }
        bf16_t* base = O + eb + cl + wc * 32 + 8 * fq;
        EPI_FOR_ROWS { bf16_t* rp = base + (size_t)EPI_ROW * pitch;
#pragma unroll
            for (int bj = 0; bj < 2; ++bj) { const f32x4 v0 = acc[ai][bj][m][0], v1 = acc[ai][bj][m][1]; u32x4 o;
                o[0] = cvt_pk_bf16(v0[0], v0[1]); o[1] = cvt_pk_bf16(v0[2], v0[3]); o[2] = cvt_pk_bf16(v1[0], v1[1]); o[3] = cvt_pk_bf16(v1[2], v1[3]);
                *(u32x4*)(rp + bj * 128) = o; } }
    }
};
struct EpiStoreF32 { float* O; int ldc;
    __device__ __forceinline__ void operator()(EPI_ARGS) const {
        EPI_FOR_ROWS { float* rp = O + (size_t)EPI_ROW * ldc;
#pragma unroll
            for (int bj = 0; bj < 2; ++bj) { *(f32x4*)(rp + EPI_COL(bj)) = acc[ai][bj][m][0]; *(f32x4*)(rp + EPI_COL(bj) + 4) = acc[ai][bj][m][1]; } }
    }
};
struct EpiWp { unsigned char* ws;
    __device__ __forceinline__ void operator()(EPI_ARGS) const {
        const int l = u.z >> 2, grp = u.z & 3; bf16_t* O = (bf16_t*)(ws + l * SZ_LAYER + LO_WP);
        EPI_FOR_ROWS { bf16_t* rp = O + (size_t)EPI_ROW * 2048 + u.pn * 1024 + grp * 256;
#pragma unroll
            for (int bj = 0; bj < 2; ++bj) { const f32x4 v0 = acc[ai][bj][m][0], v1 = acc[ai][bj][m][1]; u32x4 o;
                o[0] = cvt_pk_bf16(v0[0], v0[1]); o[1] = cvt_pk_bf16(v0[2], v0[3]); o[2] = cvt_pk_bf16(v1[0], v1[1]); o[3] = cvt_pk_bf16(v1[2], v1[3]);
                *(u32x4*)(rp + wc * 32 + 8 * fq + bj * 128) = o; } }
    }
};
struct EpiFourier { const bf16_t* parts; bf16_t* O;
    __device__ __forceinline__ void operator()(EPI_ARGS) const {
#pragma unroll
        for (int ai = 0; ai < 2; ++ai) if (ai == 0 || !u.half) { u32x4 zz[4][2];
#pragma unroll
            for (int m = 0; m < 4; ++m)
#pragma unroll
                for (int bj = 0; bj < 2; ++bj) zz[m][bj] = *(const u32x4*)(parts + E_PZC + (size_t)EPI_ROW * 1024 + EPI_COL(bj));
#pragma unroll
            for (int m = 0; m < 4; ++m)
#pragma unroll
                for (int bj = 0; bj < 2; ++bj) { const f32x4 v0 = acc[ai][bj][m][0], v1 = acc[ai][bj][m][1]; float z[8]; unpack8(zz[m][bj], z); float o[8];
#pragma unroll
                    for (int j = 0; j < 4; ++j) { o[j] = v0[j] * siluf_(z[j]); o[4 + j] = v1[j] * siluf_(z[4 + j]); }
                    *(u32x4*)(O + (size_t)EPI_ROW * 1024 + EPI_COL(bj)) = pack8(o); } }
    }
};
struct EpiGlu { const bf16_t* parts; bf16_t* O;
    __device__ __forceinline__ void operator()(EPI_ARGS) const {
        const int col = u.pn * 128 + wc * 32 + 8 * fq;
#pragma unroll
        for (int ai = 0; ai < 2; ++ai) if (ai == 0 || !u.half) { u32x4 zz[4];
#pragma unroll
            for (int m = 0; m < 4; ++m) zz[m] = *(const u32x4*)(parts + E_PZB + (size_t)EPI_ROW * 1024 + col);
#pragma unroll
            for (int m = 0; m < 4; ++m) { float z[8]; unpack8(zz[m], z);
                const f32x4 a0 = acc[ai][0][m][0], a1 = acc[ai][0][m][1], b0 = acc[ai][1][m][0], b1 = acc[ai][1][m][1]; float o[8];
#pragma unroll
                for (int j = 0; j < 4; ++j) { o[j] = a0[j] * sigmoidf_(b0[j]) * siluf_(z[j]); o[4 + j] = a1[j] * sigmoidf_(b1[j]) * siluf_(z[4 + j]); }
                *(u32x4*)(O + (size_t)EPI_ROW * 1024 + col) = pack8(o); } }
    }
};
struct EpiMerge { const bf16_t* parts; bf16_t* MB;
    __device__ __forceinline__ void operator()(EPI_ARGS) const {
        const int br = u.z; const int nb = u.half ? 2 : 4;
        u32x4 gg[2][4], pp[2][4];
#define MRG_LOAD(slot, bidx_) { const int ai = (bidx_) >> 1, bj = (bidx_) & 1; _Pragma("unroll") for (int m = 0; m < 4; ++m) { \
            gg[slot][m] = *(const u32x4*)(parts + E_PGL + (size_t)EPI_ROW * 6144 + br * DM + EPI_COL(bj)); \
            pp[slot][m] = br > 0 ? *(const u32x4*)(MB + (size_t)EPI_ROW * DM + EPI_COL(bj)) : (u32x4){0u, 0u, 0u, 0u}; } }
#define MRG_EMIT(slot, bidx_) { const int ai = (bidx_) >> 1, bj = (bidx_) & 1; _Pragma("unroll") for (int m = 0; m < 4; ++m) { \
            const f32x4 v0 = acc[ai][bj][m][0], v1 = acc[ai][bj][m][1]; float g[8], pv[8], o[8]; unpack8(gg[slot][m], g); unpack8(pp[slot][m], pv); \
            _Pragma("unroll") for (int j = 0; j < 4; ++j) { o[j] = v0[j] * sigmoidf_(g[j]) + pv[j]; o[4 + j] = v1[j] * sigmoidf_(g[4 + j]) + pv[4 + j]; } \
            *(u32x4*)(MB + (size_t)EPI_ROW * DM + EPI_COL(bj)) = pack8(o); } }
        MRG_LOAD(0, 0)
        MRG_LOAD(1, 1)
        MRG_EMIT(0, 0)
        if (nb > 2) MRG_LOAD(0, 2)
        MRG_EMIT(1, 1)
        if (nb > 2) { MRG_LOAD(1, 3) MRG_EMIT(0, 2) MRG_EMIT(1, 3) }
#undef MRG_LOAD
#undef MRG_EMIT
    }
};

template <int MTL, int NT, class BL>
__device__ __forceinline__ void lmul_core(const bf16_t* __restrict__ D, const int ldd, const int ksteps, const BL& bl, f32x4 (&acc)[MTL][NT], const int lane) {
    const int r = lane & 15, q = lane >> 4;
    const bf16_t* dp = D + (size_t)r * ldd + q * 8;
#pragma unroll
    for (int a = 0; a < MTL; ++a)
#pragma unroll
        for (int b = 0; b < NT; ++b) acc[a][b] = (f32x4){0.f, 0.f, 0.f, 0.f};
#pragma unroll 1
    for (int ks = 0; ks < ksteps; ++ks) {
        bf16x8 bf[NT];
#pragma unroll
        for (int b = 0; b < NT; ++b) bf[b] = bl(ks, b);
#pragma unroll
        for (int a = 0; a < MTL; ++a) { const bf16x8 af = *(const bf16x8*)(dp + (size_t)a * 16 * ldd + ks * 32);
#pragma unroll
            for (int b = 0; b < NT; ++b) acc[a][b] = __builtin_amdgcn_mfma_f32_16x16x32_bf16(af, bf[b], acc[a][b], 0, 0, 0); }
    }
}
template <int MTL>
__device__ __forceinline__ void lmul_g4(const bf16_t* __restrict__ D, const int ldd, const int ksteps, const bf16_t* __restrict__ base, const size_t rs, f32x4 (&acc)[MTL][4], const int lane) {
    const int r = lane & 15, q = lane >> 4;
    const bf16_t* dp = D + (size_t)r * ldd + q * 8;
#pragma unroll
    for (int a = 0; a < MTL; ++a)
#pragma unroll
        for (int b = 0; b < 4; ++b) acc[a][b] = (f32x4){0.f, 0.f, 0.f, 0.f};
    u32x2 w[8];
    { const bf16_t* p = base + (size_t)(q * 8) * rs;
#pragma unroll
      for (int j = 0; j < 8; ++j) w[j] = *(const u32x2*)(p + (size_t)j * rs); }
#pragma unroll 1
    for (int ks = 0; ks < ksteps; ++ks) {
        u32x2 wn[8];
        if (ks + 1 < ksteps) { const bf16_t* p = base + (size_t)((ks + 1) * 32 + q * 8) * rs;
#pragma unroll
            for (int j = 0; j < 8; ++j) wn[j] = *(const u32x2*)(p + (size_t)j * rs); }
        else {
#pragma unroll
            for (int j = 0; j < 8; ++j) wn[j] = w[j]; }
        union { bf16x8 v; unsigned d[4]; } f0, f1, f2, f3;
#pragma unroll
        for (int d = 0; d < 4; ++d) { const unsigned a0 = w[2 * d][0], a1 = w[2 * d + 1][0], c0 = w[2 * d][1], c1 = w[2 * d + 1][1];
            f0.d[d] = (a0 & 0xffffu) | (a1 << 16); f1.d[d] = (a0 >> 16) | (a1 & 0xffff0000u); f2.d[d] = (c0 & 0xffffu) | (c1 << 16); f3.d[d] = (c0 >> 16) | (c1 & 0xffff0000u); }
#pragma unroll
        for (int a = 0; a < MTL; ++a) { const bf16x8 af = *(const bf16x8*)(dp + (size_t)a * 16 * ldd + ks * 32);
            acc[a][0] = __builtin_amdgcn_mfma_f32_16x16x32_bf16(af, f0.v, acc[a][0], 0, 0, 0); acc[a][1] = __builtin_amdgcn_mfma_f32_16x16x32_bf16(af, f1.v, acc[a][1], 0, 0, 0);
            acc[a][2] = __builtin_amdgcn_mfma_f32_16x16x32_bf16(af, f2.v, acc[a][2], 0, 0, 0); acc[a][3] = __builtin_amdgcn_mfma_f32_16x16x32_bf16(af, f3.v, acc[a][3], 0, 0, 0); }
#pragma unroll
        for (int j = 0; j < 8; ++j) w[j] = wn[j];
    }
}
struct BLGather { const bf16_t* base; size_t rs; int lane;
    __device__ __forceinline__ bf16x8 operator()(int ks, int b) const {
        const int q = lane >> 4; const bf16_t* p = base + (size_t)(ks * 32 + q * 8) * rs + b * 16; bf16x8 v;
#pragma unroll
        for (int j = 0; j < 8; ++j) v[j] = (short)p[(size_t)j * rs];
        return v; }
};
__device__ __forceinline__ int ssm_row(int col, int s) { return col < 512 ? ((col >> 8) * SEQ + (col & 255) * 16 + s) : (MX + ((col - 512) >> 4) * LCX + ((col - 512) & 15) * 16 + s); }
template <int KW, bool YST>
__device__ __forceinline__ void ssm_stage_lds(PREF P, const int l, const int wi, unsigned char* shm, const int tid) {
    const int lane = tid & 63, wv = tid >> 6, r = lane & 15, q = lane >> 4;
    const int g = wi >> 2, mh = (wi >> 1) & 1, half = wi & 1;
    unsigned char* wl = P.ws + l * SZ_LAYER; const bf16_t* parts = (const bf16_t*)(P.ws + O_PARTS);
    const bf16_t* D = (const bf16_t*)(wl + (YST ? LO_M2 : LO_M1)) + ((size_t)g * 256 + mh * 128) * KW;
    LAS unsigned char* lds = (LAS unsigned char*)shm;
    constexpr int CPR = KW / 8, KS = KW / 32;
    for (int ch = tid; ch < 128 * CPR; ch += 512) { const int row = ch / CPR, c = ch % CPR; const u32x4 v = *(const u32x4*)(D + (size_t)row * KW + c * 8);
        *(LAS u32x4*)(lds + row * (KW * 2) + ((c ^ (row & 15)) << 4)) = v; }
    __syncthreads();
    const int nct = (YST && l == 1) ? 16 : 17, hsplit = (nct + 1) / 2;
    const int t0 = half == 0 ? 0 : hsplit, t1 = half == 0 ? hsplit : nct;
    const bf16_t* HS = (const bf16_t*)(P.ws + O_HS);
    for (int ct = t0 + wv; ct < t1; ct += 8) {
        f32x4 acc[8][2];
#pragma unroll
        for (int a = 0; a < 8; ++a) { acc[a][0] = (f32x4){0.f, 0.f, 0.f, 0.f}; acc[a][1] = (f32x4){0.f, 0.f, 0.f, 0.f}; }
        const int colA = ct * 32 + r, colB = colA + 16;
        const bf16_t* pu0 = parts + E_PU + (size_t)(ssm_row(colA, 0) + (q >> 1)) * 1024 + g * 16 + (q & 1) * 8;
        const bf16_t* pu1 = parts + E_PU + (size_t)(ssm_row(colB, 0) + (q >> 1)) * 1024 + g * 16 + (q & 1) * 8;
        const bf16_t* ph0 = HS + ((size_t)g * NCOL + colA) * 256 + q * 8; const bf16_t* ph1 = HS + ((size_t)g * NCOL + colB) * 256 + q * 8;
#pragma unroll
        for (int kh = 0; kh < KS / 8; ++kh) {
            bf16x8 bq[8][2];
#pragma unroll
            for (int k8 = 0; k8 < 8; ++k8) {
                if (kh == 0) { bq[k8][0] = *(const bf16x8*)(pu0 + (size_t)k8 * 2 * 1024); bq[k8][1] = *(const bf16x8*)(pu1 + (size_t)k8 * 2 * 1024); }
                else { bq[k8][0] = *(const bf16x8*)(ph0 + k8 * 32); bq[k8][1] = *(const bf16x8*)(ph1 + k8 * 32); } }
#pragma unroll
            for (int k8 = 0; k8 < 8; ++k8) { const int ks = kh * 8 + k8;
                __builtin_amdgcn_sched_barrier(0);
#pragma unroll
                for (int a = 0; a < 8; ++a) { const bf16x8 af = *(const LAS bf16x8*)(lds + (a * 16 + r) * (KW * 2) + (((ks * 4 + q) ^ r) << 4));
                    acc[a][0] = __builtin_amdgcn_mfma_f32_16x16x32_bf16(af, bq[k8][0], acc[a][0], 0, 0, 0); acc[a][1] = __builtin_amdgcn_mfma_f32_16x16x32_bf16(af, bq[k8][1], acc[a][1], 0, 0, 0); }
            }
            __builtin_amdgcn_sched_barrier(0);
        }
        if (!YST) { float* EB = (float*)(P.ws + O_EB);
#pragma unroll
            for (int a = 0; a < 8; ++a)
#pragma unroll
                for (int b = 0; b < 2; ++b) { const int col = ct * 32 + b * 16 + r; *(f32x4*)(EB + ((size_t)g * NCOL + col) * 256 + mh * 128 + a * 16 + q * 4) = acc[a][b]; }
        } else { bf16_t* GB = (bf16_t*)(P.ws + O_GB); const f32x4 dv = *(const f32x4*)(P.ssm_d + l * 1024 + g * 16 + q * 4);
#pragma unroll
            for (int a = 0; a < 8; ++a)
#pragma unroll
                for (int b = 0; b < 2; ++b) { const int col = ct * 32 + b * 16 + r, t = mh * 8 + a, row = ssm_row(col, t);
                    const u32x2 uu = *(const u32x2*)(parts + E_PU + (size_t)row * 1024 + g * 16 + q * 4);
                    const float y0 = gelu_tanh(acc[a][b][0] + dv[0] * lo_f(uu[0])), y1 = gelu_tanh(acc[a][b][1] + dv[1] * hi_f(uu[0])), y2 = gelu_tanh(acc[a][b][2] + dv[2] * lo_f(uu[1])), y3 = gelu_tanh(acc[a][b][3] + dv[3] * hi_f(uu[1]));
                    u32x2 o; o[0] = cvt_pk_bf16(y0, y1); o[1] = cvt_pk_bf16(y2, y3); *(u32x2*)(GB + (size_t)row * 1024 + g * 16 + q * 4) = o; }
        }
    }
    __syncthreads();
}


template <int MODE>
__device__ __forceinline__ void ctx_small_gemm(PREF P, unsigned char* shm) {
    constexpr int K = MODE >= 2 ? 2048 : 1024, ROWS = MODE >= 2 ? 32 : 64, CPR = K / 8, KS = K / 32, NBR = MODE == 1 ? 3 : 1;
    const int tid = tid_opaque(), bidx = bid_opaque(), lane = tid & 63, w = tid >> 6, r = lane & 15, q = lane >> 4;
    unsigned char* wl = P.ws; const bf16_t* parts = (const bf16_t*)(P.ws + O_PARTS); LAS unsigned char* lds = (LAS unsigned char*)shm;
    for (int it = bidx; it < 256; it += gridDim.x) {
        const int rb = MODE >= 2 ? (it >> 4) : (it >> 5), cb = MODE >= 2 ? (it & 15) : (it & 31);
        const int row_base = MX + rb * ROWS;
        const int rt0 = MODE == 0 ? (w >> 1) : (MODE == 1 ? 2 * (w >> 2) : (MODE == 2 ? 0 : (w >> 2))), rt1 = (MODE == 0 || MODE == 3) ? rt0 : rt0 + 1;
        const int col0 = MODE == 0 ? cb * 32 + (w & 1) * 16 : (MODE == 1 ? cb * 64 + (w & 3) * 16 : (MODE == 2 ? cb * 128 + w * 16 : cb * 64 + (w & 3) * 16));
        float msum[2][4];
#pragma unroll
        for (int t = 0; t < 2; ++t)
#pragma unroll
            for (int i = 0; i < 4; ++i) msum[t][i] = 0.f;
#pragma unroll 1
        for (int br = 0; br < NBR; ++br) {
            const bf16_t* Asrc = MODE == 0 ? (const bf16_t*)(P.ws + O_GB) : (MODE == 1 ? (const bf16_t*)(P.ws + O_AB + (size_t)br * SZ_BR) : (MODE == 2 ? (const bf16_t*)(P.ws + O_HB) : (const bf16_t*)(P.ws + O_YB)));
            for (int ch = tid; ch < ROWS * CPR; ch += 512) { const int row = ch / CPR, c = ch % CPR; const u32x4 v = *(const u32x4*)(Asrc + (size_t)(row_base + row) * K + c * 8);
                *(LAS u32x4*)(lds + row * (K * 2) + ((c ^ (row & 15)) << 4)) = v; }
            __syncthreads();
            const bf16_t* W0; const bf16_t* W1;
            if (MODE == 0) { const int oc = col0 + r; W0 = (const bf16_t*)(wl + LO_GLU) + (size_t)((oc >> 7) * 256 + (oc & 127)) * K + q * 8; W1 = W0 + (size_t)128 * K; }
            else if (MODE == 1) { W0 = (const bf16_t*)(wl + LO_PA + (size_t)br * SZ_P) + (size_t)(col0 + r) * K + q * 8; W1 = W0; }
            else if (MODE == 2) { W0 = (const bf16_t*)(wl + LO_WO) + (size_t)(col0 + r) * K + q * 8; W1 = W0; }
            else { W0 = (const bf16_t*)(wl + LO_WP) + (size_t)(col0 + r) * K + q * 8; W1 = W0; }
            f32x4 acc0 = (f32x4){0.f, 0.f, 0.f, 0.f}, acc1 = (f32x4){0.f, 0.f, 0.f, 0.f};
#pragma unroll 4
            for (int ks = 0; ks < KS; ++ks) {
                const bf16x8 a0 = *(const LAS bf16x8*)(lds + (rt0 * 16 + r) * (K * 2) + (((ks * 4 + q) ^ r) << 4));
                const bf16x8 b0 = *(const bf16x8*)(W0 + ks * 32);
                if (MODE == 0) { const bf16x8 b1 = *(const bf16x8*)(W1 + ks * 32);
                    acc0 = __builtin_amdgcn_mfma_f32_16x16x32_bf16(a0, b0, acc0, 0, 0, 0); acc1 = __builtin_amdgcn_mfma_f32_16x16x32_bf16(a0, b1, acc1, 0, 0, 0); }
                else if (MODE == 3) { acc0 = __builtin_amdgcn_mfma_f32_16x16x32_bf16(a0, b0, acc0, 0, 0, 0); }
                else { const bf16x8 a1 = *(const LAS bf16x8*)(lds + (rt1 * 16 + r) * (K * 2) + (((ks * 4 + q) ^ r) << 4));
                    acc0 = __builtin_amdgcn_mfma_f32_16x16x32_bf16(a0, b0, acc0, 0, 0, 0); acc1 = __builtin_amdgcn_mfma_f32_16x16x32_bf16(a1, b0, acc1, 0, 0, 0); }
            }
            const int col = col0 + r;
            if (MODE == 0) { bf16_t* BBo = (bf16_t*)(P.ws + O_BB);
#pragma unroll
                for (int i = 0; i < 4; ++i) { const int row = row_base + rt0 * 16 + q * 4 + i; const float z = bf2f(parts[E_PZB + (size_t)row * 1024 + col]);
                    BBo[(size_t)row * 1024 + col] = (bf16_t)(cvt_pk_bf16(acc0[i] * sigmoidf_(acc1[i]) * siluf_(z), 0.f) & 0xffffu); }
            } else if (MODE == 1) {
#pragma unroll
                for (int i = 0; i < 4; ++i) { const int rowa = row_base + rt0 * 16 + q * 4 + i, rowb = row_base + rt1 * 16 + q * 4 + i;
                    msum[0][i] += acc0[i] * sigmoidf_(bf2f(parts[E_PGL + (size_t)rowa * 6144 + br * DM + col])); msum[1][i] += acc1[i] * sigmoidf_(bf2f(parts[E_PGL + (size_t)rowb * 6144 + br * DM + col])); }
            } else if (MODE == 3) { bf16_t* CBo = (bf16_t*)(P.ws + O_CB);
#pragma unroll
                for (int i = 0; i < 4; ++i) { const int row = row_base + rt0 * 16 + q * 4 + i; const float z = bf2f(parts[E_PZC + (size_t)row * 1024 + col]);
                    CBo[(size_t)row * 1024 + col] = (bf16_t)(cvt_pk_bf16(acc0[i] * siluf_(z), 0.f) & 0xffffu); }
            } else { bf16_t* OBo = (bf16_t*)(P.ws + O_PARTS);
#pragma unroll
                for (int i = 0; i < 4; ++i) { const int rowa = row_base + rt0 * 16 + q * 4 + i, rowb = row_base + rt1 * 16 + q * 4 + i;
                    OBo[(size_t)rowa * DM + col] = (bf16_t)(cvt_pk_bf16(acc0[i], 0.f) & 0xffffu); OBo[(size_t)rowb * DM + col] = (bf16_t)(cvt_pk_bf16(acc1[i], 0.f) & 0xffffu); }
            }
            __syncthreads();
        }
        if (MODE == 1) { bf16_t* MBo = (bf16_t*)(P.ws + O_HB); const int col = col0 + r;
#pragma unroll
            for (int i = 0; i < 4; ++i) { const int rowa = row_base + rt0 * 16 + q * 4 + i, rowb = row_base + rt1 * 16 + q * 4 + i;
                MBo[(size_t)rowa * DM + col] = (bf16_t)(cvt_pk_bf16(msum[0][i], 0.f) & 0xffffu); MBo[(size_t)rowb * DM + col] = (bf16_t)(cvt_pk_bf16(msum[1][i], 0.f) & 0xffffu); }
        }
    }
}

struct TileJob { const float* src; bf16_t* dst; int N, K, k0, n0, drow0; };
constexpr int TILES_PER_LAYER = 4736 + 512;
__device__ __forceinline__ TileJob tile_job(PREF P, int gt) {
    const int l = gt / TILES_PER_LAYER, tt = gt - l * TILES_PER_LAYER; unsigned char* wl = P.ws + l * SZ_LAYER; TileJob J; int kt, nt;
    if (tt < 3584) { J.src = P.w_in + (size_t)l * DM * INW; J.dst = (bf16_t*)(wl + LO_WIN); J.K = DM; J.N = INW; kt = tt & 15; nt = tt >> 4; J.drow0 = nt * 64; }
    else if (tt < 3584 + 768) { const int e = tt - 3584, w = e >> 8, f = e & 255; J.src = (w == 0 ? P.proj_a : (w == 1 ? P.proj_b : P.proj_c)) + (size_t)l * 1024 * DM;
        J.dst = (bf16_t*)(wl + LO_PA + (size_t)w * SZ_P); J.K = 1024; J.N = DM; kt = f & 7; nt = f >> 3; J.drow0 = nt * 64; }
    else if (tt < 4352 + 256) { const int e = tt - 4352, w = e >> 7, f = e & 127; J.src = (w == 0 ? P.glu_wa : P.glu_wb) + (size_t)l * 1024 * 1024; J.dst = (bf16_t*)(wl + LO_GLU);
        J.K = 1024; J.N = 1024; kt = f & 7; nt = f >> 3; const int n0 = nt * 64; J.drow0 = (n0 >> 7) * 256 + (n0 & 127) + w * 128; }
    else if (tt < 4608 + 128) { const int f = tt - 4608; J.src = P.fourier_w + (size_t)l * 1024 * 1024; J.dst = (bf16_t*)(wl + LO_FW); J.K = 1024; J.N = 1024; kt = f & 7; nt = f >> 3; J.drow0 = nt * 64; }
    else { const int f = tt - 4736; J.src = P.w_out + (size_t)l * DM * DM; J.dst = (bf16_t*)(wl + LO_WO); J.K = DM; J.N = DM; kt = f & 15; nt = f >> 4; J.drow0 = nt * 64; }
    J.k0 = kt * 128; J.n0 = nt * 64; return J;
}


__device__ __forceinline__ void mod_item(PREF P, int l, int nt, float* sm) {
    const int tid = tid_opaque(); float* sc = sm; float* red = sm + 3 * 2048;
    for (int i = tid; i < 3 * 2048; i += 512) { const int r = i >> 11, k = i & 2047; const float v = r < 2 ? P.c[r * 2048 + k] : P.c_ctx[k]; sc[i] = siluf_(v); }
    __syncthreads();
    const int col = tid & 63, kg = tid >> 6; const float* w = P.w_ada + (size_t)l * DM * 6144 + nt * 64 + col;
    float a0 = 0.f, a1 = 0.f, a2 = 0.f;
#pragma unroll 16
    for (int k = kg * 256; k < kg * 256 + 256; ++k) { const float wv = w[(size_t)k * 6144]; a0 += sc[k] * wv; a1 += sc[2048 + k] * wv; a2 += sc[4096 + k] * wv; }
    red[(kg * 3 + 0) * 64 + col] = a0; red[(kg * 3 + 1) * 64 + col] = a1; red[(kg * 3 + 2) * 64 + col] = a2;
    __syncthreads();
    if (tid < 192) { const int r = tid >> 6, c = tid & 63; float s = 0.f;
#pragma unroll
        for (int k = 0; k < 8; ++k) s += red[(k * 3 + r) * 64 + c];
        float* MOD = (float*)(P.ws + l * SZ_LAYER + LO_MOD); MOD[r * 6144 + nt * 64 + c] = s + P.b_ada[l * 6144 + nt * 64 + c]; }
    __syncthreads();
}

__device__ __forceinline__ void tables_item(PREF P, int it) {
    const int tid = tid_opaque(); unsigned char* tb = P.ws + O_TAB;
    if (it < 8) {
        bf16_t* T = (bf16_t*)(tb + T_CS);
        for (int e = tid; e < 64 * 256; e += 512) { const int row = it * 64 + (e >> 8), kc = e & 255, cs = row >> 8, j = row & 255; const int mm = (j * kc) & 255;
            float s, c; sincospif((float)mm * (1.0f / 128.0f), &s, &c); T[row * 256 + kc] = (bf16_t)(cvt_pk_bf16((cs ? s : c) * 0.0625f, 0.f) & 0xffffu); }
    } else if (it < 16) {
        bf16_t* T = (bf16_t*)(tb + T_DCTX); const int i8 = it - 8;
        for (int e = tid; e < 64 * 256; e += 512) { const int row = i8 * 64 + (e >> 8), t = e & 255, cs = row >> 8, k = row & 255; const int mm = (k * t) & 255;
            float s, c; sincospif((float)mm * (1.0f / 128.0f), &s, &c); T[row * 256 + t] = (bf16_t)(cvt_pk_bf16((cs ? -s : c) * 0.0625f, 0.f) & 0xffffu); }
    } else {
        bf16_t* D1 = (bf16_t*)(tb + T_D1); bf16_t* D2 = (bf16_t*)(tb + T_D2); float* TW = (float*)(tb + T_TW);
        for (int e = tid; e < 128 * 64; e += 512) { const int row = e >> 6, t1 = e & 63, cs = row >> 6, k1 = row & 63; const int mm = (k1 * t1) & 63;
            float s, c; sincospif((float)mm * (1.0f / 32.0f), &s, &c); D1[e] = (bf16_t)(cvt_pk_bf16((cs ? -s : c) * 0.125f, 0.f) & 0xffffu); }
        for (int e = tid; e < 128 * 128; e += 512) { const int row = e >> 7, col = e & 127, cso = row >> 6, k2 = row & 63, csi = col >> 6, t2 = col & 63; const int mm = (k2 * t2) & 63;
            float s, c; sincospif((float)mm * (1.0f / 32.0f), &s, &c); const float v = (cso == csi) ? c : (cso == 0 ? s : -s);
            D2[e] = (bf16_t)(cvt_pk_bf16(v * 0.125f, 0.f) & 0xffffu); }
        for (int e = tid; e < 64 * 64; e += 512) { const int k1 = e >> 6, t2 = e & 63; float s, c; sincospif((float)(k1 * t2) * (1.0f / 2048.0f), &s, &c); TW[2 * e] = c; TW[2 * e + 1] = -s; }
    }
}

__device__ __forceinline__ void ssm_build(PREF P, int l, int g, float* sm) {
    float* ap_re = sm; float* ap_im = ap_re + 2 * 17 * 64; float* bb_re = ap_im + 2 * 17 * 64; float* bb_im = bb_re + 2 * 64 * 16;
    float* cc_re = bb_im + 2 * 64 * 16; float* cc_im = cc_re + 2 * 16 * 64; float* Kk = cc_im + 2 * 16 * 64;
    const int tid = tid_opaque(); unsigned char* wl = P.ws + l * SZ_LAYER;
    if (tid < 128) {
        const int d = tid >> 6, p = tid & 63; const size_t gi = (size_t)(l * 2 + d) * 64 + g;
        const double lr = (double)P.lam_re[gi * 64 + p], li = (double)P.lam_im[gi * 64 + p], dt = exp((double)P.log_dt[gi]);
        const double a_re = exp(lr * dt) * cos(li * dt), a_im = exp(lr * dt) * sin(li * dt);
        { double pr = 1.0, pi = 0.0;
          for (int tau = 0; tau <= 16; ++tau) { ap_re[(d * 17 + tau) * 64 + p] = (float)pr; ap_im[(d * 17 + tau) * 64 + p] = (float)pi;
              if (tau == 16) { float* A16 = (float*)(wl + LO_A16); A16[((d * 64 + g) * 64 + p) * 2] = (float)pr; A16[((d * 64 + g) * 64 + p) * 2 + 1] = (float)pi; }
              const double nr = pr * a_re - pi * a_im, ni = pr * a_im + pi * a_re; pr = nr; pi = ni; } }
        const double n_re = a_re - 1.0, n_im = a_im, den = lr * lr + li * li;
        const double q_re = (n_re * lr + n_im * li) / den, q_im = (n_im * lr - n_re * li) / den;
        for (int h = 0; h < 16; ++h) { const double br = (double)P.b_re[(gi * 64 + p) * 16 + h], bi = (double)P.b_im[(gi * 64 + p) * 16 + h];
            bb_re[(d * 64 + p) * 16 + h] = (float)(q_re * br - q_im * bi); bb_im[(d * 64 + p) * 16 + h] = (float)(q_re * bi + q_im * br); }
    }
    for (int i = tid; i < 2048; i += 512) { const int d = i >> 10, rem = i & 1023; const size_t s = ((size_t)(l * 2 + d) * 64 + g) * 1024 + rem; cc_re[i] = P.c_re[s]; cc_im[i] = P.c_im[s]; }
    __syncthreads();
    { const int d = tid >> 8, tau = (tid >> 4) & 15, ho = tid & 15; float sacc[16];
#pragma unroll
      for (int hi = 0; hi < 16; ++hi) sacc[hi] = 0.f;
      for (int p = 0; p < 64; ++p) { const float cr = cc_re[(d * 16 + ho) * 64 + p], ci = cc_im[(d * 16 + ho) * 64 + p], ar = ap_re[(d * 17 + tau) * 64 + p], ai = ap_im[(d * 17 + tau) * 64 + p];
          const float wr = cr * ar - ci * ai, wi = cr * ai + ci * ar; const float* br = bb_re + (d * 64 + p) * 16; const float* bi = bb_im + (d * 64 + p) * 16;
#pragma unroll
          for (int hi = 0; hi < 16; ++hi) sacc[hi] += wr * br[hi] - wi * bi[hi]; }
#pragma unroll
      for (int hi = 0; hi < 16; ++hi) Kk[((d * 16 + tau) * 16 + ho) * 16 + hi] = sacc[hi]; }
    __syncthreads();
    bf16_t* M1 = (bf16_t*)(wl + LO_M1) + (size_t)g * 256 * 256; bf16_t* M2 = (bf16_t*)(wl + LO_M2) + (size_t)g * 256 * 512;
    for (int v = tid; v < 8192; v += 512) { const int mrow = v >> 5, k0 = (v & 31) * 8; const int d = mrow >> 7, reim = (mrow >> 6) & 1, p = mrow & 63, s = k0 >> 4, hi0 = k0 & 15;
        const int tau = d == 0 ? 15 - s : s; const float ar = ap_re[(d * 17 + tau) * 64 + p], ai = ap_im[(d * 17 + tau) * 64 + p]; float f[8];
#pragma unroll
        for (int j = 0; j < 8; ++j) { const float br = bb_re[(d * 64 + p) * 16 + hi0 + j], bi = bb_im[(d * 64 + p) * 16 + hi0 + j]; f[j] = reim == 0 ? ar * br - ai * bi : ar * bi + ai * br; }
        *(u32x4*)(M1 + (size_t)mrow * 256 + k0) = pack8(f); }
    for (int v = tid; v < 16384; v += 512) { const int r = v >> 6, k0 = (v & 63) * 8, t = r >> 4, ho = r & 15; float f[8];
        if (k0 < 256) { const int s = k0 >> 4, hi0 = k0 & 15;
#pragma unroll
            for (int j = 0; j < 8; ++j) f[j] = s < t ? Kk[(t - s) * 256 + ho * 16 + hi0 + j] : (s > t ? Kk[(16 + (s - t)) * 256 + ho * 16 + hi0 + j] : Kk[ho * 16 + hi0 + j] + Kk[16 * 256 + ho * 16 + hi0 + j]);
        } else { const int kk = k0 - 256, d = kk >> 7, reim = (kk >> 6) & 1, p0 = kk & 63, tau = d == 0 ? t + 1 : 16 - t;
#pragma unroll
            for (int j = 0; j < 8; ++j) { const int p = p0 + j; const float cr = cc_re[(d * 16 + ho) * 64 + p], ci = cc_im[(d * 16 + ho) * 64 + p], ar = ap_re[(d * 17 + tau) * 64 + p], ai = ap_im[(d * 17 + tau) * 64 + p];
                f[j] = reim == 0 ? cr * ar - ci * ai : -(cr * ai + ci * ar); } }
        *(u32x4*)(M2 + (size_t)r * 512 + k0) = pack8(f); }
    __syncthreads();
}

__device__ __forceinline__ void phase_prep(PREF P, unsigned char* shm) {
    float* sm = (float*)shm; const int b = bid_opaque(), G = gridDim.x;
    for (int it = b; it < 337; it += G) {
        if (it < 128) ssm_build(P, it >> 6, it & 63, sm);
        else if (it < 320) { const int e = it - 128; mod_item(P, e / 96, e % 96, sm); }
        else tables_item(P, it - 320);
    }
    const int total = 2 * TILES_PER_LAYER; int start, cnt;
    if (G == 256) { if (b < 64) { start = b * 38; cnt = 38; } else if (b < 81) { start = 2432 + (b - 64) * 42; cnt = 42; } else { start = 2432 + 17 * 42 + (b - 81) * 43; cnt = 43; } }
    else { cnt = (total + G - 1) / G; start = b * cnt; }
    const int end = (start + cnt) < total ? (start + cnt) : total;
    const int tid = tid_opaque(), lr = tid >> 4, lc = (tid & 15) * 4;
    if (start < end) {
        int cur = start; TileJob J = tile_job(P, cur); f32x4 v[4];
#pragma unroll
        for (int i = 0; i < 4; ++i) v[i] = *(const f32x4*)(J.src + (size_t)(J.k0 + lr + 32 * i) * J.N + J.n0 + lc);
        for (;;) {
#pragma unroll
            for (int i = 0; i < 4; ++i)
#pragma unroll
                for (int j = 0; j < 4; ++j) sm[(lr + 32 * i) * 65 + lc + j] = v[i][j];
            __syncthreads();
            const TileJob C = J; const bool more = cur + 1 < end;
            if (more) { J = tile_job(P, cur + 1);
#pragma unroll
                for (int i = 0; i < 4; ++i) v[i] = *(const f32x4*)(J.src + (size_t)(J.k0 + lr + 32 * i) * J.N + J.n0 + lc); }
            const int n = tid >> 3, kg = tid & 7;
#pragma unroll
            for (int h = 0; h < 2; ++h) { float f[8];
#pragma unroll
                for (int j = 0; j < 8; ++j) f[j] = sm[(kg * 16 + h * 8 + j) * 65 + n];
                *(u32x4*)(C.dst + (size_t)(C.drow0 + n) * C.K + C.k0 + kg * 16 + h * 8) = pack8(f); }
            __syncthreads();
            if (!more) break;
            ++cur;
        }
    }
}

__device__ __forceinline__ void phase_prenorm0(PREF P) {
    const int tidx = tid_opaque(); const int lane = tidx & 63, gw = bid_opaque() * 8 + (tidx >> 6), nw = gridDim.x * 8;
    const float* MOD = (const float*)(P.ws + LO_MOD); bf16_t* HB = (bf16_t*)(P.ws + O_HB);
    for (int row = gw; row < MTOT; row += nw) {
        const float* src = row < MX ? P.x + (size_t)row * DM : P.ctx + (size_t)(row - MX) * DM; const float* md = MOD + (row < MX ? (row >> 12) : 2) * 6144;
        f32x4 v[8]; float ss = 0.f;
#pragma unroll
        for (int i = 0; i < 8; ++i) { v[i] = *(const f32x4*)(src + (i * 64 + lane) * 4); ss += v[i][0] * v[i][0] + v[i][1] * v[i][1] + v[i][2] * v[i][2] + v[i][3] * v[i][3]; }
        ss = wave_sum(ss, lane); const float rinv = rsqrtf(ss * (1.0f / DM) + RMS_EPS);
#pragma unroll
        for (int i = 0; i < 8; ++i) { const int c = (i * 64 + lane) * 4; const f32x4 g = *(const f32x4*)(P.g_pre + c), sh = *(const f32x4*)(md + c), sc = *(const f32x4*)(md + 2048 + c); float h[4];
#pragma unroll
            for (int j = 0; j < 4; ++j) h[j] = v[i][j] * rinv * g[j] * (1.0f + sc[j]) + sh[j];
            u32x2 o; o[0] = cvt_pk_bf16(h[0], h[1]); o[1] = cvt_pk_bf16(h[2], h[3]); *(u32x2*)(HB + (size_t)row * DM + c) = o; }
    }
}
__device__ __forceinline__ void phase_postnorm(PREF P, int l) {
    const int tidx = tid_opaque(); const int lane = tidx & 63, gw = bid_opaque() * 8 + (tidx >> 6), nw = gridDim.x * 8;
    const float* MOD = (const float*)(P.ws + l * SZ_LAYER + LO_MOD); const float* MOD1 = (const float*)(P.ws + SZ_LAYER + LO_MOD);
    bf16_t* HB = (bf16_t*)(P.ws + O_HB); const bf16_t* OB = (const bf16_t*)(P.ws + O_PARTS); float* X1 = (float*)(P.ws + O_X1);
    const int rows = l == 0 ? MTOT : MX;
    for (int row = gw; row < rows; row += nw) {
        const int mr = row < MX ? (row >> 12) : 2; const float* md = MOD + mr * 6144;
        const float* xo = l == 0 ? (row < MX ? P.x + (size_t)row * DM : P.ctx + (size_t)(row - MX) * DM) : X1 + (size_t)row * DM;
        const bf16_t* op = OB + (size_t)row * DM;
        f32x4 o[8], xv[8]; float ss = 0.f;
#pragma unroll
        for (int i = 0; i < 8; ++i) { const u32x2 ob = *(const u32x2*)(op + (i * 64 + lane) * 4); o[i] = (f32x4){lo_f(ob[0]), hi_f(ob[0]), lo_f(ob[1]), hi_f(ob[1])}; xv[i] = *(const f32x4*)(xo + (i * 64 + lane) * 4); ss += o[i][0] * o[i][0] + o[i][1] * o[i][1] + o[i][2] * o[i][2] + o[i][3] * o[i][3]; }
        ss = wave_sum(ss, lane); const float rinv = rsqrtf(ss * (1.0f / DM) + RMS_EPS); float s2 = 0.f;
#pragma unroll
        for (int i = 0; i < 8; ++i) { const int c = (i * 64 + lane) * 4; const f32x4 gp = *(const f32x4*)(P.g_post + l * DM + c), gt = *(const f32x4*)(md + 4096 + c);
#pragma unroll
            for (int j = 0; j < 4; ++j) { xv[i][j] = xv[i][j] + gt[j] * (o[i][j] * rinv * gp[j]); s2 += xv[i][j] * xv[i][j]; }
            if (l == 0) *(f32x4*)(X1 + (size_t)row * DM + c) = xv[i]; else *(f32x4*)(P.out + (size_t)row * DM + c) = xv[i]; }
        if (l == 0) { s2 = wave_sum(s2, lane); const float r2 = rsqrtf(s2 * (1.0f / DM) + RMS_EPS); const float* m1 = MOD1 + mr * 6144;
#pragma unroll
            for (int i = 0; i < 8; ++i) { const int c = (i * 64 + lane) * 4; const f32x4 g = *(const f32x4*)(P.g_pre + DM + c), sh = *(const f32x4*)(m1 + c), sc = *(const f32x4*)(m1 + 2048 + c); float h[4];
#pragma unroll
                for (int j = 0; j < 4; ++j) h[j] = xv[i][j] * r2 * g[j] * (1.0f + sc[j]) + sh[j];
                u32x2 ov; ov[0] = cvt_pk_bf16(h[0], h[1]); ov[1] = cvt_pk_bf16(h[2], h[3]); *(u32x2*)(HB + (size_t)row * DM + c) = ov; } }
    }
}


__device__ __forceinline__ void conv_rows(PREF P, const int l, const int bsub, const int nblk, const int tidx) {
    const bf16_t* parts = (const bf16_t*)(P.ws + O_PARTS); bf16_t* AB = (bf16_t*)(P.ws + O_AB);
    const int rows = l == 0 ? MTOT : MX; const float* cw = P.conv_w + (size_t)l * 3 * 1024;
    for (int idx = bsub * 512 + tidx; idx < (rows >> 2) * 128; idx += nblk * 512) {
        const int r0 = (idx >> 7) * 4, c0 = (idx & 127) * 8; bool lv, rv;
        if (r0 < MX) { const int cp = r0 & 63; lv = cp > 0; rv = cp < 60; } else { const int t = (r0 - MX) & 255; lv = t > 0; rv = t < 252; }
        const bf16_t* pr = parts + E_PC + (size_t)r0 * 4096 + c0;
        u32x4 xr[6], cr[6], br[4], zr[4];
#pragma unroll
        for (int k = 0; k < 6; ++k) { const bool ok = (k == 0) ? lv : ((k == 5) ? rv : true);
            if (ok) { xr[k] = *(const u32x4*)(pr + (ptrdiff_t)(k - 1) * 4096 + C_XA); cr[k] = *(const u32x4*)(pr + (ptrdiff_t)(k - 1) * 4096 + C_CA); }
            else { xr[k] = (u32x4){0u, 0u, 0u, 0u}; cr[k] = (u32x4){0u, 0u, 0u, 0u}; } }
#pragma unroll
        for (int k = 0; k < 4; ++k) { br[k] = *(const u32x4*)(pr + (size_t)k * 4096 + C_BA); zr[k] = *(const u32x4*)(pr + (size_t)k * 4096 + C_ZA); }
        float w0[8], w1[8], w2[8];
#pragma unroll
        for (int j = 0; j < 8; ++j) { w0[j] = cw[c0 + j]; w1[j] = cw[1024 + c0 + j]; w2[j] = cw[2048 + c0 + j]; }
        float v[6][8];
#pragma unroll
        for (int k = 0; k < 6; ++k) { float xa[8], ca[8]; unpack8(xr[k], xa); unpack8(cr[k], ca);
#pragma unroll
            for (int j = 0; j < 8; ++j) v[k][j] = xa[j] * ca[j]; }
#pragma unroll
        for (int k = 0; k < 4; ++k) { float ba[8], za[8], o[8]; unpack8(br[k], ba); unpack8(zr[k], za);
#pragma unroll
            for (int j = 0; j < 8; ++j) { const float y = w0[j] * v[k][j] + w1[j] * v[k + 1][j] + w2[j] * v[k + 2][j]; o[j] = ba[j] * y * siluf_(za[j]); }
            *(u32x4*)(AB + (size_t)(r0 + k) * 1024 + c0) = pack8(o); }
    }
}

__device__ __forceinline__ void phase_mix1(PREF P, int l, unsigned char* shm) {
    const bf16_t* parts = (const bf16_t*)(P.ws + O_PARTS); unsigned char* wl = P.ws + l * SZ_LAYER;
    const int tidx = tid_opaque(), bidx = bid_opaque(); const int lane = tidx & 63, wv = tidx >> 6, r = lane & 15, q = lane >> 4;
    const int gw = bidx * 8 + wv, nw = gridDim.x * 8;
    for (int wi = bidx; wi < 256; wi += gridDim.x) ssm_stage_lds<256, false>(P, l, wi, shm, tidx);
    {
        bf16_t* ZB = (bf16_t*)(P.ws + O_ZB); const bf16_t* D1 = (const bf16_t*)(P.ws + O_TAB + T_D1); const float* TW = (const float*)(P.ws + O_TAB + T_TW);
        for (int it = gw; it < 2048; it += nw) {
            const int cg = it & 15, t2 = (it >> 4) & 63, b = it >> 10;
            f32x4 acc[8][4];
            lmul_g4<8>(D1, 64, 2, parts + E_PF + (size_t)(b * SEQ + t2) * 1024 + cg * 64 + r * 4, (size_t)64 * 1024, acc, lane);
#pragma unroll
            for (int a = 0; a < 4; ++a)
#pragma unroll
                for (int i = 0; i < 4; ++i) { const int k1 = a * 16 + q * 4 + i; const float twr = TW[(k1 * 64 + t2) * 2], twi = TW[(k1 * 64 + t2) * 2 + 1];
                    bf16_t* zr = ZB + ((size_t)((b * 64 + k1) * 128 + t2)) * 1024 + cg * 64 + r * 4; bf16_t* zi = zr + (size_t)64 * 1024; float vr[4], vi[4];
#pragma unroll
                    for (int nb = 0; nb < 4; ++nb) { const float re = acc[a][nb][i], im = acc[a + 4][nb][i]; vr[nb] = re * twr - im * twi; vi[nb] = re * twi + im * twr; }
                    u32x2 o; o[0] = cvt_pk_bf16(vr[0], vr[1]); o[1] = cvt_pk_bf16(vr[2], vr[3]); *(u32x2*)zr = o; o[0] = cvt_pk_bf16(vi[0], vi[1]); o[1] = cvt_pk_bf16(vi[2], vi[3]); *(u32x2*)zi = o; }
        }
    }
}


__device__ __forceinline__ void ctx_dft_item(PREF P, const int it, const int lane) {
    const int r = lane & 15, q = lane >> 4; const bf16_t* parts = (const bf16_t*)(P.ws + O_PARTS);
    bf16_t* YB = (bf16_t*)(P.ws + O_YB); const bf16_t* DC = (const bf16_t*)(P.ws + O_TAB + T_DCTX);
    const int cg = it & 15, mc = (it >> 4) & 3, b = it >> 6;
    f32x4 acc[8][4];
    lmul_g4<8>(DC + (size_t)mc * 128 * 256, 256, 8, parts + E_PF + (size_t)(MX + b * LCX) * 1024 + cg * 64 + r * 4, (size_t)1024, acc, lane);
#pragma unroll
    for (int a = 0; a < 8; ++a)
#pragma unroll
        for (int i = 0; i < 4; ++i) { const int mrow = mc * 128 + a * 16 + q * 4 + i, cs = mrow >> 8, k = mrow & 255;
            bf16_t* yp = YB + (size_t)(MX + b * LCX + k) * 2048 + cs * 1024 + cg * 64 + r * 4;
            u32x2 o; o[0] = cvt_pk_bf16(acc[a][0][i], acc[a][1][i]); o[1] = cvt_pk_bf16(acc[a][2][i], acc[a][3][i]); *(u32x2*)yp = o; }
}

__device__ __forceinline__ void phase_mix2(PREF P, int l) {
    unsigned char* wl = P.ws + l * SZ_LAYER;
    const int tidx = tid_opaque(), bidx = bid_opaque(); const int lane = tidx & 63, wv = tidx >> 6, r = lane & 15, q = lane >> 4;
    const int gw = bidx * 8 + wv, nw = gridDim.x * 8;
    if (wv == 0) {
        const float* EB = (const float*)(P.ws + O_EB); bf16_t* HS = (bf16_t*)(P.ws + O_HS); const float* A16 = (const float*)(wl + LO_A16);
        for (int it = bidx; it < 256; it += gridDim.x) {
            const int d = it & 1, g = (it >> 1) & 63, b = it >> 7, p = lane;
            const float ar = A16[((d * 64 + g) * 64 + p) * 2], ai = A16[((d * 64 + g) * 64 + p) * 2 + 1];
            float hr = 0.f, hi = 0.f;
#define SCAN_COL(j) ((j) < 16 ? 512 + b * 16 + (d ? 15 - (j) : (j)) : b * 256 + (d ? 255 - ((j) - 16) : ((j) - 16)))
#define SCAN_LOAD(er, ei, j0) _Pragma("unroll") for (int jj = 0; jj < 16; ++jj) { const int col = SCAN_COL((j0) + jj); const float* ep = EB + ((size_t)g * NCOL + col) * 256 + d * 128 + p; er[jj] = ep[0]; ei[jj] = ep[64]; }
#define SCAN_STEP(er, ei, j0) _Pragma("unroll") for (int jj = 0; jj < 16; ++jj) { const int col = SCAN_COL((j0) + jj); \
                bf16_t* hp = HS + ((size_t)g * NCOL + col) * 256 + d * 128 + p; const unsigned pk = cvt_pk_bf16(hr, hi); hp[0] = (bf16_t)(pk & 0xffffu); hp[64] = (bf16_t)(pk >> 16); \
                const float nr = ar * hr - ai * hi + er[jj], ni = ar * hi + ai * hr + ei[jj]; hr = nr; hi = ni; }
            float era[16], eia[16], erb[16], eib[16];
            SCAN_LOAD(era, eia, 0)
            for (int it2 = 0; it2 < 8; ++it2) {
                SCAN_LOAD(erb, eib, it2 * 32 + 16)
                SCAN_STEP(era, eia, it2 * 32)
                SCAN_LOAD(era, eia, it2 * 32 + 32)
                SCAN_STEP(erb, eib, it2 * 32 + 16)
            }
            SCAN_STEP(era, eia, 256)
#undef SCAN_COL
#undef SCAN_LOAD
#undef SCAN_STEP
        }
    }
    {
        const bf16_t* ZB = (const bf16_t*)(P.ws + O_ZB); bf16_t* YB = (bf16_t*)(P.ws + O_YB); const bf16_t* D2 = (const bf16_t*)(P.ws + O_TAB + T_D2);
        for (int it = gw; it < 2048; it += nw) {
            const int cg = it & 15, k1 = (it >> 4) & 63, b = it >> 10;
            f32x4 acc[8][4];
            lmul_g4<8>(D2, 128, 4, ZB + (size_t)(b * 64 + k1) * 128 * 1024 + cg * 64 + r * 4, (size_t)1024, acc, lane);
#pragma unroll
            for (int a = 0; a < 8; ++a)
#pragma unroll
                for (int i = 0; i < 4; ++i) { const int mrow = a * 16 + q * 4 + i, cs = mrow >> 6, k2 = mrow & 63;
                    bf16_t* yp = YB + (size_t)(b * SEQ + k1 + 64 * k2) * 2048 + cs * 1024 + cg * 64 + r * 4;
                    u32x2 o; o[0] = cvt_pk_bf16(acc[a][0][i], acc[a][1][i]); o[1] = cvt_pk_bf16(acc[a][2][i], acc[a][3][i]); *(u32x2*)yp = o; }
        }
    }
    if (l == 0 && wv >= 1) { for (int it = bidx * 7 + (wv - 1); it < 128; it += gridDim.x * 7) ctx_dft_item(P, it, lane); }
}

template <int ph>
__device__ __forceinline__ void run_phase(KPtr kp, unsigned char* shm) {
    asm volatile("" : "+s"(kp)); PREF P = *kp;
    LAS unsigned char* lds = (LAS unsigned char*)shm; const int G = gridDim.x, c = bid_opaque();
    if constexpr (ph == 0) { phase_prep(P, shm); return; }
    if constexpr (ph == 1) {
        phase_prenorm0(P);
        return;
    }
    constexpr int l = ph >= 2 ? ((ph - 2) >> 3) : 0, sp = ph >= 2 ? ((ph - 2) & 7) : 0; unsigned char* wl = P.ws + l * SZ_LAYER; constexpr int nM = 32, nh = l == 0 ? 4 : 0;
    const bf16_t* parts = (const bf16_t*)(P.ws + O_PARTS);
    switch (sp) {
    case 0: { EpiParts E{(bf16_t*)(P.ws + O_PARTS)};
        if (l == 0) { SchedGrid S{(const char*)(P.ws + O_HB), (const char*)(wl + LO_WIN), 32, 56, DM, DM, G, c, 4, MX, 1 << 20}; gemm_phase(lds, S, E, DM, DM, DM);
            { const int c3 = bid_opaque(); const int first = G > 224 ? 224 : 0; if (c3 >= first) { SchedWp SW{P.ws, G - first, c3 - first}; EpiWp EW{P.ws}; gemm_phase(lds, SW, EW, 256, 1024, 256); } } }
        else {
            {
                const int tq = tid_opaque(), lane = tq & 63, r = lane & 15, q = lane >> 4; const bf16_t* HB = (const bf16_t*)(P.ws + O_HB); const bf16_t* WT = (const bf16_t*)(wl + LO_WIN); bf16_t* po = (bf16_t*)(P.ws + O_PARTS);
                for (int it = c * 8 + (tq >> 6); it < 2048; it += G * 8) { const int tr = it >> 6, tc = it & 63;
                    const bf16_t* ap = HB + (size_t)(MX + tr * 16 + r) * DM + q * 8; const bf16_t* bp = WT + (size_t)(C_U + tc * 16 + r) * DM + q * 8; f32x4 a4 = (f32x4){0.f, 0.f, 0.f, 0.f};
#pragma unroll 8
                    for (int ks = 0; ks < 64; ++ks) a4 = __builtin_amdgcn_mfma_f32_16x16x32_bf16(*(const bf16x8*)(ap + ks * 32), *(const bf16x8*)(bp + ks * 32), a4, 0, 0, 0);
#pragma unroll
                    for (int i = 0; i < 4; ++i) po[E_PU + (size_t)(MX + tr * 16 + q * 4 + i) * 1024 + tc * 16 + r] = (bf16_t)(cvt_pk_bf16(a4[i], 0.f) & 0xffffu); }
            }
            SchedGrid S{(const char*)(P.ws + O_HB), (const char*)(wl + LO_WIN), 32, 56, DM, DM, G, c, 0, MX, 1 << 20}; gemm_phase(lds, S, E, DM, DM, DM); }
    } break;
    case 1: phase_mix1(P, l, shm); break;
    case 2: phase_mix2(P, l); break;
    case 3: { const int tq = tid_opaque(), c2 = bid_opaque();
        for (int wi = c2; wi < 256; wi += G) ssm_stage_lds<512, true>(P, l, wi, shm, tq);
        conv_rows(P, l, c2, G, tq);
    } break;
    case 4: {
        if (l == 0) { ctx_small_gemm<0>(P, shm); ctx_small_gemm<3>(P, shm); }
        const int nf = nM * 4;
        { const int c1 = bid_opaque(); SchedGrid S{(const char*)(P.ws + O_YB), (const char*)(wl + LO_WP), nM, 4, 2048, 2048, nf, c1, 0, MX, c1 < nf ? 1 : 0}; EpiFourier E{parts, (bf16_t*)(P.ws + O_CB)}; gemm_phase(lds, S, E, 2048, 2048, 2048); }
        { const int c2 = bid_opaque(); const int ng = nM * 8, two = 2 * (G - nf);
          int L0, dL, cn;
          if (G > nf && two <= ng) { if (c2 >= nf) { L0 = 2 * (c2 - nf); dL = 1; cn = 2; } else { L0 = two + c2; dL = nf; cn = (ng - two - c2 + nf - 1) / nf; if (cn < 0) cn = 0; } }
          else { L0 = c2; dL = G; cn = 1 << 20; }
          SchedGrid S{(const char*)(P.ws + O_GB), (const char*)(wl + LO_GLU), nM, 8, 1024, 1024, dL, L0, 0, MX, cn}; EpiGlu E{parts, (bf16_t*)(P.ws + O_BB)}; gemm_phase(lds, S, E, 1024, 1024, 1024); }
    } break;
    case 5: { if (l == 0) ctx_small_gemm<1>(P, shm);
        SchedMerge S{(const char*)(P.ws + O_AB), (const char*)(wl + LO_PA), nM, G, c, 0, MX};
        EpiMerge E{parts, (bf16_t*)(P.ws + O_HB)}; gemm_phase(lds, S, E, 1024, 1024, 1024); } break;
    case 6: { if (l == 0) ctx_small_gemm<2>(P, shm);
        SchedGrid S{(const char*)(P.ws + O_HB), (const char*)(wl + LO_WO), nM, 8, DM, DM, G, c, 0, MX, 1 << 20}; EpiStoreBf16 E{(bf16_t*)(P.ws + O_PARTS), DM}; gemm_phase(lds, S, E, DM, DM, DM); } break;
    default: phase_postnorm(P, l); break;
    }
}

#define XB_TMO      128
#define XB_XCNT(j)  (256  + 64 * (j))
#define XB_XSUB(j)  (1280 + 64 * (j))
#define XB_XGEN(j)  (2304 + 64 * (j))
#define XB_TOP      3328
#define XB_TOPGEN   3392
#define XCD_BAR_WORDS 3456
#define XB_SPIN_CAP (1u << 18)
__device__ __forceinline__ unsigned xb_ld(unsigned* p)              { return __hip_atomic_load(p, __ATOMIC_RELAXED, __HIP_MEMORY_SCOPE_AGENT); }
__device__ __forceinline__ unsigned xb_add(unsigned* p, unsigned v) { return __hip_atomic_fetch_add(p, v, __ATOMIC_RELAXED, __HIP_MEMORY_SCOPE_AGENT); }
__device__ __forceinline__ unsigned xb_xcc_id() { return (unsigned)__builtin_amdgcn_s_getreg((3 << 11) | 20) & 0xFu; }
#define XB_SPIN(cond, bar) do { unsigned _sp = 0; while (cond) { __builtin_amdgcn_s_sleep(1); \
    if ((++_sp & 255u) == 0u) { if (xb_ld(&(bar)[XB_TMO])) break; if (_sp > XB_SPIN_CAP) { atomicAdd(&(bar)[XB_TMO], 1u); break; } } } } while (0)
struct XcdBarrier { unsigned* bar; unsigned x; volatile LAS unsigned* st; };
__device__ __forceinline__ XcdBarrier xcd_barrier_post(unsigned* bar, volatile LAS unsigned* st) {
    XcdBarrier b; b.bar = bar; b.x = xb_xcc_id(); b.st = st;
    if (threadIdx.x == 0) (void)xb_add(&bar[XB_XCNT(b.x)], 1u);
    return b;
}
__device__ __forceinline__ void xcd_barrier_complete(unsigned* bar, unsigned x, unsigned& nloc, unsigned& nx) {
    const unsigned G = gridDim.x * gridDim.y * gridDim.z;
    unsigned sum, cnt, mine, sp = 0u;
    for (;;) {
        sum = 0u; cnt = 0u; mine = 0u;
#pragma unroll
        for (unsigned j = 0; j < 16; ++j) { const unsigned c = xb_ld(&bar[XB_XCNT(j)]); sum += c; cnt += (c > 0u) ? 1u : 0u; mine = (j == x) ? c : mine; }
        if (sum == G) break;
        __builtin_amdgcn_s_sleep(1);
        if ((++sp & 255u) == 0u) { if (xb_ld(&bar[XB_TMO])) break; if (sp > XB_SPIN_CAP) { atomicAdd(&bar[XB_TMO], 1u); break; } }
    }
    nloc = mine > 0u ? mine : 1u; nx = cnt > 0u ? cnt : 1u;
}
__device__ __forceinline__ void xcd_barrier(const XcdBarrier& b) {
    asm volatile("s_waitcnt vmcnt(0)" ::: "memory");
    __syncthreads();
    if (threadIdx.x == 0) {
        unsigned* bar = b.bar;
        __builtin_amdgcn_s_waitcnt(0);
        unsigned nloc = b.st[0], nx = b.st[1];
        if (nloc == 0u) { xcd_barrier_complete(bar, b.x, nloc, nx); b.st[0] = nloc; b.st[1] = nx; }
        const unsigned old = xb_add(&bar[XB_XSUB(b.x)], 1u);
        const unsigned gen = old / nloc;
        if (old + 1u == (gen + 1u) * nloc) {
            __builtin_amdgcn_fence(__ATOMIC_RELEASE, "agent");
            asm volatile("s_waitcnt vmcnt(0)" ::: "memory");
            const unsigned og = xb_add(&bar[XB_TOP], 1u);
            const unsigned tg = og / nx;
            if (og + 1u == (tg + 1u) * nx) xb_add(&bar[XB_TOPGEN], 1u);
            else XB_SPIN(xb_ld(&bar[XB_TOPGEN]) == tg, bar);
            __builtin_amdgcn_fence(__ATOMIC_ACQUIRE, "agent");
            xb_add(&bar[XB_XGEN(b.x)], 1u);
            asm volatile("s_waitcnt vmcnt(0)" ::: "memory");
        } else {
            XB_SPIN(xb_ld(&bar[XB_XGEN(b.x)]) == gen, bar);
            __builtin_amdgcn_fence(__ATOMIC_ACQUIRE, "agent");
            asm volatile("s_waitcnt vmcnt(0)" ::: "memory");
        }
    }
    __syncthreads();
}

constexpr int N_PHASES = 18;

__global__ void __launch_bounds__(512, 2) mega(Params P, int ph0, int ph1) {
    extern __shared__ __attribute__((aligned(16))) unsigned char shm[];
    __shared__ uint4 xb_words;
    if (threadIdx.x == 0) xb_words = make_uint4(0u, 0u, 0u, 0u);
    __syncthreads();
    const XcdBarrier xb = xcd_barrier_post((unsigned*)(P.ws + O_BAR), (volatile LAS unsigned*)&xb_words);
    const KPtr kp = (KPtr)__builtin_amdgcn_kernarg_segment_ptr();
#define RUN_PH(k) if (ph0 <= (k) && (k) < ph1) { if ((k) != ph0) xcd_barrier(xb); run_phase<(k)>(kp, shm); }
    RUN_PH(0) RUN_PH(1) RUN_PH(2) RUN_PH(3) RUN_PH(4) RUN_PH(5) RUN_PH(6) RUN_PH(7) RUN_PH(8) RUN_PH(9)
    RUN_PH(10) RUN_PH(11) RUN_PH(12) RUN_PH(13) RUN_PH(14) RUN_PH(15) RUN_PH(16) RUN_PH(17)
#undef RUN_PH
}

extern "C" void kernel_launch(void* const* d_in, const int* in_sizes, int n_in, void* d_out, int out_size, void* d_ws, size_t ws_size, hipStream_t stream) {
    static int grid_blocks = 0;
    if (!grid_blocks) {
        int dev = 0, cus = 0, per_cu = 0;
        hipGetDevice(&dev); hipDeviceGetAttribute(&cus, hipDeviceAttributeMultiprocessorCount, dev);
        hipFuncSetAttribute((const void*)mega, hipFuncAttributeMaxDynamicSharedMemorySize, STAGE_BYTES);
        hipOccupancyMaxActiveBlocksPerMultiprocessor(&per_cu, (const void*)mega, 512, STAGE_BYTES);
        if (per_cu < 1) { fprintf(stderr, "occupancy query says %d blocks/CU\n", per_cu); per_cu = 1; }
        grid_blocks = cus;
        if (ws_size < WS_END) { fprintf(stderr, "workspace too small: %zu < %zu\n", ws_size, (size_t)WS_END); grid_blocks = -1; }
    }
    if (grid_blocks < 0) return;
    if (hipMemsetAsync((char*)d_ws + O_BAR, 0, SZ_BAR, stream) != hipSuccess) { fprintf(stderr, "memset of barrier words failed\n"); return; }
    Params p{};
    const float** pp = (const float**)&p;
    for (int i = 0; i < 25; ++i) pp[i] = (const float*)d_in[i];
    p.out = (float*)d_out; p.ws = (unsigned char*)d_ws;
    int ph0 = 0, ph1 = N_PHASES;
    void* args[] = {&p, &ph0, &ph1};
    hipError_t e = hipLaunchCooperativeKernel((const void*)mega, dim3(grid_blocks), dim3(512), args, STAGE_BYTES, stream);
    if (e != hipSuccess) fprintf(stderr, "cooperative launch failed: %s (grid %d)\n", hipGetErrorString(e), grid_blocks);
}
```

```cpp
#include <hip/hip_runtime.h>
#include <hip/hip_cooperative_groups.h>
#include <cstdio>
namespace cg = cooperative_groups;

#define LAS __attribute__((address_space(3)))
typedef unsigned short bf16_t;
typedef short bf16x8 __attribute__((ext_vector_type(8)));
typedef float f32x4 __attribute__((ext_vector_type(4)));
typedef unsigned u32x4 __attribute__((ext_vector_type(4)));
typedef unsigned u32x2 __attribute__((ext_vector_type(2)));

constexpr int DM = 2048, NB = 2, SEQ = 4096, LCX = 256, MX = NB * SEQ, MCT = NB * LCX, MTOT = MX + MCT;
constexpr int INW = 14336;
constexpr int C_XA = 0, C_BA = 1024, C_CA = 2048, C_ZA = 3072, C_U = 4096, C_ZB = 5120, C_F = 6144, C_ZC = 7168, C_GL = 8192;
constexpr size_t E_PC = 0, E_PU = (size_t)8704 * 4096, E_PZB = E_PU + (size_t)8704 * 1024, E_PF = E_PZB + (size_t)8704 * 1024, E_PZC = E_PF + (size_t)8704 * 1024, E_PGL = E_PZC + (size_t)8704 * 1024;
constexpr int NCOL = 544;
constexpr float RMS_EPS = 1e-6f;

constexpr size_t AL(size_t x) { return (x + 255) & ~(size_t)255; }
constexpr size_t SZ_WIN = (size_t)INW * DM * 2, SZ_P = (size_t)DM * 1024 * 2, SZ_GLU = (size_t)2048 * 1024 * 2, SZ_FW = (size_t)1024 * 1024 * 2,
                 SZ_WP = (size_t)1024 * 2048 * 2, SZ_WO = (size_t)DM * DM * 2, SZ_M1 = (size_t)64 * 256 * 256 * 2, SZ_M2 = (size_t)64 * 256 * 512 * 2,
                 SZ_A16 = (size_t)2 * 64 * 64 * 2 * 4, SZ_MOD = (size_t)3 * 6144 * 4;
constexpr size_t LO_WIN = 0, LO_PA = LO_WIN + SZ_WIN, LO_PB = LO_PA + SZ_P, LO_PC = LO_PB + SZ_P, LO_GLU = LO_PC + SZ_P, LO_FW = LO_GLU + SZ_GLU,
                 LO_WP = LO_FW + SZ_FW, LO_WO = LO_WP + SZ_WP, LO_M1 = LO_WO + SZ_WO, LO_M2 = LO_M1 + SZ_M1, LO_A16 = LO_M2 + SZ_M2, LO_MOD = LO_A16 + SZ_A16,
                 SZ_LAYER = AL(LO_MOD + SZ_MOD);
constexpr size_t O_TAB = 2 * SZ_LAYER;
constexpr size_t T_CS = 0, T_D1 = T_CS + 512 * 256 * 2, T_D2 = T_D1 + 128 * 64 * 2, T_DCTX = T_D2 + 128 * 128 * 2, T_TW = T_DCTX + 512 * 256 * 2, SZ_TAB = AL(T_TW + 64 * 64 * 8);
constexpr size_t O_X1 = O_TAB + SZ_TAB, SZ_X1 = (size_t)MTOT * DM * 4;
constexpr size_t O_HB = O_X1 + SZ_X1, SZ_HB = (size_t)MTOT * DM * 2;
constexpr size_t O_PARTS = O_HB + SZ_HB, SZ_PARTS = (size_t)MTOT * INW * 2;
constexpr size_t O_AB = O_PARTS + SZ_PARTS, SZ_BR = (size_t)MTOT * 1024 * 2;
constexpr size_t O_BB = O_AB + SZ_BR, O_CB = O_BB + SZ_BR, O_GB = O_CB + SZ_BR;
constexpr size_t O_ZB = O_GB + SZ_BR, SZ_ZB = (size_t)2 * 64 * 128 * 1024 * 2;
constexpr size_t O_YB = O_ZB + SZ_ZB, SZ_YB = (size_t)MTOT * 2048 * 2;
constexpr size_t O_EB = O_YB + SZ_YB, SZ_EB = (size_t)64 * NCOL * 256 * 4;
constexpr size_t O_HS = O_EB + SZ_EB, SZ_HS = (size_t)64 * NCOL * 256 * 2;
constexpr size_t O_MP = O_ZB;
constexpr size_t O_BAR = O_HS + SZ_HS, SZ_BAR = 16384;
constexpr size_t WS_END = O_BAR + SZ_BAR;
static_assert(SZ_ZB + SZ_YB + SZ_EB >= (size_t)MTOT * DM * 4, "alias");
static_assert(SZ_PARTS >= (size_t)MTOT * DM * 4, "alias");

struct Params {
    const float *x, *c, *ctx, *c_ctx, *w_ada, *b_ada, *g_pre, *g_post, *w_in, *conv_w, *lam_re, *lam_im, *log_dt, *b_re, *b_im, *c_re, *c_im,
        *ssm_d, *glu_wa, *glu_wb, *fourier_w, *proj_a, *proj_b, *proj_c, *w_out;
    float* out; unsigned char* ws;
};
typedef const __attribute__((address_space(4))) Params* KPtr;
#define PREF const __attribute__((address_space(4))) Params&

__device__ __forceinline__ int tid_opaque() { int t = threadIdx.x; asm volatile("" : "+v"(t)); return t; }
__device__ __forceinline__ int bid_opaque() { int b = blockIdx.x; asm volatile("" : "+s"(b)); return b; }
__device__ __forceinline__ float bf2f(unsigned v) { return __uint_as_float(v << 16); }
__device__ __forceinline__ unsigned cvt_pk_bf16(float lo, float hi) { unsigned r; asm volatile("v_cvt_pk_bf16_f32 %0, %1, %2" : "=v"(r) : "v"(lo), "v"(hi)); return r; }
__device__ __forceinline__ float lo_f(unsigned u) { return __uint_as_float(u << 16); }
__device__ __forceinline__ float hi_f(unsigned u) { return __uint_as_float(u & 0xffff0000u); }
__device__ __forceinline__ float sigmoidf_(float x) { return __builtin_amdgcn_rcpf(1.0f + __expf(-x)); }
__device__ __forceinline__ float siluf_(float x) { return x * __builtin_amdgcn_rcpf(1.0f + __expf(-x)); }
__device__ __forceinline__ float gelu_tanh(float x) { const float z = 0.7978845608028654f * (x + 0.044715f * x * x * x); const float t = 1.0f - 2.0f * __builtin_amdgcn_rcpf(__expf(2.0f * z) + 1.0f); return 0.5f * x * (1.0f + t); }
__device__ __forceinline__ float wave_sum(float v, const int lane) {
#pragma unroll
    for (int o = 32; o; o >>= 1) v += __int_as_float(__builtin_amdgcn_ds_bpermute((lane ^ o) << 2, __float_as_int(v)));
    return v;
}
__device__ __forceinline__ void unpack8(const u32x4 u, float (&f)[8]) {
    f[0] = lo_f(u[0]); f[1] = hi_f(u[0]); f[2] = lo_f(u[1]); f[3] = hi_f(u[1]); f[4] = lo_f(u[2]); f[5] = hi_f(u[2]); f[6] = lo_f(u[3]); f[7] = hi_f(u[3]);
}
__device__ __forceinline__ u32x4 pack8(const float (&f)[8]) { u32x4 r; r[0] = cvt_pk_bf16(f[0], f[1]); r[1] = cvt_pk_bf16(f[2], f[3]); r[2] = cvt_pk_bf16(f[4], f[5]); r[3] = cvt_pk_bf16(f[6], f[7]); return r; }

constexpr int BM = 256, BK = 64, HALF = 128, HTB = HALF * BK * 2, STAGE_BYTES = 8 * HTB;
__device__ __forceinline__ int lds_byte(int r, int c) { const int st = (r >> 4) * 2 + (c >> 5), rr = r & 15, cc = c & 31, ob = rr * 64 + cc * 2; return st * 1024 + (ob ^ (((ob >> 9) & 1) << 5)); }
__device__ __forceinline__ void stage_rc(int b, int& R, int& C) { const int st = b / 1024, sb = b % 1024, swz = sb ^ (((sb >> 9) & 1) << 5); R = (st >> 1) * 16 + swz / 64; C = (st & 1) * 32 + (swz % 64) / 2; }
__device__ __forceinline__ int perm32(int rho) { const int n = rho >> 4, i = rho & 15; return 8 * (i >> 2) + 4 * n + (i & 3); }

struct Unit { const char* A; const char* B; int row0, pn, z, half; };

__device__ __forceinline__ void tile_of(int L, int nM, int nN, int& pm, int& pn) {
    const int nwg = nM * nN; int wgid = L;
    { const int q = nwg / 8, r = nwg % 8, xcd = wgid % 8, off = wgid / 8; wgid = (xcd < r ? xcd * (q + 1) : r * (q + 1) + (xcd - r) * q) + off; }
    const int nig = 8 * nN, gid = wgid / nig, fm = gid * 8, gsz = (nM - fm) < 8 ? (nM - fm) : 8;
    pm = fm + ((wgid % nig) % gsz); pn = (wgid % nig) / gsz;
}

template <class Sched, class Epi>
__device__ __forceinline__ void gemm_phase(LAS unsigned char* lds, const Sched& S, const Epi& E, const int K, const int lda, const int ldb) {
    const int tid = tid_opaque(), wid = __builtin_amdgcn_readfirstlane(tid >> 6), lane = tid & 63, wr = wid >> 2, wc = wid & 3, fr = lane & 15, fq = lane >> 4;
    const int nt = K / BK;
    unsigned voffA[2], voffB[2];
#pragma unroll
    for (int i = 0; i < 2; ++i) { int R, C; stage_rc(tid * 16 + i * 8192, R, C); const int Rb = (R & ~31) + perm32(R & 31);
        voffA[i] = (unsigned)(R * lda + C) * 2u; voffB[i] = (unsigned)(Rb * ldb + C) * 2u; }
    const size_t kstep = (size_t)(BK * 2);
    const size_t hstepA = (size_t)HALF * lda * 2, hstepB = (size_t)HALF * ldb * 2;
    const unsigned ldsw = (unsigned)wid * 1024u;
    const int aoff = lds_byte(wr * 64 + fr, fq * 8), boff = lds_byte(wc * 32 + fr, fq * 8);
#define PG8_SA(b, h) (((b) * 2 + (h)) * HTB)
#define PG8_SB(b, h) ((4 + (b) * 2 + (h)) * HTB)
#define PG8_STAGE(bufoff, gbase, voff) do { _Pragma("unroll") for (int _i = 0; _i < 2; ++_i) \
        __builtin_amdgcn_global_load_lds((const unsigned*)((const char*)(gbase) + (voff)[_i]), (LAS unsigned*)(lds + (bufoff) + ldsw + _i * 8192), 16, 0, 0); } while (0)
#define PG8_LDA(dst, b, h) do { _Pragma("unroll") for (int m = 0; m < 4; ++m) _Pragma("unroll") for (int k = 0; k < 2; ++k) dst[m][k] = *(const LAS bf16x8*)(lds + PG8_SA(b, h) + aoff + m * 2048 + k * 1024); } while (0)
#define PG8_LDB(dst, b, h) do { _Pragma("unroll") for (int n = 0; n < 2; ++n) _Pragma("unroll") for (int k = 0; k < 2; ++k) dst[n][k] = *(const LAS bf16x8*)(lds + PG8_SB(b, h) + boff + n * 2048 + k * 1024); } while (0)
#define PG8_MMA(ai, bj, At, Bt) do { __builtin_amdgcn_s_setprio(1); _Pragma("unroll") for (int m = 0; m < 4; ++m) _Pragma("unroll") for (int n = 0; n < 2; ++n) _Pragma("unroll") for (int k = 0; k < 2; ++k) \
        acc[ai][bj][m][n] = __builtin_amdgcn_mfma_f32_16x16x32_bf16(Bt[n][k], At[m][k], acc[ai][bj][m][n], 0, 0, 0); __builtin_amdgcn_s_setprio(0); } while (0)
#define PG8_WAIT_V(n) asm volatile("s_waitcnt vmcnt(" #n ")" ::: "memory")
#define PG8_WAIT_L(n) asm volatile("s_waitcnt lgkmcnt(" #n ")" ::: "memory")
#define PG8_BAR __builtin_amdgcn_s_barrier()
#define PG8_SCHED __builtin_amdgcn_sched_barrier(0)
    Unit cur, nxt; int ui = 0;
    if (!S.next(0, cur)) return;
    f32x4 acc[2][2][4][2];
#pragma unroll
    for (int a = 0; a < 2; ++a)
#pragma unroll
        for (int b = 0; b < 2; ++b)
#pragma unroll
            for (int m = 0; m < 4; ++m)
#pragma unroll
                for (int n = 0; n < 2; ++n) acc[a][b][m][n] = (f32x4){0.f, 0.f, 0.f, 0.f};
    bf16x8 At[4][2], B0[2][2], B1[2][2];
    const char* cA = cur.A; const char* cB = cur.B;
    PG8_STAGE(PG8_SB(0, 0), cB, voffB); PG8_STAGE(PG8_SA(0, 0), cA, voffA); PG8_STAGE(PG8_SB(0, 1), cB + hstepB, voffB); PG8_STAGE(PG8_SA(0, 1), cA + hstepA, voffA);
    if (wr == 1) PG8_BAR;
    PG8_WAIT_V(4); PG8_BAR;
    PG8_STAGE(PG8_SB(1, 0), cB + kstep, voffB); PG8_STAGE(PG8_SA(1, 0), cA + kstep, voffA); PG8_STAGE(PG8_SB(1, 1), cB + hstepB + kstep, voffB);
    PG8_WAIT_V(6); PG8_BAR;
    for (;;) {
        const bool has_next = S.next(ui + 1, nxt);
        const char* nA = has_next ? nxt.A : cA; const char* nB = has_next ? nxt.B : cB;
        const bool chalf = cur.half != 0;
        for (int t = 0; t < nt; t += 2) {
            const bool last = (t == nt - 2);
            const char* a1 = cA + (size_t)(t + 1) * kstep;
            const char* a2 = last ? nA : cA + (size_t)(t + 2) * kstep; const char* b2 = last ? nB : cB + (size_t)(t + 2) * kstep;
            const char* a3 = a2 + kstep; const char* b3 = b2 + kstep;
            PG8_LDB(B0, 0, 0); PG8_SCHED; PG8_LDA(At, 0, 0); PG8_STAGE(PG8_SA(1, 1), a1 + hstepA, voffA);
            PG8_WAIT_L(8); PG8_BAR; PG8_WAIT_L(0); PG8_MMA(0, 0, At, B0); PG8_BAR; PG8_SCHED;
            PG8_LDB(B1, 0, 1); PG8_STAGE(PG8_SB(0, 0), b2, voffB);
            PG8_BAR; PG8_WAIT_L(0); PG8_MMA(0, 1, At, B1); PG8_BAR;
            PG8_LDA(At, 0, 1); PG8_STAGE(PG8_SA(0, 0), a2, voffA);
            PG8_BAR; PG8_WAIT_L(0); if (!chalf) PG8_MMA(1, 0, At, B0); PG8_BAR; PG8_SCHED;
            PG8_STAGE(PG8_SB(0, 1), b2 + hstepB, voffB);
            PG8_WAIT_V(6); PG8_BAR; if (!chalf) PG8_MMA(1, 1, At, B1); PG8_BAR;
            PG8_LDB(B0, 1, 0); PG8_SCHED; PG8_LDA(At, 1, 0); PG8_STAGE(PG8_SA(0, 1), a2 + hstepA, voffA);
            PG8_WAIT_L(8); PG8_BAR; PG8_WAIT_L(0); PG8_MMA(0, 0, At, B0); PG8_BAR; PG8_SCHED;
            PG8_LDB(B1, 1, 1); PG8_STAGE(PG8_SB(1, 0), b3, voffB);
            PG8_BAR; PG8_WAIT_L(0); PG8_MMA(0, 1, At, B1); PG8_BAR;
            PG8_LDA(At, 1, 1); PG8_STAGE(PG8_SA(1, 0), a3, voffA);
            PG8_BAR; PG8_WAIT_L(0); if (!chalf) PG8_MMA(1, 0, At, B0); PG8_BAR; PG8_SCHED;
            PG8_STAGE(PG8_SB(1, 1), b3 + hstepB, voffB);
            PG8_WAIT_V(6); PG8_BAR; if (!chalf) PG8_MMA(1, 1, At, B1); PG8_BAR;
        }
        E(acc, cur, wr, wc, fr, fq);
        if (!has_next) break;
#pragma unroll
        for (int a = 0; a < 2; ++a)
#pragma unroll
            for (int b = 0; b < 2; ++b)
#pragma unroll
                for (int m = 0; m < 4; ++m)
#pragma unroll
                    for (int n = 0; n < 2; ++n) acc[a][b][m][n] = (f32x4){0.f, 0.f, 0.f, 0.f};
        cur = nxt; cA = nA; cB = nB; ++ui;
    }
    PG8_WAIT_V(0);
    if (wr == 0) PG8_BAR;
    PG8_BAR;
#undef PG8_SA
#undef PG8_SB
#undef PG8_STAGE
#undef PG8_LDA
#undef PG8_LDB
#undef PG8_MMA
#undef PG8_WAIT_V
#undef PG8_WAIT_L
#undef PG8_BAR
#undef PG8_SCHED
}

typedef f32x4 AccT[2][2][4][2];
#define EPI_ARGS const AccT& acc, const Unit& u, int wr, int wc, int fr, int fq
#define EPI_FOR_ROWS _Pragma("unroll") for (int ai = 0; ai < 2; ++ai) if (ai == 0 || !u.half) _Pragma("unroll") for (int m = 0; m < 4; ++m)
#define EPI_ROW (u.row0 + wr * 64 + fr + ai * 128 + m * 16)
#define EPI_COL(bj) (u.pn * 256 + wc * 32 + 8 * fq + (bj) * 128)

struct SchedGrid {
    const char* A; const char* B; int nM, nN, lda, ldb, G, c, nh, hrow0, cnt;
    __device__ __forceinline__ bool next(int i, Unit& u) const {
        const long L = (long)i * G + c; const int nfull = nM * nN; if (i >= cnt || L >= (long)nfull + nh * nN) return false;
        int pm;
        if (L < nfull) { tile_of((int)L, nM, nN, pm, u.pn); u.row0 = pm * 256; u.half = 0; }
        else { const int e = (int)L - nfull; u.pn = e % nN; u.row0 = hrow0 + (e / nN) * 128; u.half = 1; }
        u.z = 0; u.A = A + (size_t)u.row0 * lda * 2; u.B = B + (size_t)u.pn * 256 * ldb * 2; return true;
    }
};
struct SchedMerge {
    const char* A0; const char* B0; int nM, G, c, nh, hrow0;
    __device__ __forceinline__ bool next(int i, Unit& u) const {
        const int j = i / 3, br = i - 3 * j; const long L = (long)j * G + c; const int nfull = nM * 8; if (L >= (long)nfull + nh * 8) return false;
        int pm;
        if (L < nfull) { tile_of((int)L, nM, 8, pm, u.pn); u.row0 = pm * 256; u.half = 0; }
        else { const int e = (int)L - nfull; u.pn = e & 7; u.row0 = hrow0 + (e >> 3) * 128; u.half = 1; }
        u.z = br;
        u.A = A0 + (size_t)br * SZ_BR + (size_t)u.row0 * 1024 * 2; u.B = B0 + (size_t)br * SZ_P + (size_t)u.pn * 256 * 1024 * 2; return true;
    }
};
struct SchedWp {
    const unsigned char* ws; int G, c;
    __device__ __forceinline__ bool next(int i, Unit& u) const {
        const long L = (long)i * G + c; if (L >= 64) return false;
        const int l = (int)L >> 5, grp = ((int)L >> 3) & 3, pm = ((int)L >> 1) & 3; u.row0 = pm * 256; u.half = 0; u.pn = (int)L & 1; u.z = l * 4 + grp;
        u.A = (const char*)ws + l * SZ_LAYER + LO_FW + ((size_t)pm * 256 * 1024 + grp * 256) * 2;
        u.B = (const char*)ws + O_TAB + T_CS + (size_t)u.pn * 256 * 256 * 2; return true;
    }
};

struct EpiStoreBf16 { bf16_t* O; int ldc;
    __device__ __forceinline__ void operator()(EPI_ARGS) const {
        EPI_FOR_ROWS { bf16_t* rp = O + (size_t)EPI_ROW * ldc;
#pragma unroll
            for (int bj = 0; bj < 2; ++bj) { const f32x4 v0 = acc[ai][bj][m][0], v1 = acc[ai][bj][m][1]; u32x4 o;
                o[0] = cvt_pk_bf16(v0[0], v0[1]); o[1] = cvt_pk_bf16(v0[2], v0[3]); o[2] = cvt_pk_bf16(v1[0], v1[1]); o[3] = cvt_pk_bf16(v1[2], v1[3]);
                *(u32x4*)(rp + EPI_COL(bj)) = o; } }
    }
};
struct EpiParts { bf16_t* O;
    __device__ __forceinline__ void operator()(EPI_ARGS) const {
        const int c0 = u.pn * 256; size_t eb; int pitch, cl;
        if (c0 < C_U) { eb = E_PC; pitch = 4096; cl = c0; } else if (c0 < C_ZB) { eb = E_PU; pitch = 1024; cl = c0 - C_U; } else if (c0 < C_F) { eb = E_PZB; pitch = 1024; cl = c0 - C_ZB; }
        else if (c0 < C_ZC) { eb = E_PF; pitch = 1024; cl = c0 - C_F; } else if (c0 < C_GL) { eb = E_PZC; pitch = 1024; cl = c0 - C_ZC; } else { eb = E_PGL; pitch = 6144; cl = c0 - C_GL; }
        bf16_t* base = O + eb + cl + wc * 32 + 8 * fq;
        EPI_FOR_ROWS { bf16_t* rp = base + (size_t)EPI_ROW * pitch;
#pragma unroll
            for (int bj = 0; bj < 2; ++bj) { const f32x4 v0 = acc[ai][bj][m][0], v1 = acc[ai][bj][m][1]; u32x4 o;
                o[0] = cvt_pk_bf16(v0[0], v0[1]); o[1] = cvt_pk_bf16(v0[2], v0[3]); o[2] = cvt_pk_bf16(v1[0], v1[1]); o[3] = cvt_pk_bf16(v1[2], v1[3]);
                *(u32x4*)(rp + bj * 128) = o; } }
    }
};
struct EpiStoreF32 { float* O; int ldc;
    __device__ __forceinline__ void operator()(EPI_ARGS) const {
        EPI_FOR_ROWS { float* rp = O + (size_t)EPI_ROW * ldc;
#pragma unroll
            for (int bj = 0; bj < 2; ++bj) { *(f32x4*)(rp + EPI_COL(bj)) = acc[ai][bj][m][0]; *(f32x4*)(rp + EPI_COL(bj) + 4) = acc[ai][bj][m][1]; } }
    }
};
struct EpiWp { unsigned char* ws;
    __device__ __forceinline__ void operator()(EPI_ARGS) const {
        const int l = u.z >> 2, grp = u.z & 3; bf16_t* O = (bf16_t*)(ws + l * SZ_LAYER + LO_WP);
        EPI_FOR_ROWS { bf16_t* rp = O + (size_t)EPI_ROW * 2048 + u.pn * 1024 + grp * 256;
#pragma unroll
            for (int bj = 0; bj < 2; ++bj) { const f32x4 v0 = acc[ai][bj][m][0], v1 = acc[ai][bj][m][1]; u32x4 o;
                o[0] = cvt_pk_bf16(v0[0], v0[1]); o[1] = cvt_pk_bf16(v0[2], v0[3]); o[2] = cvt_pk_bf16(v1[0], v1[1]); o[3] = cvt_pk_bf16(v1[2], v1[3]);
                *(u32x4*)(rp + wc * 32 + 8 * fq + bj * 128) = o; } }
    }
};
struct EpiFourier { const bf16_t* parts; bf16_t* O;
    __device__ __forceinline__ void operator()(EPI_ARGS) const {
#pragma unroll
        for (int ai = 0; ai < 2; ++ai) if (ai == 0 || !u.half) { u32x4 zz[4][2];
#pragma unroll
            for (int m = 0; m < 4; ++m)
#pragma unroll
                for (int bj = 0; bj < 2; ++bj) zz[m][bj] = *(const u32x4*)(parts + E_PZC + (size_t)EPI_ROW * 1024 + EPI_COL(bj));
#pragma unroll
            for (int m = 0; m < 4; ++m)
#pragma unroll
                for (int bj = 0; bj < 2; ++bj) { const f32x4 v0 = acc[ai][bj][m][0], v1 = acc[ai][bj][m][1]; float z[8]; unpack8(zz[m][bj], z); float o[8];
#pragma unroll
                    for (int j = 0; j < 4; ++j) { o[j] = v0[j] * siluf_(z[j]); o[4 + j] = v1[j] * siluf_(z[4 + j]); }
                    *(u32x4*)(O + (size_t)EPI_ROW * 1024 + EPI_COL(bj)) = pack8(o); } }
    }
};
struct EpiGlu { const bf16_t* parts; bf16_t* O;
    __device__ __forceinline__ void operator()(EPI_ARGS) const {
        const int col = u.pn * 128 + wc * 32 + 8 * fq;
#pragma unroll
        for (int ai = 0; ai < 2; ++ai) if (ai == 0 || !u.half) { u32x4 zz[4];
#pragma unroll
            for (int m = 0; m < 4; ++m) zz[m] = *(const u32x4*)(parts + E_PZB + (size_t)EPI_ROW * 1024 + col);
#pragma unroll
            for (int m = 0; m < 4; ++m) { float z[8]; unpack8(zz[m], z);
                const f32x4 a0 = acc[ai][0][m][0], a1 = acc[ai][0][m][1], b0 = acc[ai][1][m][0], b1 = acc[ai][1][m][1]; float o[8];
#pragma unroll
                for (int j = 0; j < 4; ++j) { o[j] = a0[j] * z[j] * __builtin_amdgcn_rcpf((1.0f + __expf(-b0[j])) * (1.0f + __expf(-z[j]))); o[4 + j] = a1[j] * z[4 + j] * __builtin_amdgcn_rcpf((1.0f + __expf(-b1[j])) * (1.0f + __expf(-z[4 + j]))); }
                *(u32x4*)(O + (size_t)EPI_ROW * 1024 + col) = pack8(o); } }
    }
};
struct EpiMerge { const bf16_t* parts; bf16_t* MB;
    __device__ __forceinline__ void operator()(EPI_ARGS) const {
        const int br = u.z; const int nb = u.half ? 2 : 4;
        u32x4 gg[2][4], pp[2][4];
#define MRG_LOAD(slot, bidx_) { const int ai = (bidx_) >> 1, bj = (bidx_) & 1; _Pragma("unroll") for (int m = 0; m < 4; ++m) { \
            gg[slot][m] = *(const u32x4*)(parts + E_PGL + (size_t)EPI_ROW * 6144 + br * DM + EPI_COL(bj)); \
            pp[slot][m] = br > 0 ? *(const u32x4*)(MB + (size_t)EPI_ROW * DM + EPI_COL(bj)) : (u32x4){0u, 0u, 0u, 0u}; } }
#define MRG_EMIT(slot, bidx_) { const int ai = (bidx_) >> 1, bj = (bidx_) & 1; _Pragma("unroll") for (int m = 0; m < 4; ++m) { \
            const f32x4 v0 = acc[ai][bj][m][0], v1 = acc[ai][bj][m][1]; float g[8], pv[8], o[8]; unpack8(gg[slot][m], g); unpack8(pp[slot][m], pv); \
            _Pragma("unroll") for (int j = 0; j < 4; ++j) { o[j] = v0[j] * sigmoidf_(g[j]) + pv[j]; o[4 + j] = v1[j] * sigmoidf_(g[4 + j]) + pv[4 + j]; } \
            *(u32x4*)(MB + (size_t)EPI_ROW * DM + EPI_COL(bj)) = pack8(o); } }
        MRG_LOAD(0, 0)
        MRG_LOAD(1, 1)
        MRG_EMIT(0, 0)
        if (nb > 2) MRG_LOAD(0, 2)
        MRG_EMIT(1, 1)
        if (nb > 2) { MRG_LOAD(1, 3) MRG_EMIT(0, 2) MRG_EMIT(1, 3) }
#undef MRG_LOAD
#undef MRG_EMIT
    }
};

template <int MTL, int NT, class BL>
__device__ __forceinline__ void lmul_core(const bf16_t* __restrict__ D, const int ldd, const int ksteps, const BL& bl, f32x4 (&acc)[MTL][NT], const int lane) {
    const int r = lane & 15, q = lane >> 4;
    const bf16_t* dp = D + (size_t)r * ldd + q * 8;
#pragma unroll
    for (int a = 0; a < MTL; ++a)
#pragma unroll
        for (int b = 0; b < NT; ++b) acc[a][b] = (f32x4){0.f, 0.f, 0.f, 0.f};
#pragma unroll 1
    for (int ks = 0; ks < ksteps; ++ks) {
        bf16x8 bf[NT];
#pragma unroll
        for (int b = 0; b < NT; ++b) bf[b] = bl(ks, b);
#pragma unroll
        for (int a = 0; a < MTL; ++a) { const bf16x8 af = *(const bf16x8*)(dp + (size_t)a * 16 * ldd + ks * 32);
#pragma unroll
            for (int b = 0; b < NT; ++b) acc[a][b] = __builtin_amdgcn_mfma_f32_16x16x32_bf16(af, bf[b], acc[a][b], 0, 0, 0); }
    }
}
template <int MTL>
__device__ __forceinline__ void lmul_g4(const bf16_t* __restrict__ D, const int ldd, const int ksteps, const bf16_t* __restrict__ base, const size_t rs, f32x4 (&acc)[MTL][4], const int lane) {
    const int r = lane & 15, q = lane >> 4;
    const bf16_t* dp = D + (size_t)r * ldd + q * 8;
#pragma unroll
    for (int a = 0; a < MTL; ++a)
#pragma unroll
        for (int b = 0; b < 4; ++b) acc[a][b] = (f32x4){0.f, 0.f, 0.f, 0.f};
    u32x2 w[8];
    { const bf16_t* p = base + (size_t)(q * 8) * rs;
#pragma unroll
      for (int j = 0; j < 8; ++j) w[j] = *(const u32x2*)(p + (size_t)j * rs); }
#pragma unroll 1
    for (int ks = 0; ks < ksteps; ++ks) {
        u32x2 wn[8];
        if (ks + 1 < ksteps) { const bf16_t* p = base + (size_t)((ks + 1) * 32 + q * 8) * rs;
#pragma unroll
            for (int j = 0; j < 8; ++j) wn[j] = *(const u32x2*)(p + (size_t)j * rs); }
        else {
#pragma unroll
            for (int j = 0; j < 8; ++j) wn[j] = w[j]; }
        union { bf16x8 v; unsigned d[4]; } f0, f1, f2, f3;
#pragma unroll
        for (int d = 0; d < 4; ++d) { const unsigned a0 = w[2 * d][0], a1 = w[2 * d + 1][0], c0 = w[2 * d][1], c1 = w[2 * d + 1][1];
            f0.d[d] = (a0 & 0xffffu) | (a1 << 16); f1.d[d] = (a0 >> 16) | (a1 & 0xffff0000u); f2.d[d] = (c0 & 0xffffu) | (c1 << 16); f3.d[d] = (c0 >> 16) | (c1 & 0xffff0000u); }
#pragma unroll
        for (int a = 0; a < MTL; ++a) { const bf16x8 af = *(const bf16x8*)(dp + (size_t)a * 16 * ldd + ks * 32);
            acc[a][0] = __builtin_amdgcn_mfma_f32_16x16x32_bf16(af, f0.v, acc[a][0], 0, 0, 0); acc[a][1] = __builtin_amdgcn_mfma_f32_16x16x32_bf16(af, f1.v, acc[a][1], 0, 0, 0);
            acc[a][2] = __builtin_amdgcn_mfma_f32_16x16x32_bf16(af, f2.v, acc[a][2], 0, 0, 0); acc[a][3] = __builtin_amdgcn_mfma_f32_16x16x32_bf16(af, f3.v, acc[a][3], 0, 0, 0); }
#pragma unroll
        for (int j = 0; j < 8; ++j) w[j] = wn[j];
    }
}
struct BLGather { const bf16_t* base; size_t rs; int lane;
    __device__ __forceinline__ bf16x8 operator()(int ks, int b) const {
        const int q = lane >> 4; const bf16_t* p = base + (size_t)(ks * 32 + q * 8) * rs + b * 16; bf16x8 v;
#pragma unroll
        for (int j = 0; j < 8; ++j) v[j] = (short)p[(size_t)j * rs];
        return v; }
};
__device__ __forceinline__ int ssm_row(int col, int s) { return col < 512 ? ((col >> 8) * SEQ + (col & 255) * 16 + s) : (MX + ((col - 512) >> 4) * LCX + ((col - 512) & 15) * 16 + s); }
template <int KW, bool YST>
__device__ __forceinline__ void ssm_stage_lds(PREF P, const int l, const int wi, unsigned char* shm, const int tid) {
    const int lane = tid & 63, wv = tid >> 6, r = lane & 15, q = lane >> 4;
    const int g = wi >> 2, mh = (wi >> 1) & 1, half = wi & 1;
    unsigned char* wl = P.ws + l * SZ_LAYER; const bf16_t* parts = (const bf16_t*)(P.ws + O_PARTS);
    const bf16_t* D = (const bf16_t*)(wl + (YST ? LO_M2 : LO_M1)) + ((size_t)g * 256 + mh * 128) * KW;
    LAS unsigned char* lds = (LAS unsigned char*)shm;
    constexpr int CPR = KW / 8, KS = KW / 32;
    for (int ch = tid; ch < 128 * CPR; ch += 512) { const int row = ch / CPR, c = ch % CPR; const u32x4 v = *(const u32x4*)(D + (size_t)row * KW + c * 8);
        *(LAS u32x4*)(lds + row * (KW * 2) + ((c ^ (row & 15)) << 4)) = v; }
    __syncthreads();
    const int nct = (YST && l == 1) ? 16 : 17, hsplit = (nct + 1) / 2;
    const int t0 = half == 0 ? 0 : hsplit, t1 = half == 0 ? hsplit : nct;
    const bf16_t* HS = (const bf16_t*)(P.ws + O_HS);
    for (int ct = t0 + wv; ct < t1; ct += 8) {
        f32x4 acc[8][2];
#pragma unroll
        for (int a = 0; a < 8; ++a) { acc[a][0] = (f32x4){0.f, 0.f, 0.f, 0.f}; acc[a][1] = (f32x4){0.f, 0.f, 0.f, 0.f}; }
        const int colA = ct * 32 + r, colB = colA + 16;
        const bf16_t* pu0 = parts + E_PU + (size_t)(ssm_row(colA, 0) + (q >> 1)) * 1024 + g * 16 + (q & 1) * 8;
        const bf16_t* pu1 = parts + E_PU + (size_t)(ssm_row(colB, 0) + (q >> 1)) * 1024 + g * 16 + (q & 1) * 8;
        const bf16_t* ph0 = HS + ((size_t)g * NCOL + colA) * 256 + q * 8; const bf16_t* ph1 = HS + ((size_t)g * NCOL + colB) * 256 + q * 8;
#pragma unroll
        for (int kh = 0; kh < KS / 8; ++kh) {
            bf16x8 bq[8][2];
#pragma unroll
            for (int k8 = 0; k8 < 8; ++k8) {
                if (kh == 0) { bq[k8][0] = *(const bf16x8*)(pu0 + (size_t)k8 * 2 * 1024); bq[k8][1] = *(const bf16x8*)(pu1 + (size_t)k8 * 2 * 1024); }
                else { bq[k8][0] = *(const bf16x8*)(ph0 + k8 * 32); bq[k8][1] = *(const bf16x8*)(ph1 + k8 * 32); } }
#pragma unroll
            for (int k8 = 0; k8 < 8; ++k8) { const int ks = kh * 8 + k8;
                __builtin_amdgcn_sched_barrier(0);
#pragma unroll
                for (int a = 0; a < 8; ++a) { const bf16x8 af = *(const LAS bf16x8*)(lds + (a * 16 + r) * (KW * 2) + (((ks * 4 + q) ^ r) << 4));
                    acc[a][0] = __builtin_amdgcn_mfma_f32_16x16x32_bf16(af, bq[k8][0], acc[a][0], 0, 0, 0); acc[a][1] = __builtin_amdgcn_mfma_f32_16x16x32_bf16(af, bq[k8][1], acc[a][1], 0, 0, 0); }
            }
            __builtin_amdgcn_sched_barrier(0);
        }
        if (!YST) { float* EB = (float*)(P.ws + O_EB);
#pragma unroll
            for (int a = 0; a < 8; ++a)
#pragma unroll
                for (int b = 0; b < 2; ++b) { const int col = ct * 32 + b * 16 + r; *(f32x4*)(EB + ((size_t)g * NCOL + col) * 256 + mh * 128 + a * 16 + q * 4) = acc[a][b]; }
        } else { bf16_t* GB = (bf16_t*)(P.ws + O_GB); const f32x4 dv = *(const f32x4*)(P.ssm_d + l * 1024 + g * 16 + q * 4);
#pragma unroll
            for (int a = 0; a < 8; ++a)
#pragma unroll
                for (int b = 0; b < 2; ++b) { const int col = ct * 32 + b * 16 + r, t = mh * 8 + a, row = ssm_row(col, t);
                    const u32x2 uu = *(const u32x2*)(parts + E_PU + (size_t)row * 1024 + g * 16 + q * 4);
                    const float y0 = gelu_tanh(acc[a][b][0] + dv[0] * lo_f(uu[0])), y1 = gelu_tanh(acc[a][b][1] + dv[1] * hi_f(uu[0])), y2 = gelu_tanh(acc[a][b][2] + dv[2] * lo_f(uu[1])), y3 = gelu_tanh(acc[a][b][3] + dv[3] * hi_f(uu[1]));
                    u32x2 o; o[0] = cvt_pk_bf16(y0, y1); o[1] = cvt_pk_bf16(y2, y3); *(u32x2*)(GB + (size_t)row * 1024 + g * 16 + q * 4) = o; }
        }
    }
    __syncthreads();
}


template <int MODE>
__device__ __forceinline__ void ctx_small_gemm(PREF P, unsigned char* shm) {
    constexpr int K = MODE >= 2 ? 2048 : 1024, ROWS = MODE >= 2 ? 32 : 64, CPR = K / 8, KS = K / 32, NBR = MODE == 1 ? 3 : 1;
    const int tid = tid_opaque(), bidx = bid_opaque(), lane = tid & 63, w = tid >> 6, r = lane & 15, q = lane >> 4;
    unsigned char* wl = P.ws; const bf16_t* parts = (const bf16_t*)(P.ws + O_PARTS); LAS unsigned char* lds = (LAS unsigned char*)shm;
    for (int it = bidx; it < 256; it += gridDim.x) {
        const int rb = MODE >= 2 ? (it >> 4) : (it >> 5), cb = MODE >= 2 ? (it & 15) : (it & 31);
        const int row_base = MX + rb * ROWS;
        const int rt0 = MODE == 0 ? (w >> 1) : (MODE == 1 ? 2 * (w >> 2) : (MODE == 2 ? 0 : (w >> 2))), rt1 = (MODE == 0 || MODE == 3) ? rt0 : rt0 + 1;
        const int col0 = MODE == 0 ? cb * 32 + (w & 1) * 16 : (MODE == 1 ? cb * 64 + (w & 3) * 16 : (MODE == 2 ? cb * 128 + w * 16 : cb * 64 + (w & 3) * 16));
        float msum[2][4];
#pragma unroll
        for (int t = 0; t < 2; ++t)
#pragma unroll
            for (int i = 0; i < 4; ++i) msum[t][i] = 0.f;
#pragma unroll 1
        for (int br = 0; br < NBR; ++br) {
            const bf16_t* Asrc = MODE == 0 ? (const bf16_t*)(P.ws + O_GB) : (MODE == 1 ? (const bf16_t*)(P.ws + O_AB + (size_t)br * SZ_BR) : (MODE == 2 ? (const bf16_t*)(P.ws + O_HB) : (const bf16_t*)(P.ws + O_YB)));
            for (int ch = tid; ch < ROWS * CPR; ch += 512) { const int row = ch / CPR, c = ch % CPR; const u32x4 v = *(const u32x4*)(Asrc + (size_t)(row_base + row) * K + c * 8);
                *(LAS u32x4*)(lds + row * (K * 2) + ((c ^ (row & 15)) << 4)) = v; }
            __syncthreads();
            const bf16_t* W0; const bf16_t* W1;
            if (MODE == 0) { const int oc = col0 + r; W0 = (const bf16_t*)(wl + LO_GLU) + (size_t)((oc >> 7) * 256 + (oc & 127)) * K + q * 8; W1 = W0 + (size_t)128 * K; }
            else if (MODE == 1) { W0 = (const bf16_t*)(wl + LO_PA + (size_t)br * SZ_P) + (size_t)(col0 + r) * K + q * 8; W1 = W0; }
            else if (MODE == 2) { W0 = (const bf16_t*)(wl + LO_WO) + (size_t)(col0 + r) * K + q * 8; W1 = W0; }
            else { W0 = (const bf16_t*)(wl + LO_WP) + (size_t)(col0 + r) * K + q * 8; W1 = W0; }
            f32x4 acc0 = (f32x4){0.f, 0.f, 0.f, 0.f}, acc1 = (f32x4){0.f, 0.f, 0.f, 0.f};
#pragma unroll 4
            for (int ks = 0; ks < KS; ++ks) {
                const bf16x8 a0 = *(const LAS bf16x8*)(lds + (rt0 * 16 + r) * (K * 2) + (((ks * 4 + q) ^ r) << 4));
                const bf16x8 b0 = *(const bf16x8*)(W0 + ks * 32);
                if (MODE == 0) { const bf16x8 b1 = *(const bf16x8*)(W1 + ks * 32);
                    acc0 = __builtin_amdgcn_mfma_f32_16x16x32_bf16(a0, b0, acc0, 0, 0, 0); acc1 = __builtin_amdgcn_mfma_f32_16x16x32_bf16(a0, b1, acc1, 0, 0, 0); }
                else if (MODE == 3) { acc0 = __builtin_amdgcn_mfma_f32_16x16x32_bf16(a0, b0, acc0, 0, 0, 0); }
                else { const bf16x8 a1 = *(const LAS bf16x8*)(lds + (rt1 * 16 + r) * (K * 2) + (((ks * 4 + q) ^ r) << 4));
                    acc0 = __builtin_amdgcn_mfma_f32_16x16x32_bf16(a0, b0, acc0, 0, 0, 0); acc1 = __builtin_amdgcn_mfma_f32_16x16x32_bf16(a1, b0, acc1, 0, 0, 0); }
            }
            const int col = col0 + r;
            if (MODE == 0) { bf16_t* BBo = (bf16_t*)(P.ws + O_BB);
#pragma unroll
                for (int i = 0; i < 4; ++i) { const int row = row_base + rt0 * 16 + q * 4 + i; const float z = bf2f(parts[E_PZB + (size_t)row * 1024 + col]);
                    BBo[(size_t)row * 1024 + col] = (bf16_t)(cvt_pk_bf16(acc0[i] * sigmoidf_(acc1[i]) * siluf_(z), 0.f) & 0xffffu); }
            } else if (MODE == 1) {
#pragma unroll
                for (int i = 0; i < 4; ++i) { const int rowa = row_base + rt0 * 16 + q * 4 + i, rowb = row_base + rt1 * 16 + q * 4 + i;
                    msum[0][i] += acc0[i] * sigmoidf_(bf2f(parts[E_PGL + (size_t)rowa * 6144 + br * DM + col])); msum[1][i] += acc1[i] * sigmoidf_(bf2f(parts[E_PGL + (size_t)rowb * 6144 + br * DM + col])); }
            } else if (MODE == 3) { bf16_t* CBo = (bf16_t*)(P.ws + O_CB);
#pragma unroll
                for (int i = 0; i < 4; ++i) { const int row = row_base + rt0 * 16 + q * 4 + i; const float z = bf2f(parts[E_PZC + (size_t)row * 1024 + col]);
                    CBo[(size_t)row * 1024 + col] = (bf16_t)(cvt_pk_bf16(acc0[i] * siluf_(z), 0.f) & 0xffffu); }
            } else { bf16_t* OBo = (bf16_t*)(P.ws + O_PARTS);
#pragma unroll
                for (int i = 0; i < 4; ++i) { const int rowa = row_base + rt0 * 16 + q * 4 + i, rowb = row_base + rt1 * 16 + q * 4 + i;
                    OBo[(size_t)rowa * DM + col] = (bf16_t)(cvt_pk_bf16(acc0[i], 0.f) & 0xffffu); OBo[(size_t)rowb * DM + col] = (bf16_t)(cvt_pk_bf16(acc1[i], 0.f) & 0xffffu); }
            }
            __syncthreads();
        }
        if (MODE == 1) { bf16_t* MBo = (bf16_t*)(P.ws + O_HB); const int col = col0 + r;
#pragma unroll
            for (int i = 0; i < 4; ++i) { const int rowa = row_base + rt0 * 16 + q * 4 + i, rowb = row_base + rt1 * 16 + q * 4 + i;
                MBo[(size_t)rowa * DM + col] = (bf16_t)(cvt_pk_bf16(msum[0][i], 0.f) & 0xffffu); MBo[(size_t)rowb * DM + col] = (bf16_t)(cvt_pk_bf16(msum[1][i], 0.f) & 0xffffu); }
        }
    }
}

struct TileJob { const float* src; bf16_t* dst; int N, K, k0, n0, drow0; };
constexpr int TILES_PER_LAYER = 4736 + 512;
__device__ __forceinline__ TileJob tile_job(PREF P, int gt) {
    const int l = gt / TILES_PER_LAYER, tt = gt - l * TILES_PER_LAYER; unsigned char* wl = P.ws + l * SZ_LAYER; TileJob J; int kt, nt;
    if (tt < 3584) { J.src = P.w_in + (size_t)l * DM * INW; J.dst = (bf16_t*)(wl + LO_WIN); J.K = DM; J.N = INW; kt = tt & 15; nt = tt >> 4; J.drow0 = nt * 64; }
    else if (tt < 3584 + 768) { const int e = tt - 3584, w = e >> 8, f = e & 255; J.src = (w == 0 ? P.proj_a : (w == 1 ? P.proj_b : P.proj_c)) + (size_t)l * 1024 * DM;
        J.dst = (bf16_t*)(wl + LO_PA + (size_t)w * SZ_P); J.K = 1024; J.N = DM; kt = f & 7; nt = f >> 3; J.drow0 = nt * 64; }
    else if (tt < 4352 + 256) { const int e = tt - 4352, w = e >> 7, f = e & 127; J.src = (w == 0 ? P.glu_wa : P.glu_wb) + (size_t)l * 1024 * 1024; J.dst = (bf16_t*)(wl + LO_GLU);
        J.K = 1024; J.N = 1024; kt = f & 7; nt = f >> 3; const int n0 = nt * 64; J.drow0 = (n0 >> 7) * 256 + (n0 & 127) + w * 128; }
    else if (tt < 4608 + 128) { const int f = tt - 4608; J.src = P.fourier_w + (size_t)l * 1024 * 1024; J.dst = (bf16_t*)(wl + LO_FW); J.K = 1024; J.N = 1024; kt = f & 7; nt = f >> 3; J.drow0 = nt * 64; }
    else { const int f = tt - 4736; J.src = P.w_out + (size_t)l * DM * DM; J.dst = (bf16_t*)(wl + LO_WO); J.K = DM; J.N = DM; kt = f & 15; nt = f >> 4; J.drow0 = nt * 64; }
    J.k0 = kt * 128; J.n0 = nt * 64; return J;
}


__device__ __forceinline__ void mod_item(PREF P, int l, int nt, float* sm) {
    const int tid = tid_opaque(); float* sc = sm; float* red = sm + 3 * 2048;
    for (int i = tid; i < 3 * 2048; i += 512) { const int r = i >> 11, k = i & 2047; const float v = r < 2 ? P.c[r * 2048 + k] : P.c_ctx[k]; sc[i] = siluf_(v); }
    __syncthreads();
    const int col = tid & 63, kg = tid >> 6; const float* w = P.w_ada + (size_t)l * DM * 6144 + nt * 64 + col;
    float a0 = 0.f, a1 = 0.f, a2 = 0.f;
#pragma unroll 16
    for (int k = kg * 256; k < kg * 256 + 256; ++k) { const float wv = w[(size_t)k * 6144]; a0 += sc[k] * wv; a1 += sc[2048 + k] * wv; a2 += sc[4096 + k] * wv; }
    red[(kg * 3 + 0) * 64 + col] = a0; red[(kg * 3 + 1) * 64 + col] = a1; red[(kg * 3 + 2) * 64 + col] = a2;
    __syncthreads();
    if (tid < 192) { const int r = tid >> 6, c = tid & 63; float s = 0.f;
#pragma unroll
        for (int k = 0; k < 8; ++k) s += red[(k * 3 + r) * 64 + c];
        float* MOD = (float*)(P.ws + l * SZ_LAYER + LO_MOD); MOD[r * 6144 + nt * 64 + c] = s + P.b_ada[l * 6144 + nt * 64 + c]; }
    __syncthreads();
}

__device__ __forceinline__ void tables_item(PREF P, int it) {
    const int tid = tid_opaque(); unsigned char* tb = P.ws + O_TAB;
    if (it < 8) {
        bf16_t* T = (bf16_t*)(tb + T_CS);
        for (int e = tid; e < 64 * 256; e += 512) { const int row = it * 64 + (e >> 8), kc = e & 255, cs = row >> 8, j = row & 255; const int mm = (j * kc) & 255;
            float s, c; sincospif((float)mm * (1.0f / 128.0f), &s, &c); T[row * 256 + kc] = (bf16_t)(cvt_pk_bf16((cs ? s : c) * 0.0625f, 0.f) & 0xffffu); }
    } else if (it < 16) {
        bf16_t* T = (bf16_t*)(tb + T_DCTX); const int i8 = it - 8;
        for (int e = tid; e < 64 * 256; e += 512) { const int row = i8 * 64 + (e >> 8), t = e & 255, cs = row >> 8, k = row & 255; const int mm = (k * t) & 255;
            float s, c; sincospif((float)mm * (1.0f / 128.0f), &s, &c); T[row * 256 + t] = (bf16_t)(cvt_pk_bf16((cs ? -s : c) * 0.0625f, 0.f) & 0xffffu); }
    } else {
        bf16_t* D1 = (bf16_t*)(tb + T_D1); bf16_t* D2 = (bf16_t*)(tb + T_D2); float* TW = (float*)(tb + T_TW);
        for (int e = tid; e < 128 * 64; e += 512) { const int row = e >> 6, t1 = e & 63, cs = row >> 6, k1 = row & 63; const int mm = (k1 * t1) & 63;
            float s, c; sincospif((float)mm * (1.0f / 32.0f), &s, &c); D1[e] = (bf16_t)(cvt_pk_bf16((cs ? -s : c) * 0.125f, 0.f) & 0xffffu); }
        for (int e = tid; e < 128 * 128; e += 512) { const int row = e >> 7, col = e & 127, cso = row >> 6, k2 = row & 63, csi = col >> 6, t2 = col & 63; const int mm = (k2 * t2) & 63;
            float s, c; sincospif((float)mm * (1.0f / 32.0f), &s, &c); const float v = (cso == csi) ? c : (cso == 0 ? s : -s);
            D2[e] = (bf16_t)(cvt_pk_bf16(v * 0.125f, 0.f) & 0xffffu); }
        for (int e = tid; e < 64 * 64; e += 512) { const int k1 = e >> 6, t2 = e & 63; float s, c; sincospif((float)(k1 * t2) * (1.0f / 2048.0f), &s, &c); TW[2 * e] = c; TW[2 * e + 1] = -s; }
    }
}

__device__ __forceinline__ void ssm_build(PREF P, int l, int g, float* sm) {
    float* ap_re = sm; float* ap_im = ap_re + 2 * 17 * 64; float* bb_re = ap_im + 2 * 17 * 64; float* bb_im = bb_re + 2 * 64 * 16;
    float* cc_re = bb_im + 2 * 64 * 16; float* cc_im = cc_re + 2 * 16 * 64; float* Kk = cc_im + 2 * 16 * 64;
    const int tid = tid_opaque(); unsigned char* wl = P.ws + l * SZ_LAYER;
    if (tid < 128) {
        const int d = tid >> 6, p = tid & 63; const size_t gi = (size_t)(l * 2 + d) * 64 + g;
        const double lr = (double)P.lam_re[gi * 64 + p], li = (double)P.lam_im[gi * 64 + p], dt = exp((double)P.log_dt[gi]);
        const double a_re = exp(lr * dt) * cos(li * dt), a_im = exp(lr * dt) * sin(li * dt);
        { double pr = 1.0, pi = 0.0;
          for (int tau = 0; tau <= 16; ++tau) { ap_re[(d * 17 + tau) * 64 + p] = (float)pr; ap_im[(d * 17 + tau) * 64 + p] = (float)pi;
              if (tau == 16) { float* A16 = (float*)(wl + LO_A16); A16[((d * 64 + g) * 64 + p) * 2] = (float)pr; A16[((d * 64 + g) * 64 + p) * 2 + 1] = (float)pi; }
              const double nr = pr * a_re - pi * a_im, ni = pr * a_im + pi * a_re; pr = nr; pi = ni; } }
        const double n_re = a_re - 1.0, n_im = a_im, den = lr * lr + li * li;
        const double q_re = (n_re * lr + n_im * li) / den, q_im = (n_im * lr - n_re * li) / den;
        for (int h = 0; h < 16; ++h) { const double br = (double)P.b_re[(gi * 64 + p) * 16 + h], bi = (double)P.b_im[(gi * 64 + p) * 16 + h];
            bb_re[(d * 64 + p) * 16 + h] = (float)(q_re * br - q_im * bi); bb_im[(d * 64 + p) * 16 + h] = (float)(q_re * bi + q_im * br); }
    }
    for (int i = tid; i < 2048; i += 512) { const int d = i >> 10, rem = i & 1023; const size_t s = ((size_t)(l * 2 + d) * 64 + g) * 1024 + rem; cc_re[i] = P.c_re[s]; cc_im[i] = P.c_im[s]; }
    __syncthreads();
    { const int d = tid >> 8, tau = (tid >> 4) & 15, ho = tid & 15; float sacc[16];
#pragma unroll
      for (int hi = 0; hi < 16; ++hi) sacc[hi] = 0.f;
      for (int p = 0; p < 64; ++p) { const float cr = cc_re[(d * 16 + ho) * 64 + p], ci = cc_im[(d * 16 + ho) * 64 + p], ar = ap_re[(d * 17 + tau) * 64 + p], ai = ap_im[(d * 17 + tau) * 64 + p];
          const float wr = cr * ar - ci * ai, wi = cr * ai + ci * ar; const float* br = bb_re + (d * 64 + p) * 16; const float* bi = bb_im + (d * 64 + p) * 16;
#pragma unroll
          for (int hi = 0; hi < 16; ++hi) sacc[hi] += wr * br[hi] - wi * bi[hi]; }
#pragma unroll
      for (int hi = 0; hi < 16; ++hi) Kk[((d * 16 + tau) * 16 + ho) * 16 + hi] = sacc[hi]; }
    __syncthreads();
    bf16_t* M1 = (bf16_t*)(wl + LO_M1) + (size_t)g * 256 * 256; bf16_t* M2 = (bf16_t*)(wl + LO_M2) + (size_t)g * 256 * 512;
    for (int v = tid; v < 8192; v += 512) { const int mrow = v >> 5, k0 = (v & 31) * 8; const int d = mrow >> 7, reim = (mrow >> 6) & 1, p = mrow & 63, s = k0 >> 4, hi0 = k0 & 15;
        const int tau = d == 0 ? 15 - s : s; const float ar = ap_re[(d * 17 + tau) * 64 + p], ai = ap_im[(d * 17 + tau) * 64 + p]; float f[8];
#pragma unroll
        for (int j = 0; j < 8; ++j) { const float br = bb_re[(d * 64 + p) * 16 + hi0 + j], bi = bb_im[(d * 64 + p) * 16 + hi0 + j]; f[j] = reim == 0 ? ar * br - ai * bi : ar * bi + ai * br; }
        *(u32x4*)(M1 + (size_t)mrow * 256 + k0) = pack8(f); }
    for (int v = tid; v < 16384; v += 512) { const int r = v >> 6, k0 = (v & 63) * 8, t = r >> 4, ho = r & 15; float f[8];
        if (k0 < 256) { const int s = k0 >> 4, hi0 = k0 & 15;
#pragma unroll
            for (int j = 0; j < 8; ++j) f[j] = s < t ? Kk[(t - s) * 256 + ho * 16 + hi0 + j] : (s > t ? Kk[(16 + (s - t)) * 256 + ho * 16 + hi0 + j] : Kk[ho * 16 + hi0 + j] + Kk[16 * 256 + ho * 16 + hi0 + j]);
        } else { const int kk = k0 - 256, d = kk >> 7, reim = (kk >> 6) & 1, p0 = kk & 63, tau = d == 0 ? t + 1 : 16 - t;
#pragma unroll
            for (int j = 0; j < 8; ++j) { const int p = p0 + j; const float cr = cc_re[(d * 16 + ho) * 64 + p], ci = cc_im[(d * 16 + ho) * 64 + p], ar = ap_re[(d * 17 + tau) * 64 + p], ai = ap_im[(d * 17 + tau) * 64 + p];
                f[j] = reim == 0 ? cr * ar - ci * ai : -(cr * ai + ci * ar); } }
        *(u32x4*)(M2 + (size_t)r * 512 + k0) = pack8(f); }
    __syncthreads();
}

__device__ __forceinline__ void phase_prep(PREF P, unsigned char* shm) {
    float* sm = (float*)shm; const int b = bid_opaque(), G = gridDim.x;
    for (int it = b; it < 337; it += G) {
        if (it < 128) ssm_build(P, it >> 6, it & 63, sm);
        else if (it < 320) { const int e = it - 128; mod_item(P, e / 96, e % 96, sm); }
        else tables_item(P, it - 320);
    }
    const int total = 2 * TILES_PER_LAYER; int start, cnt;
    if (G == 256) { if (b < 64) { start = b * 38; cnt = 38; } else if (b < 81) { start = 2432 + (b - 64) * 42; cnt = 42; } else { start = 2432 + 17 * 42 + (b - 81) * 43; cnt = 43; } }
    else { cnt = (total + G - 1) / G; start = b * cnt; }
    const int end = (start + cnt) < total ? (start + cnt) : total;
    const int tid = tid_opaque(), lr = tid >> 4, lc = (tid & 15) * 4;
    if (start < end) {
        int cur = start; TileJob J = tile_job(P, cur); f32x4 v[4];
#pragma unroll
        for (int i = 0; i < 4; ++i) v[i] = *(const f32x4*)(J.src + (size_t)(J.k0 + lr + 32 * i) * J.N + J.n0 + lc);
        for (;;) {
#pragma unroll
            for (int i = 0; i < 4; ++i)
#pragma unroll
                for (int j = 0; j < 4; ++j) sm[(lr + 32 * i) * 65 + lc + j] = v[i][j];
            __syncthreads();
            const TileJob C = J; const bool more = cur + 1 < end;
            if (more) { J = tile_job(P, cur + 1);
#pragma unroll
                for (int i = 0; i < 4; ++i) v[i] = *(const f32x4*)(J.src + (size_t)(J.k0 + lr + 32 * i) * J.N + J.n0 + lc); }
            const int n = tid >> 3, kg = tid & 7;
#pragma unroll
            for (int h = 0; h < 2; ++h) { float f[8];
#pragma unroll
                for (int j = 0; j < 8; ++j) f[j] = sm[(kg * 16 + h * 8 + j) * 65 + n];
                *(u32x4*)(C.dst + (size_t)(C.drow0 + n) * C.K + C.k0 + kg * 16 + h * 8) = pack8(f); }
            __syncthreads();
            if (!more) break;
            ++cur;
        }
    }
}

__device__ __forceinline__ void phase_prenorm0(PREF P) {
    const int tidx = tid_opaque(); const int lane = tidx & 63, gw = bid_opaque() * 8 + (tidx >> 6), nw = gridDim.x * 8;
    const float* MOD = (const float*)(P.ws + LO_MOD); bf16_t* HB = (bf16_t*)(P.ws + O_HB);
    for (int row = gw; row < MTOT; row += nw) {
        const float* src = row < MX ? P.x + (size_t)row * DM : P.ctx + (size_t)(row - MX) * DM; const float* md = MOD + (row < MX ? (row >> 12) : 2) * 6144;
        f32x4 v[8]; float ss = 0.f;
#pragma unroll
        for (int i = 0; i < 8; ++i) { v[i] = *(const f32x4*)(src + (i * 64 + lane) * 4); ss += v[i][0] * v[i][0] + v[i][1] * v[i][1] + v[i][2] * v[i][2] + v[i][3] * v[i][3]; }
        ss = wave_sum(ss, lane); const float rinv = rsqrtf(ss * (1.0f / DM) + RMS_EPS);
#pragma unroll
        for (int i = 0; i < 8; ++i) { const int c = (i * 64 + lane) * 4; const f32x4 g = *(const f32x4*)(P.g_pre + c), sh = *(const f32x4*)(md + c), sc = *(const f32x4*)(md + 2048 + c); float h[4];
#pragma unroll
            for (int j = 0; j < 4; ++j) h[j] = v[i][j] * rinv * g[j] * (1.0f + sc[j]) + sh[j];
            u32x2 o; o[0] = cvt_pk_bf16(h[0], h[1]); o[1] = cvt_pk_bf16(h[2], h[3]); *(u32x2*)(HB + (size_t)row * DM + c) = o; }
    }
}
__device__ __forceinline__ void phase_postnorm(PREF P, int l) {
    const int tidx = tid_opaque(); const int lane = tidx & 63, gw = bid_opaque() * 8 + (tidx >> 6), nw = gridDim.x * 8;
    const float* MOD = (const float*)(P.ws + l * SZ_LAYER + LO_MOD); const float* MOD1 = (const float*)(P.ws + SZ_LAYER + LO_MOD);
    bf16_t* HB = (bf16_t*)(P.ws + O_HB); const bf16_t* OB = (const bf16_t*)(P.ws + O_PARTS); float* X1 = (float*)(P.ws + O_X1);
    const int rows = l == 0 ? MTOT : MX;
    for (int row = gw; row < rows; row += nw) {
        const int mr = row < MX ? (row >> 12) : 2; const float* md = MOD + mr * 6144;
        const float* xo = l == 0 ? (row < MX ? P.x + (size_t)row * DM : P.ctx + (size_t)(row - MX) * DM) : X1 + (size_t)row * DM;
        const bf16_t* op = OB + (size_t)row * DM;
        f32x4 o[8], xv[8]; float ss = 0.f;
#pragma unroll
        for (int i = 0; i < 8; ++i) { const u32x2 ob = *(const u32x2*)(op + (i * 64 + lane) * 4); o[i] = (f32x4){lo_f(ob[0]), hi_f(ob[0]), lo_f(ob[1]), hi_f(ob[1])}; xv[i] = *(const f32x4*)(xo + (i * 64 + lane) * 4); ss += o[i][0] * o[i][0] + o[i][1] * o[i][1] + o[i][2] * o[i][2] + o[i][3] * o[i][3]; }
        ss = wave_sum(ss, lane); const float rinv = rsqrtf(ss * (1.0f / DM) + RMS_EPS); float s2 = 0.f;
#pragma unroll
        for (int i = 0; i < 8; ++i) { const int c = (i * 64 + lane) * 4; const f32x4 gp = *(const f32x4*)(P.g_post + l * DM + c), gt = *(const f32x4*)(md + 4096 + c);
#pragma unroll
            for (int j = 0; j < 4; ++j) { xv[i][j] = xv[i][j] + gt[j] * (o[i][j] * rinv * gp[j]); s2 += xv[i][j] * xv[i][j]; }
            if (l == 0) *(f32x4*)(X1 + (size_t)row * DM + c) = xv[i]; else *(f32x4*)(P.out + (size_t)row * DM + c) = xv[i]; }
        if (l == 0) { s2 = wave_sum(s2, lane); const float r2 = rsqrtf(s2 * (1.0f / DM) + RMS_EPS); const float* m1 = MOD1 + mr * 6144;
#pragma unroll
            for (int i = 0; i < 8; ++i) { const int c = (i * 64 + lane) * 4; const f32x4 g = *(const f32x4*)(P.g_pre + DM + c), sh = *(const f32x4*)(m1 + c), sc = *(const f32x4*)(m1 + 2048 + c); float h[4];
#pragma unroll
                for (int j = 0; j < 4; ++j) h[j] = xv[i][j] * r2 * g[j] * (1.0f + sc[j]) + sh[j];
                u32x2 ov; ov[0] = cvt_pk_bf16(h[0], h[1]); ov[1] = cvt_pk_bf16(h[2], h[3]); *(u32x2*)(HB + (size_t)row * DM + c) = ov; } }
    }
}


__device__ __forceinline__ void conv_rows(PREF P, const int l, const int bsub, const int nblk, const int tidx) {
    const bf16_t* parts = (const bf16_t*)(P.ws + O_PARTS); bf16_t* AB = (bf16_t*)(P.ws + O_AB);
    const int rows = l == 0 ? MTOT : MX; const float* cw = P.conv_w + (size_t)l * 3 * 1024;
    for (int idx = bsub * 512 + tidx; idx < (rows >> 2) * 128; idx += nblk * 512) {
        const int r0 = (idx >> 7) * 4, c0 = (idx & 127) * 8; bool lv, rv;
        if (r0 < MX) { const int cp = r0 & 63; lv = cp > 0; rv = cp < 60; } else { const int t = (r0 - MX) & 255; lv = t > 0; rv = t < 252; }
        const bf16_t* pr = parts + E_PC + (size_t)r0 * 4096 + c0;
        u32x4 xr[6], cr[6], br[4], zr[4];
#pragma unroll
        for (int k = 0; k < 6; ++k) { const bool ok = (k == 0) ? lv : ((k == 5) ? rv : true);
            if (ok) { xr[k] = *(const u32x4*)(pr + (ptrdiff_t)(k - 1) * 4096 + C_XA); cr[k] = *(const u32x4*)(pr + (ptrdiff_t)(k - 1) * 4096 + C_CA); }
            else { xr[k] = (u32x4){0u, 0u, 0u, 0u}; cr[k] = (u32x4){0u, 0u, 0u, 0u}; } }
#pragma unroll
        for (int k = 0; k < 4; ++k) { br[k] = *(const u32x4*)(pr + (size_t)k * 4096 + C_BA); zr[k] = *(const u32x4*)(pr + (size_t)k * 4096 + C_ZA); }
        float w0[8], w1[8], w2[8];
#pragma unroll
        for (int j = 0; j < 8; ++j) { w0[j] = cw[c0 + j]; w1[j] = cw[1024 + c0 + j]; w2[j] = cw[2048 + c0 + j]; }
        float v[6][8];
#pragma unroll
        for (int k = 0; k < 6; ++k) { float xa[8], ca[8]; unpack8(xr[k], xa); unpack8(cr[k], ca);
#pragma unroll
            for (int j = 0; j < 8; ++j) v[k][j] = xa[j] * ca[j]; }
#pragma unroll
        for (int k = 0; k < 4; ++k) { float ba[8], za[8], o[8]; unpack8(br[k], ba); unpack8(zr[k], za);
#pragma unroll
            for (int j = 0; j < 8; ++j) { const float y = w0[j] * v[k][j] + w1[j] * v[k + 1][j] + w2[j] * v[k + 2][j]; o[j] = ba[j] * y * siluf_(za[j]); }
            *(u32x4*)(AB + (size_t)(r0 + k) * 1024 + c0) = pack8(o); }
    }
}

__device__ __forceinline__ void phase_mix1(PREF P, int l, unsigned char* shm) {
    const bf16_t* parts = (const bf16_t*)(P.ws + O_PARTS); unsigned char* wl = P.ws + l * SZ_LAYER;
    const int tidx = tid_opaque(), bidx = bid_opaque(); const int lane = tidx & 63, wv = tidx >> 6, r = lane & 15, q = lane >> 4;
    const int gw = bidx * 8 + wv, nw = gridDim.x * 8;
    for (int wi = bidx; wi < 256; wi += gridDim.x) ssm_stage_lds<256, false>(P, l, wi, shm, tidx);
    {
        bf16_t* ZB = (bf16_t*)(P.ws + O_ZB); const bf16_t* D1 = (const bf16_t*)(P.ws + O_TAB + T_D1); const float* TW = (const float*)(P.ws + O_TAB + T_TW);
        for (int it = gw; it < 2048; it += nw) {
            const int cg = it & 15, t2 = (it >> 4) & 63, b = it >> 10;
            f32x4 acc[8][4];
            lmul_g4<8>(D1, 64, 2, parts + E_PF + (size_t)(b * SEQ + t2) * 1024 + cg * 64 + r * 4, (size_t)64 * 1024, acc, lane);
#pragma unroll
            for (int a = 0; a < 4; ++a)
#pragma unroll
                for (int i = 0; i < 4; ++i) { const int k1 = a * 16 + q * 4 + i; const float twr = TW[(k1 * 64 + t2) * 2], twi = TW[(k1 * 64 + t2) * 2 + 1];
                    bf16_t* zr = ZB + ((size_t)((b * 64 + k1) * 128 + t2)) * 1024 + cg * 64 + r * 4; bf16_t* zi = zr + (size_t)64 * 1024; float vr[4], vi[4];
#pragma unroll
                    for (int nb = 0; nb < 4; ++nb) { const float re = acc[a][nb][i], im = acc[a + 4][nb][i]; vr[nb] = re * twr - im * twi; vi[nb] = re * twi + im * twr; }
                    u32x2 o; o[0] = cvt_pk_bf16(vr[0], vr[1]); o[1] = cvt_pk_bf16(vr[2], vr[3]); *(u32x2*)zr = o; o[0] = cvt_pk_bf16(vi[0], vi[1]); o[1] = cvt_pk_bf16(vi[2], vi[3]); *(u32x2*)zi = o; }
        }
    }
}


__device__ __forceinline__ void ctx_dft_item(PREF P, const int it, const int lane) {
    const int r = lane & 15, q = lane >> 4; const bf16_t* parts = (const bf16_t*)(P.ws + O_PARTS);
    bf16_t* YB = (bf16_t*)(P.ws + O_YB); const bf16_t* DC = (const bf16_t*)(P.ws + O_TAB + T_DCTX);
    const int cg = it & 15, mc = (it >> 4) & 3, b = it >> 6;
    f32x4 acc[8][4];
    lmul_g4<8>(DC + (size_t)mc * 128 * 256, 256, 8, parts + E_PF + (size_t)(MX + b * LCX) * 1024 + cg * 64 + r * 4, (size_t)1024, acc, lane);
#pragma unroll
    for (int a = 0; a < 8; ++a)
#pragma unroll
        for (int i = 0; i < 4; ++i) { const int mrow = mc * 128 + a * 16 + q * 4 + i, cs = mrow >> 8, k = mrow & 255;
            bf16_t* yp = YB + (size_t)(MX + b * LCX + k) * 2048 + cs * 1024 + cg * 64 + r * 4;
            u32x2 o; o[0] = cvt_pk_bf16(acc[a][0][i], acc[a][1][i]); o[1] = cvt_pk_bf16(acc[a][2][i], acc[a][3][i]); *(u32x2*)yp = o; }
}

__device__ __forceinline__ void phase_mix2(PREF P, int l) {
    unsigned char* wl = P.ws + l * SZ_LAYER;
    const int tidx = tid_opaque(), bidx = bid_opaque(); const int lane = tidx & 63, wv = tidx >> 6, r = lane & 15, q = lane >> 4;
    const int gw = bidx * 8 + wv, nw = gridDim.x * 8;
    if (wv == 0) {
        const float* EB = (const float*)(P.ws + O_EB); bf16_t* HS = (bf16_t*)(P.ws + O_HS); const float* A16 = (const float*)(wl + LO_A16);
        for (int it = bidx; it < 256; it += gridDim.x) {
            const int d = it & 1, g = (it >> 1) & 63, b = it >> 7, p = lane;
            const float ar = A16[((d * 64 + g) * 64 + p) * 2], ai = A16[((d * 64 + g) * 64 + p) * 2 + 1];
            float hr = 0.f, hi = 0.f;
#define SCAN_COL(j) ((j) < 16 ? 512 + b * 16 + (d ? 15 - (j) : (j)) : b * 256 + (d ? 255 - ((j) - 16) : ((j) - 16)))
#define SCAN_LOAD(er, ei, j0) _Pragma("unroll") for (int jj = 0; jj < 16; ++jj) { const int col = SCAN_COL((j0) + jj); const float* ep = EB + ((size_t)g * NCOL + col) * 256 + d * 128 + p; er[jj] = ep[0]; ei[jj] = ep[64]; }
#define SCAN_STEP(er, ei, j0) _Pragma("unroll") for (int jj = 0; jj < 16; ++jj) { const int col = SCAN_COL((j0) + jj); \
                bf16_t* hp = HS + ((size_t)g * NCOL + col) * 256 + d * 128 + p; const unsigned pk = cvt_pk_bf16(hr, hi); hp[0] = (bf16_t)(pk & 0xffffu); hp[64] = (bf16_t)(pk >> 16); \
                const float nr = ar * hr - ai * hi + er[jj], ni = ar * hi + ai * hr + ei[jj]; hr = nr; hi = ni; }
            float era[16], eia[16], erb[16], eib[16];
            SCAN_LOAD(era, eia, 0)
            for (int it2 = 0; it2 < 8; ++it2) {
                SCAN_LOAD(erb, eib, it2 * 32 + 16)
                SCAN_STEP(era, eia, it2 * 32)
                SCAN_LOAD(era, eia, it2 * 32 + 32)
                SCAN_STEP(erb, eib, it2 * 32 + 16)
            }
            SCAN_STEP(era, eia, 256)
#undef SCAN_COL
#undef SCAN_LOAD
#undef SCAN_STEP
        }
    }
    {
        const bf16_t* ZB = (const bf16_t*)(P.ws + O_ZB); bf16_t* YB = (bf16_t*)(P.ws + O_YB); const bf16_t* D2 = (const bf16_t*)(P.ws + O_TAB + T_D2);
        for (int it = gw; it < 2048; it += nw) {
            const int cg = it & 15, k1 = (it >> 4) & 63, b = it >> 10;
            f32x4 acc[8][4];
            lmul_g4<8>(D2, 128, 4, ZB + (size_t)(b * 64 + k1) * 128 * 1024 + cg * 64 + r * 4, (size_t)1024, acc, lane);
#pragma unroll
            for (int a = 0; a < 8; ++a)
#pragma unroll
                for (int i = 0; i < 4; ++i) { const int mrow = a * 16 + q * 4 + i, cs = mrow >> 6, k2 = mrow & 63;
                    bf16_t* yp = YB + (size_t)(b * SEQ + k1 + 64 * k2) * 2048 + cs * 1024 + cg * 64 + r * 4;
                    u32x2 o; o[0] = cvt_pk_bf16(acc[a][0][i], acc[a][1][i]); o[1] = cvt_pk_bf16(acc[a][2][i], acc[a][3][i]); *(u32x2*)yp = o; }
        }
    }
    if (l == 0 && wv >= 1) { for (int it = bidx * 7 + (wv - 1); it < 128; it += gridDim.x * 7) ctx_dft_item(P, it, lane); }
}

template <int ph>
__device__ __forceinline__ void run_phase(KPtr kp, unsigned char* shm) {
    asm volatile("" : "+s"(kp)); PREF P = *kp;
    LAS unsigned char* lds = (LAS unsigned char*)shm; const int G = gridDim.x, c = bid_opaque();
    if constexpr (ph == 0) { phase_prep(P, shm); return; }
    if constexpr (ph == 1) {
        phase_prenorm0(P);
        return;
    }
    constexpr int l = ph >= 2 ? ((ph - 2) >> 3) : 0, sp = ph >= 2 ? ((ph - 2) & 7) : 0; unsigned char* wl = P.ws + l * SZ_LAYER; constexpr int nM = 32, nh = l == 0 ? 4 : 0;
    const bf16_t* parts = (const bf16_t*)(P.ws + O_PARTS);
    switch (sp) {
    case 0: { EpiParts E{(bf16_t*)(P.ws + O_PARTS)};
        if (l == 0) { SchedGrid S{(const char*)(P.ws + O_HB), (const char*)(wl + LO_WIN), 32, 56, DM, DM, G, c, 4, MX, 1 << 20}; gemm_phase(lds, S, E, DM, DM, DM);
            { const int c3 = bid_opaque(); const int first = G > 224 ? 224 : 0; if (c3 >= first) { SchedWp SW{P.ws, G - first, c3 - first}; EpiWp EW{P.ws}; gemm_phase(lds, SW, EW, 256, 1024, 256); } } }
        else {
            {
                const int tq = tid_opaque(), lane = tq & 63, r = lane & 15, q = lane >> 4; const bf16_t* HB = (const bf16_t*)(P.ws + O_HB); const bf16_t* WT = (const bf16_t*)(wl + LO_WIN); bf16_t* po = (bf16_t*)(P.ws + O_PARTS);
                for (int it = c * 8 + (tq >> 6); it < 2048; it += G * 8) { const int tr = it >> 6, tc = it & 63;
                    const bf16_t* ap = HB + (size_t)(MX + tr * 16 + r) * DM + q * 8; const bf16_t* bp = WT + (size_t)(C_U + tc * 16 + r) * DM + q * 8; f32x4 a4 = (f32x4){0.f, 0.f, 0.f, 0.f};
#pragma unroll 8
                    for (int ks = 0; ks < 64; ++ks) a4 = __builtin_amdgcn_mfma_f32_16x16x32_bf16(*(const bf16x8*)(ap + ks * 32), *(const bf16x8*)(bp + ks * 32), a4, 0, 0, 0);
#pragma unroll
                    for (int i = 0; i < 4; ++i) po[E_PU + (size_t)(MX + tr * 16 + q * 4 + i) * 1024 + tc * 16 + r] = (bf16_t)(cvt_pk_bf16(a4[i], 0.f) & 0xffffu); }
            }
            SchedGrid S{(const char*)(P.ws + O_HB), (const char*)(wl + LO_WIN), 32, 56, DM, DM, G, c, 0, MX, 1 << 20}; gemm_phase(lds, S, E, DM, DM, DM); }
    } break;
    case 1: phase_mix1(P, l, shm); break;
    case 2: phase_mix2(P, l); break;
    case 3: { const int tq = tid_opaque(), c2 = bid_opaque();
        for (int wi = c2; wi < 256; wi += G) ssm_stage_lds<512, true>(P, l, wi, shm, tq);
        conv_rows(P, l, c2, G, tq);
    } break;
    case 4: {
        if (l == 0) { ctx_small_gemm<0>(P, shm); ctx_small_gemm<3>(P, shm); }
        const int nf = nM * 4;
        { const int c1 = bid_opaque(); SchedGrid S{(const char*)(P.ws + O_YB), (const char*)(wl + LO_WP), nM, 4, 2048, 2048, nf, c1, 0, MX, c1 < nf ? 1 : 0}; EpiFourier E{parts, (bf16_t*)(P.ws + O_CB)}; gemm_phase(lds, S, E, 2048, 2048, 2048); }
        { const int c2 = bid_opaque(); const int ng = nM * 8, two = 2 * (G - nf);
          int L0, dL, cn;
          if (G > nf && two <= ng) { if (c2 >= nf) { L0 = 2 * (c2 - nf); dL = 1; cn = 2; } else { L0 = two + c2; dL = nf; cn = (ng - two - c2 + nf - 1) / nf; if (cn < 0) cn = 0; } }
          else { L0 = c2; dL = G; cn = 1 << 20; }
          SchedGrid S{(const char*)(P.ws + O_GB), (const char*)(wl + LO_GLU), nM, 8, 1024, 1024, dL, L0, 0, MX, cn}; EpiGlu E{parts, (bf16_t*)(P.ws + O_BB)}; gemm_phase(lds, S, E, 1024, 1024, 1024); }
    } break;
    case 5: { if (l == 0) ctx_small_gemm<1>(P, shm);
        SchedMerge S{(const char*)(P.ws + O_AB), (const char*)(wl + LO_PA), nM, G, c, 0, MX};
        EpiMerge E{parts, (bf16_t*)(P.ws + O_HB)}; gemm_phase(lds, S, E, 1024, 1024, 1024); } break;
    case 6: { if (l == 0) ctx_small_gemm<2>(P, shm);
        SchedGrid S{(const char*)(P.ws + O_HB), (const char*)(wl + LO_WO), nM, 8, DM, DM, G, c, 0, MX, 1 << 20}; EpiStoreBf16 E{(bf16_t*)(P.ws + O_PARTS), DM}; gemm_phase(lds, S, E, DM, DM, DM); } break;
    default: phase_postnorm(P, l); break;
    }
}

#define XB_TMO      128
#define XB_XCNT(j)  (256  + 64 * (j))
#define XB_XSUB(j)  (1280 + 64 * (j))
#define XB_XGEN(j)  (2304 + 64 * (j))
#define XB_TOP      3328
#define XB_TOPGEN   3392
#define XCD_BAR_WORDS 3456
#define XB_SPIN_CAP (1u << 18)
__device__ __forceinline__ unsigned xb_ld(unsigned* p)              { return __hip_atomic_load(p, __ATOMIC_RELAXED, __HIP_MEMORY_SCOPE_AGENT); }
__device__ __forceinline__ unsigned xb_add(unsigned* p, unsigned v) { return __hip_atomic_fetch_add(p, v, __ATOMIC_RELAXED, __HIP_MEMORY_SCOPE_AGENT); }
__device__ __forceinline__ unsigned xb_xcc_id() { return (unsigned)__builtin_amdgcn_s_getreg((3 << 11) | 20) & 0xFu; }
#define XB_SPIN(cond, bar) do { unsigned _sp = 0; while (cond) { __builtin_amdgcn_s_sleep(1); \
    if ((++_sp & 255u) == 0u) { if (xb_ld(&(bar)[XB_TMO])) break; if (_sp > XB_SPIN_CAP) { atomicAdd(&(bar)[XB_TMO], 1u); break; } } } } while (0)
struct XcdBarrier { unsigned* bar; unsigned x; volatile LAS unsigned* st; };
__device__ __forceinline__ XcdBarrier xcd_barrier_post(unsigned* bar, volatile LAS unsigned* st) {
    XcdBarrier b; b.bar = bar; b.x = xb_xcc_id(); b.st = st;
    if (threadIdx.x == 0) (void)xb_add(&bar[XB_XCNT(b.x)], 1u);
    return b;
}
__device__ __forceinline__ void xcd_barrier_complete(unsigned* bar, unsigned x, unsigned& nloc, unsigned& nx) {
    const unsigned G = gridDim.x * gridDim.y * gridDim.z;
    unsigned sum, cnt, mine, sp = 0u;
    for (;;) {
        sum = 0u; cnt = 0u; mine = 0u;
#pragma unroll
        for (unsigned j = 0; j < 16; ++j) { const unsigned c = xb_ld(&bar[XB_XCNT(j)]); sum += c; cnt += (c > 0u) ? 1u : 0u; mine = (j == x) ? c : mine; }
        if (sum == G) break;
        __builtin_amdgcn_s_sleep(1);
        if ((++sp & 255u) == 0u) { if (xb_ld(&bar[XB_TMO])) break; if (sp > XB_SPIN_CAP) { atomicAdd(&bar[XB_TMO], 1u); break; } }
    }
    nloc = mine > 0u ? mine : 1u; nx = cnt > 0u ? cnt : 1u;
}
__device__ __forceinline__ void xcd_barrier(const XcdBarrier& b) {
    asm volatile("s_waitcnt vmcnt(0)" ::: "memory");
    __syncthreads();
    if (threadIdx.x == 0) {
        unsigned* bar = b.bar;
        __builtin_amdgcn_s_waitcnt(0);
        unsigned nloc = b.st[0], nx = b.st[1];
        if (nloc == 0u) { xcd_barrier_complete(bar, b.x, nloc, nx); b.st[0] = nloc; b.st[1] = nx; }
        const unsigned old = xb_add(&bar[XB_XSUB(b.x)], 1u);
        const unsigned gen = old / nloc;
        if (old + 1u == (gen + 1u) * nloc) {
            __builtin_amdgcn_fence(__ATOMIC_RELEASE, "agent");
            asm volatile("s_waitcnt vmcnt(0)" ::: "memory");
            const unsigned og = xb_add(&bar[XB_TOP], 1u);
            const unsigned tg = og / nx;
            if (og + 1u == (tg + 1u) * nx) xb_add(&bar[XB_TOPGEN], 1u);
            else XB_SPIN(xb_ld(&bar[XB_TOPGEN]) == tg, bar);
            __builtin_amdgcn_fence(__ATOMIC_ACQUIRE, "agent");
            xb_add(&bar[XB_XGEN(b.x)], 1u);
            asm volatile("s_waitcnt vmcnt(0)" ::: "memory");
        } else {
            XB_SPIN(xb_ld(&bar[XB_XGEN(b.x)]) == gen, bar);
            __builtin_amdgcn_fence(__ATOMIC_ACQUIRE, "agent");
            asm volatile("s_waitcnt vmcnt(0)" ::: "memory");
        }
    }
    __syncthreads();
}

constexpr int N_PHASES = 18;

__global__ void __launch_bounds__(512, 2) mega(Params P, int ph0, int ph1) {
    extern __shared__ __attribute__((aligned(16))) unsigned char shm[];
    __shared__ uint4 xb_words;
    if (threadIdx.x == 0) xb_words = make_uint4(0u, 0u, 0u, 0u);
    __syncthreads();
    const XcdBarrier xb = xcd_barrier_post((unsigned*)(P.ws + O_BAR), (volatile LAS unsigned*)&xb_words);
    const KPtr kp = (KPtr)__builtin_amdgcn_kernarg_segment_ptr();
#define RUN_PH(k) if (ph0 <= (k) && (k) < ph1) { if ((k) != ph0) xcd_barrier(xb); run_phase<(k)>(kp, shm); }
    RUN_PH(0) RUN_PH(1) RUN_PH(2) RUN_PH(3) RUN_PH(4) RUN_PH(5) RUN_PH(6) RUN_PH(7) RUN_PH(8) RUN_PH(9)
    RUN_PH(10) RUN_PH(11) RUN_PH(12) RUN_PH(13) RUN_PH(14) RUN_PH(15) RUN_PH(16) RUN_PH(17)
#undef RUN_PH
}

extern "C" void kernel_launch(void* const* d_in, const int* in_sizes, int n_in, void* d_out, int out_size, void* d_ws, size_t ws_size, hipStream_t stream) {
    static int grid_blocks = 0;
    if (!grid_blocks) {
        int dev = 0, cus = 0, per_cu = 0;
        hipGetDevice(&dev); hipDeviceGetAttribute(&cus, hipDeviceAttributeMultiprocessorCount, dev);
        hipFuncSetAttribute((const void*)mega, hipFuncAttributeMaxDynamicSharedMemorySize, STAGE_BYTES);
        hipOccupancyMaxActiveBlocksPerMultiprocessor(&per_cu, (const void*)mega, 512, STAGE_BYTES);
        if (per_cu < 1) { fprintf(stderr, "occupancy query says %d blocks/CU\n", per_cu); per_cu = 1; }
        grid_blocks = cus;
        if (ws_size < WS_END) { fprintf(stderr, "workspace too small: %zu < %zu\n", ws_size, (size_t)WS_END); grid_blocks = -1; }
    }
    if (grid_blocks < 0) return;
    if (hipMemsetAsync((char*)d_ws + O_BAR, 0, SZ_BAR, stream) != hipSuccess) { fprintf(stderr, "memset of barrier words failed\n"); return; }
    Params p{};
    const float** pp = (const float**)&p;
    for (int i = 0; i < 25; ++i) pp[i] = (const float*)d_in[i];
    p.out = (float*)d_out; p.ws = (unsigned char*)d_ws;
    int ph0 = 0, ph1 = N_PHASES;
    void* args[] = {&p, &ph0, &ph1};
    hipError_t e = hipLaunchCooperativeKernel((const void*)mega, dim3(grid_blocks), dim3(512), args, STAGE_BYTES, stream);
    if (e != hipSuccess) fprintf(stderr, "cooperative launch failed: %s (grid %d)\n", hipGetErrorString(e), grid_blocks);
}
```

```cpp
#include <hip/hip_runtime.h>
#include <hip/hip_cooperative_groups.h>
#include <cstdio>
namespace cg = cooperative_groups;

#define LAS __attribute__((address_space(3)))
typedef unsigned short bf16_t;
typedef short bf16x8 __attribute__((ext_vector_type(8)));
typedef float f32x4 __attribute__((ext_vector_type(4)));
typedef unsigned u32x4 __attribute__((ext_vector_type(4)));
typedef unsigned u32x2 __attribute__((ext_vector_type(2)));

constexpr int DM = 2048, NB = 2, SEQ = 4096, LCX = 256, MX = NB * SEQ, MCT = NB * LCX, MTOT = MX + MCT;
constexpr int INW = 14336;
constexpr int C_XA = 0, C_BA = 1024, C_CA = 2048, C_ZA = 3072, C_U = 4096, C_ZB = 5120, C_F = 6144, C_ZC = 7168, C_GL = 8192;
constexpr size_t E_PC = 0, E_PU = (size_t)8704 * 4096, E_PZB = E_PU + (size_t)8704 * 1024, E_PF = E_PZB + (size_t)8704 * 1024, E_PZC = E_PF + (size_t)8704 * 1024, E_PGL = E_PZC + (size_t)8704 * 1024;
constexpr int NCOL = 544;
constexpr float RMS_EPS = 1e-6f;

constexpr size_t AL(size_t x) { return (x + 255) & ~(size_t)255; }
constexpr size_t SZ_WIN = (size_t)INW * DM * 2, SZ_P = (size_t)DM * 1024 * 2, SZ_GLU = (size_t)2048 * 1024 * 2, SZ_FW = (size_t)1024 * 1024 * 2,
                 SZ_WP = (size_t)1024 * 2048 * 2, SZ_WO = (size_t)DM * DM * 2, SZ_M1 = (size_t)64 * 256 * 256 * 2, SZ_M2 = (size_t)64 * 256 * 512 * 2,
                 SZ_A16 = (size_t)2 * 64 * 64 * 2 * 4, SZ_MOD = (size_t)3 * 6144 * 4;
constexpr size_t LO_WIN = 0, LO_PA = LO_WIN + SZ_WIN, LO_PB = LO_PA + SZ_P, LO_PC = LO_PB + SZ_P, LO_GLU = LO_PC + SZ_P, LO_FW = LO_GLU + SZ_GLU,
                 LO_WP = LO_FW + SZ_FW, LO_WO = LO_WP + SZ_WP, LO_M1 = LO_WO + SZ_WO, LO_M2 = LO_M1 + SZ_M1, LO_A16 = LO_M2 + SZ_M2, LO_MOD = LO_A16 + SZ_A16,
                 SZ_LAYER = AL(LO_MOD + SZ_MOD);
constexpr size_t O_TAB = 2 * SZ_LAYER;
constexpr size_t T_CS = 0, T_D1 = T_CS + 512 * 256 * 2, T_D2 = T_D1 + 128 * 64 * 2, T_DCTX = T_D2 + 128 * 128 * 2, T_TW = T_DCTX + 512 * 256 * 2, SZ_TAB = AL(T_TW + 64 * 64 * 8);
constexpr size_t O_X1 = O_TAB + SZ_TAB, SZ_X1 = (size_t)MTOT * DM * 4;
constexpr size_t O_HB = O_X1 + SZ_X1, SZ_HB = (size_t)MTOT * DM * 2;
constexpr size_t O_PARTS = O_HB + SZ_HB, SZ_PARTS = (size_t)MTOT * INW * 2;
constexpr size_t O_AB = O_PARTS + SZ_PARTS, SZ_BR = (size_t)MTOT * 1024 * 2;
constexpr size_t O_BB = O_AB + SZ_BR, O_CB = O_BB + SZ_BR, O_GB = O_CB + SZ_BR;
constexpr size_t O_ZB = O_GB + SZ_BR, SZ_ZB = (size_t)2 * 64 * 128 * 1024 * 2;
constexpr size_t O_YB = O_ZB + SZ_ZB, SZ_YB = (size_t)MTOT * 2048 * 2;
constexpr size_t O_EB = O_YB + SZ_YB, SZ_EB = (size_t)64 * NCOL * 256 * 4;
constexpr size_t O_HS = O_EB + SZ_EB, SZ_HS = (size_t)64 * NCOL * 256 * 2;
constexpr size_t O_MP = O_ZB;
constexpr size_t O_BAR = O_HS + SZ_HS, SZ_BAR = 16384;
constexpr size_t WS_END = O_BAR + SZ_BAR;
static_assert(SZ_ZB + SZ_YB + SZ_EB >= (size_t)MTOT * DM * 4, "alias");
static_assert(SZ_PARTS >= (size_t)MTOT * DM * 4, "alias");

struct Params {
    const float *x, *c, *ctx, *c_ctx, *w_ada, *b_ada, *g_pre, *g_post, *w_in, *conv_w, *lam_re, *lam_im, *log_dt, *b_re, *b_im, *c_re, *c_im,
        *ssm_d, *glu_wa, *glu_wb, *fourier_w, *proj_a, *proj_b, *proj_c, *w_out;
    float* out; unsigned char* ws;
};
typedef const __attribute__((address_space(4))) Params* KPtr;
#define PREF const __attribute__((address_space(4))) Params&

__device__ __forceinline__ int tid_opaque() { int t = threadIdx.x; asm volatile("" : "+v"(t)); return t; }
__device__ __forceinline__ int bid_opaque() { int b = blockIdx.x; asm volatile("" : "+s"(b)); return b; }
__device__ __forceinline__ float bf2f(unsigned v) { return __uint_as_float(v << 16); }
__device__ __forceinline__ unsigned cvt_pk_bf16(float lo, float hi) { unsigned r; asm volatile("v_cvt_pk_bf16_f32 %0, %1, %2" : "=v"(r) : "v"(lo), "v"(hi)); return r; }
__device__ __forceinline__ float lo_f(unsigned u) { return __uint_as_float(u << 16); }
__device__ __forceinline__ float hi_f(unsigned u) { return __uint_as_float(u & 0xffff0000u); }
__device__ __forceinline__ float sigmoidf_(float x) { return __builtin_amdgcn_rcpf(1.0f + __expf(-x)); }
__device__ __forceinline__ float siluf_(float x) { return x * __builtin_amdgcn_rcpf(1.0f + __expf(-x)); }
__device__ __forceinline__ float gelu_tanh(float x) { const float z = 0.7978845608028654f * (x + 0.044715f * x * x * x); const float t = 1.0f - 2.0f * __builtin_amdgcn_rcpf(__expf(2.0f * z) + 1.0f); return 0.5f * x * (1.0f + t); }
__device__ __forceinline__ float wave_sum(float v, const int lane) {
#pragma unroll
    for (int o = 32; o; o >>= 1) v += __int_as_float(__builtin_amdgcn_ds_bpermute((lane ^ o) << 2, __float_as_int(v)));
    return v;
}
__device__ __forceinline__ void unpack8(const u32x4 u, float (&f)[8]) {
    f[0] = lo_f(u[0]); f[1] = hi_f(u[0]); f[2] = lo_f(u[1]); f[3] = hi_f(u[1]); f[4] = lo_f(u[2]); f[5] = hi_f(u[2]); f[6] = lo_f(u[3]); f[7] = hi_f(u[3]);
}
__device__ __forceinline__ u32x4 pack8(const float (&f)[8]) { u32x4 r; r[0] = cvt_pk_bf16(f[0], f[1]); r[1] = cvt_pk_bf16(f[2], f[3]); r[2] = cvt_pk_bf16(f[4], f[5]); r[3] = cvt_pk_bf16(f[6], f[7]); return r; }

constexpr int BM = 256, BK = 64, HALF = 128, HTB = HALF * BK * 2, STAGE_BYTES = 8 * HTB;
__device__ __forceinline__ int lds_byte(int r, int c) { const int st = (r >> 4) * 2 + (c >> 5), rr = r & 15, cc = c & 31, ob = rr * 64 + cc * 2; return st * 1024 + (ob ^ (((ob >> 9) & 1) << 5)); }
__device__ __forceinline__ void stage_rc(int b, int& R, int& C) { const int st = b / 1024, sb = b % 1024, swz = sb ^ (((sb >> 9) & 1) << 5); R = (st >> 1) * 16 + swz / 64; C = (st & 1) * 32 + (swz % 64) / 2; }
__device__ __forceinline__ int perm32(int rho) { const int n = rho >> 4, i = rho & 15; return 8 * (i >> 2) + 4 * n + (i & 3); }

struct Unit { const char* A; const char* B; int row0, pn, z, half; };

__device__ __forceinline__ void tile_of(int L, int nM, int nN, int& pm, int& pn) {
    const int nwg = nM * nN; int wgid = L;
    { const int q = nwg / 8, r = nwg % 8, xcd = wgid % 8, off = wgid / 8; wgid = (xcd < r ? xcd * (q + 1) : r * (q + 1) + (xcd - r) * q) + off; }
    const int nig = 8 * nN, gid = wgid / nig, fm = gid * 8, gsz = (nM - fm) < 8 ? (nM - fm) : 8;
    pm = fm + ((wgid % nig) % gsz); pn = (wgid % nig) / gsz;
}

template <class Sched, class Epi>
__device__ __forceinline__ void gemm_phase(LAS unsigned char* lds, const Sched& S, const Epi& E, const int K, const int lda, const int ldb) {
    const int tid = tid_opaque(), wid = __builtin_amdgcn_readfirstlane(tid >> 6), lane = tid & 63, wr = wid >> 2, wc = wid & 3, fr = lane & 15, fq = lane >> 4;
    const int nt = K / BK;
    unsigned voffA[2], voffB[2];
#pragma unroll
    for (int i = 0; i < 2; ++i) { int R, C; stage_rc(tid * 16 + i * 8192, R, C); const int Rb = (R & ~31) + perm32(R & 31);
        voffA[i] = (unsigned)(R * lda + C) * 2u; voffB[i] = (unsigned)(Rb * ldb + C) * 2u; }
    const size_t kstep = (size_t)(BK * 2);
    const size_t hstepA = (size_t)HALF * lda * 2, hstepB = (size_t)HALF * ldb * 2;
    const unsigned ldsw = (unsigned)wid * 1024u;
    const int aoff = lds_byte(wr * 64 + fr, fq * 8), boff = lds_byte(wc * 32 + fr, fq * 8);
#define PG8_SA(b, h) (((b) * 2 + (h)) * HTB)
#define PG8_SB(b, h) ((4 + (b) * 2 + (h)) * HTB)
#define PG8_STAGE(bufoff, gbase, voff) do { _Pragma("unroll") for (int _i = 0; _i < 2; ++_i) \
        __builtin_amdgcn_global_load_lds((const unsigned*)((const char*)(gbase) + (voff)[_i]), (LAS unsigned*)(lds + (bufoff) + ldsw + _i * 8192), 16, 0, 0); } while (0)
#define PG8_LDA(dst, b, h) do { _Pragma("unroll") for (int m = 0; m < 4; ++m) _Pragma("unroll") for (int k = 0; k < 2; ++k) dst[m][k] = *(const LAS bf16x8*)(lds + PG8_SA(b, h) + aoff + m * 2048 + k * 1024); } while (0)
#define PG8_LDB(dst, b, h) do { _Pragma("unroll") for (int n = 0; n < 2; ++n) _Pragma("unroll") for (int k = 0; k < 2; ++k) dst[n][k] = *(const LAS bf16x8*)(lds + PG8_SB(b, h) + boff + n * 2048 + k * 1024); } while (0)
#define PG8_MMA(ai, bj, At, Bt) do { __builtin_amdgcn_s_setprio(1); _Pragma("unroll") for (int m = 0; m < 4; ++m) _Pragma("unroll") for (int n = 0; n < 2; ++n) _Pragma("unroll") for (int k = 0; k < 2; ++k) \
        acc[ai][bj][m][n] = __builtin_amdgcn_mfma_f32_16x16x32_bf16(Bt[n][k], At[m][k], acc[ai][bj][m][n], 0, 0, 0); __builtin_amdgcn_s_setprio(0); } while (0)
#define PG8_WAIT_V(n) asm volatile("s_waitcnt vmcnt(" #n ")" ::: "memory")
#define PG8_WAIT_L(n) asm volatile("s_waitcnt lgkmcnt(" #n ")" ::: "memory")
#define PG8_BAR __builtin_amdgcn_s_barrier()
#define PG8_SCHED __builtin_amdgcn_sched_barrier(0)
    Unit cur, nxt; int ui = 0;
    if (!S.next(0, cur)) return;
    f32x4 acc[2][2][4][2];
#pragma unroll
    for (int a = 0; a < 2; ++a)
#pragma unroll
        for (int b = 0; b < 2; ++b)
#pragma unroll
            for (int m = 0; m < 4; ++m)
#pragma unroll
                for (int n = 0; n < 2; ++n) acc[a][b][m][n] = (f32x4){0.f, 0.f, 0.f, 0.f};
    bf16x8 At[4][2], B0[2][2], B1[2][2];
    const char* cA = cur.A; const char* cB = cur.B;
    PG8_STAGE(PG8_SB(0, 0), cB, voffB); PG8_STAGE(PG8_SA(0, 0), cA, voffA); PG8_STAGE(PG8_SB(0, 1), cB + hstepB, voffB); PG8_STAGE(PG8_SA(0, 1), cA + hstepA, voffA);
    if (wr == 1) PG8_BAR;
    PG8_WAIT_V(4); PG8_BAR;
    PG8_STAGE(PG8_SB(1, 0), cB + kstep, voffB); PG8_STAGE(PG8_SA(1, 0), cA + kstep, voffA); PG8_STAGE(PG8_SB(1, 1), cB + hstepB + kstep, voffB);
    PG8_WAIT_V(6); PG8_BAR;
    for (;;) {
        const bool has_next = S.next(ui + 1, nxt);
        const char* nA = has_next ? nxt.A : cA; const char* nB = has_next ? nxt.B : cB;
        const bool chalf = cur.half != 0;
        for (int t = 0; t < nt; t += 2) {
            const bool last = (t == nt - 2);
            const char* a1 = cA + (size_t)(t + 1) * kstep;
            const char* a2 = last ? nA : cA + (size_t)(t + 2) * kstep; const char* b2 = last ? nB : cB + (size_t)(t + 2) * kstep;
            const char* a3 = a2 + kstep; const char* b3 = b2 + kstep;
            PG8_LDB(B0, 0, 0); PG8_SCHED; PG8_LDA(At, 0, 0); PG8_STAGE(PG8_SA(1, 1), a1 + hstepA, voffA);
            PG8_WAIT_L(8); PG8_BAR; PG8_WAIT_L(0); PG8_MMA(0, 0, At, B0); PG8_BAR; PG8_SCHED;
            PG8_LDB(B1, 0, 1); PG8_STAGE(PG8_SB(0, 0), b2, voffB);
            PG8_BAR; PG8_WAIT_L(0); PG8_MMA(0, 1, At, B1); PG8_BAR;
            PG8_LDA(At, 0, 1); PG8_STAGE(PG8_SA(0, 0), a2, voffA);
            PG8_BAR; PG8_WAIT_L(0); if (!chalf) PG8_MMA(1, 0, At, B0); PG8_BAR; PG8_SCHED;
            PG8_STAGE(PG8_SB(0, 1), b2 + hstepB, voffB);
            PG8_WAIT_V(6); PG8_BAR; if (!chalf) PG8_MMA(1, 1, At, B1); PG8_BAR;
            PG8_LDB(B0, 1, 0); PG8_SCHED; PG8_LDA(At, 1, 0); PG8_STAGE(PG8_SA(0, 1), a2 + hstepA, voffA);
            PG8_WAIT_L(8); PG8_BAR; PG8_WAIT_L(0); PG8_MMA(0, 0, At, B0); PG8_BAR; PG8_SCHED;
            PG8_LDB(B1, 1, 1); PG8_STAGE(PG8_SB(1, 0), b3, voffB);
            PG8_BAR; PG8_WAIT_L(0); PG8_MMA(0, 1, At, B1); PG8_BAR;
            PG8_LDA(At, 1, 1); PG8_STAGE(PG8_SA(1, 0), a3, voffA);
            PG8_BAR; PG8_WAIT_L(0); if (!chalf) PG8_MMA(1, 0, At, B0); PG8_BAR; PG8_SCHED;
            PG8_STAGE(PG8_SB(1, 1), b3 + hstepB, voffB);
            PG8_WAIT_V(6); PG8_BAR; if (!chalf) PG8_MMA(1, 1, At, B1); PG8_BAR;
        }
        E(acc, cur, wr, wc, fr, fq);
        if (!has_next) break;
#pragma unroll
        for (int a = 0; a < 2; ++a)
#pragma unroll
            for (int b = 0; b < 2; ++b)
#pragma unroll
                for (int m = 0; m < 4; ++m)
#pragma unroll
                    for (int n = 0; n < 2; ++n) acc[a][b][m][n] = (f32x4){0.f, 0.f, 0.f, 0.f};
        cur = nxt; cA = nA; cB = nB; ++ui;
    }
    PG8_WAIT_V(0);
    if (wr == 0) PG8_BAR;
    PG8_BAR;
#undef PG8_SA
#undef PG8_SB
#undef PG8_STAGE
#undef PG8_LDA
#undef PG8_LDB
#undef PG8_MMA
#undef PG8_WAIT_V
#undef PG8_WAIT_L
#undef PG8_BAR
#undef PG8_SCHED
}

typedef f32x4 AccT[2][2][4][2];
#define EPI_ARGS const AccT& acc, const Unit& u, int wr, int wc, int fr, int fq
#define EPI_FOR_ROWS _Pragma("unroll") for (int ai = 0; ai < 2; ++ai) if (ai == 0 || !u.half) _Pragma("unroll") for (int m = 0; m < 4; ++m)
#define EPI_ROW (u.row0 + wr * 64 + fr + ai * 128 + m * 16)
#define EPI_COL(bj) (u.pn * 256 + wc * 32 + 8 * fq + (bj) * 128)

struct SchedGrid {
    const char* A; const char* B; int nM, nN, lda, ldb, G, c, nh, hrow0, cnt;
    __device__ __forceinline__ bool next(int i, Unit& u) const {
        const long L = (long)i * G + c; const int nfull = nM * nN; if (i >= cnt || L >= (long)nfull + nh * nN) return false;
        int pm;
        if (L < nfull) { tile_of((int)L, nM, nN, pm, u.pn); u.row0 = pm * 256; u.half = 0; }
        else { const int e = (int)L - nfull; u.pn = e % nN; u.row0 = hrow0 + (e / nN) * 128; u.half = 1; }
        u.z = 0; u.A = A + (size_t)u.row0 * lda * 2; u.B = B + (size_t)u.pn * 256 * ldb * 2; return true;
    }
};
struct SchedMerge {
    const char* A0; const char* B0; int nM, G, c, nh, hrow0;
    __device__ __forceinline__ bool next(int i, Unit& u) const {
        const int j = i / 3, br = i - 3 * j; const long L = (long)j * G + c; const int nfull = nM * 8; if (L >= (long)nfull + nh * 8) return false;
        int pm;
        if (L < nfull) { tile_of((int)L, nM, 8, pm, u.pn); u.row0 = pm * 256; u.half = 0; }
        else { const int e = (int)L - nfull; u.pn = e & 7; u.row0 = hrow0 + (e >> 3) * 128; u.half = 1; }
        u.z = br;
        u.A = A0 + (size_t)br * SZ_BR + (size_t)u.row0 * 1024 * 2; u.B = B0 + (size_t)br * SZ_P + (size_t)u.pn * 256 * 1024 * 2; return true;
    }
};
struct SchedWp {
    const unsigned char* ws; int G, c;
    __device__ __forceinline__ bool next(int i, Unit& u) const {
        const long L = (long)i * G + c; if (L >= 64) return false;
        const int l = (int)L >> 5, grp = ((int)L >> 3) & 3, pm = ((int)L >> 1) & 3; u.row0 = pm * 256; u.half = 0; u.pn = (int)L & 1; u.z = l * 4 + grp;
        u.A = (const char*)ws + l * SZ_LAYER + LO_FW + ((size_t)pm * 256 * 1024 + grp * 256) * 2;
        u.B = (const char*)ws + O_TAB + T_CS + (size_t)u.pn * 256 * 256 * 2; return true;
    }
};

struct EpiStoreBf16 { bf16_t* O; int ldc;
    __device__ __forceinline__ void operator()(EPI_ARGS) const {
        EPI_FOR_ROWS { bf16_t* rp = O + (size_t)EPI_ROW * ldc;
#pragma unroll
            for (int bj = 0; bj < 2; ++bj) { const f32x4 v0 = acc[ai][bj][m][0], v1 = acc[ai][bj][m][1]; u32x4 o;
                o[0] = cvt_pk_bf16(v0[0], v0[1]); o[1] = cvt_pk_bf16(v0[2], v0[3]); o[2] = cvt_pk_bf16(v1[0], v1[1]); o[3] = cvt_pk_bf16(v1[2], v1[3]);
                *(u32x4*)(rp + EPI_COL(bj)) = o; } }
    }
};
struct EpiParts { bf16_t* O;
    __device__ __forceinline__ void operator()(EPI_ARGS) const {
        const int c0 = u.pn * 256; size_t eb; int pitch, cl;
        if (c0 < C_U) { eb = E_PC; pitch = 4096; cl = c0; } else if (c0 < C_ZB) { eb = E_PU; pitch = 1024; cl = c0 - C_U; } else if (c0 < C_F) { eb = E_PZB; pitch = 1024; cl = c0 - C_ZB; }
        else if (c0 < C_ZC) { eb = E_PF; pitch = 1024; cl = c0 - C_F; } else if (c0 < C_GL) { eb = E_PZC; pitch = 1024; cl = c0 - C_ZC; } else { eb = E_PGL; pitch = 6144; cl = c0 - C_GL; }
        bf16_t* base = O + eb + cl + wc * 32 + 8 * fq;
        EPI_FOR_ROWS { bf16_t* rp = base + (size_t)EPI_ROW * pitch;
#pragma unroll
            for (int bj = 0; bj < 2; ++bj) { const f32x4 v0 = acc[ai][bj][m][0], v1 = acc[ai][bj][m][1]; u32x4 o;
                o[0] = cvt_pk_bf16(v0[0], v0[1]); o[1] = cvt_pk_bf16(v0[2], v0[3]); o[2] = cvt_pk_bf16(v1[0], v1[1]); o[3] = cvt_pk_bf16(v1[2], v1[3]);
                *(u32x4*)(rp + bj * 128) = o; } }
    }
};
struct EpiStoreF32 { float* O; int ldc;
    __device__ __forceinline__ void operator()(EPI_ARGS) const {
        EPI_FOR_ROWS { float* rp = O + (size_t)EPI_ROW * ldc;
#pragma unroll
            for (int bj = 0; bj < 2; ++bj) { *(f32x4*)(rp + EPI_COL(bj)) = acc[ai][bj][m][0]; *(f32x4*)(rp + EPI_COL(bj) + 4) = acc[ai][bj][m][1]; } }
    }
};
struct EpiWp { unsigned char* ws;
    __device__ __forceinline__ void operator()(EPI_ARGS) const {
        const int l = u.z >> 2, grp = u.z & 3; bf16_t* O = (bf16_t*)(ws + l * SZ_LAYER + LO_WP);
        EPI_FOR_ROWS { bf16_t* rp = O + (size_t)EPI_ROW * 2048 + u.pn * 1024 + grp * 256;
#pragma unroll
            for (int bj = 0; bj < 2; ++bj) { const f32x4 v0 = acc[ai][bj][m][0], v1 = acc[ai][bj][m][1]; u32x4 o;
                o[0] = cvt_pk_bf16(v0[0], v0[1]); o[1] = cvt_pk_bf16(v0[2], v0[3]); o[2] = cvt_pk_bf16(v1[0], v1[1]); o[3] = cvt_pk_bf16(v1[2], v1[3]);
                *(u32x4*)(rp + wc * 32 + 8 * fq + bj * 128) = o; } }
    }
};
struct EpiFourier { const bf16_t* parts; bf16_t* O;
    __device__ __forceinline__ void operator()(EPI_ARGS) const {
#pragma unroll
        for (int ai = 0; ai < 2; ++ai) if (ai == 0 || !u.half) { u32x4 zz[4][2];
#pragma unroll
            for (int m = 0; m < 4; ++m)
#pragma unroll
                for (int bj = 0; bj < 2; ++bj) zz[m][bj] = *(const u32x4*)(parts + E_PZC + (size_t)EPI_ROW * 1024 + EPI_COL(bj));
#pragma unroll
            for (int m = 0; m < 4; ++m)
#pragma unroll
                for (int bj = 0; bj < 2; ++bj) { const f32x4 v0 = acc[ai][bj][m][0], v1 = acc[ai][bj][m][1]; float z[8]; unpack8(zz[m][bj], z); float o[8];
#pragma unroll
                    for (int j = 0; j < 4; ++j) { o[j] = v0[j] * siluf_(z[j]); o[4 + j] = v1[j] * siluf_(z[4 + j]); }
                    *(u32x4*)(O + (size_t)EPI_ROW * 1024 + EPI_COL(bj)) = pack8(o); } }
    }
};
struct EpiGlu { const bf16_t* parts; bf16_t* O;
    __device__ __forceinline__ void operator()(EPI_ARGS) const {
        const int col = u.pn * 128 + wc * 32 + 8 * fq;
#pragma unroll
        for (int ai = 0; ai < 2; ++ai) if (ai == 0 || !u.half) { u32x4 zz[4];
#pragma unroll
            for (int m = 0; m < 4; ++m) zz[m] = *(const u32x4*)(parts + E_PZB + (size_t)EPI_ROW * 1024 + col);
#pragma unroll
            for (int m = 0; m < 4; ++m) { float z[8]; unpack8(zz[m], z);
                const f32x4 a0 = acc[ai][0][m][0], a1 = acc[ai][0][m][1], b0 = acc[ai][1][m][0], b1 = acc[ai][1][m][1]; float o[8];
#pragma unroll
                for (int j = 0; j < 4; ++j) { o[j] = a0[j] * z[j] * __builtin_amdgcn_rcpf((1.0f + __expf(-b0[j])) * (1.0f + __expf(-z[j]))); o[4 + j] = a1[j] * z[4 + j] * __builtin_amdgcn_rcpf((1.0f + __expf(-b1[j])) * (1.0f + __expf(-z[4 + j]))); }
                *(u32x4*)(O + (size_t)EPI_ROW * 1024 + col) = pack8(o); } }
    }
};
struct EpiMerge { const bf16_t* parts; bf16_t* MB;
    __device__ __forceinline__ void operator()(EPI_ARGS) const {
        const int br = u.z; const int nb = u.half ? 2 : 4;
        u32x4 gg[2][4], pp[2][4];
#define MRG_LOAD(slot, bidx_) { const int ai = (bidx_) >> 1, bj = (bidx_) & 1; _Pragma("unroll") for (int m = 0; m < 4; ++m) { \
            gg[slot][m] = *(const u32x4*)(parts + E_PGL + (size_t)EPI_ROW * 6144 + br * DM + EPI_COL(bj)); \
            pp[slot][m] = br > 0 ? *(const u32x4*)(MB + (size_t)EPI_ROW * DM + EPI_COL(bj)) : (u32x4){0u, 0u, 0u, 0u}; } }
#define MRG_EMIT(slot, bidx_) { const int ai = (bidx_) >> 1, bj = (bidx_) & 1; _Pragma("unroll") for (int m = 0; m < 4; ++m) { \
            const f32x4 v0 = acc[ai][bj][m][0], v1 = acc[ai][bj][m][1]; float g[8], pv[8], o[8]; unpack8(gg[slot][m], g); unpack8(pp[slot][m], pv); \
            _Pragma("unroll") for (int j = 0; j < 4; ++j) { o[j] = v0[j] * sigmoidf_(g[j]) + pv[j]; o[4 + j] = v1[j] * sigmoidf_(g[4 + j]) + pv[4 + j]; } \
            *(u32x4*)(MB + (size_t)EPI_ROW * DM + EPI_COL(bj)) = pack8(o); } }
        MRG_LOAD(0, 0)
        MRG_LOAD(1, 1)
        MRG_EMIT(0, 0)
        if (nb > 2) MRG_LOAD(0, 2)
        MRG_EMIT(1, 1)
        if (nb > 2) { MRG_LOAD(1, 3) MRG_EMIT(0, 2) MRG_EMIT(1, 3) }
#undef MRG_LOAD
#undef MRG_EMIT
    }
};

template <int MTL, int NT, class BL>
__device__ __forceinline__ void lmul_core(const bf16_t* __restrict__ D, const int ldd, const int ksteps, const BL& bl, f32x4 (&acc)[MTL][NT], const int lane) {
    const int r = lane & 15, q = lane >> 4;
    const bf16_t* dp = D + (size_t)r * ldd + q * 8;
#pragma unroll
    for (int a = 0; a < MTL; ++a)
#pragma unroll
        for (int b = 0; b < NT; ++b) acc[a][b] = (f32x4){0.f, 0.f, 0.f, 0.f};
#pragma unroll 1
    for (int ks = 0; ks < ksteps; ++ks) {
        bf16x8 bf[NT];
#pragma unroll
        for (int b = 0; b < NT; ++b) bf[b] = bl(ks, b);
#pragma unroll
        for (int a = 0; a < MTL; ++a) { const bf16x8 af = *(const bf16x8*)(dp + (size_t)a * 16 * ldd + ks * 32);
#pragma unroll
            for (int b = 0; b < NT; ++b) acc[a][b] = __builtin_amdgcn_mfma_f32_16x16x32_bf16(af, bf[b], acc[a][b], 0, 0, 0); }
    }
}
template <int MTL>
__device__ __forceinline__ void lmul_g4(const bf16_t* __restrict__ D, const int ldd, const int ksteps, const bf16_t* __restrict__ base, const size_t rs, f32x4 (&acc)[MTL][4], const int lane) {
    const int r = lane & 15, q = lane >> 4;
    const bf16_t* dp = D + (size_t)r * ldd + q * 8;
#pragma unroll
    for (int a = 0; a < MTL; ++a)
#pragma unroll
        for (int b = 0; b < 4; ++b) acc[a][b] = (f32x4){0.f, 0.f, 0.f, 0.f};
    u32x2 w[8];
    { const bf16_t* p = base + (size_t)(q * 8) * rs;
#pragma unroll
      for (int j = 0; j < 8; ++j) w[j] = *(const u32x2*)(p + (size_t)j * rs); }
#pragma unroll 1
    for (int ks = 0; ks < ksteps; ++ks) {
        u32x2 wn[8];
        if (ks + 1 < ksteps) { const bf16_t* p = base + (size_t)((ks + 1) * 32 + q * 8) * rs;
#pragma unroll
            for (int j = 0; j < 8; ++j) wn[j] = *(const u32x2*)(p + (size_t)j * rs); }
        else {
#pragma unroll
            for (int j = 0; j < 8; ++j) wn[j] = w[j]; }
        union { bf16x8 v; unsigned d[4]; } f0, f1, f2, f3;
#pragma unroll
        for (int d = 0; d < 4; ++d) { const unsigned a0 = w[2 * d][0], a1 = w[2 * d + 1][0], c0 = w[2 * d][1], c1 = w[2 * d + 1][1];
            f0.d[d] = (a0 & 0xffffu) | (a1 << 16); f1.d[d] = (a0 >> 16) | (a1 & 0xffff0000u); f2.d[d] = (c0 & 0xffffu) | (c1 << 16); f3.d[d] = (c0 >> 16) | (c1 & 0xffff0000u); }
#pragma unroll
        for (int a = 0; a < MTL; ++a) { const bf16x8 af = *(const bf16x8*)(dp + (size_t)a * 16 * ldd + ks * 32);
            acc[a][0] = __builtin_amdgcn_mfma_f32_16x16x32_bf16(af, f0.v, acc[a][0], 0, 0, 0); acc[a][1] = __builtin_amdgcn_mfma_f32_16x16x32_bf16(af, f1.v, acc[a][1], 0, 0, 0);
            acc[a][2] = __builtin_amdgcn_mfma_f32_16x16x32_bf16(af, f2.v, acc[a][2], 0, 0, 0); acc[a][3] = __builtin_amdgcn_mfma_f32_16x16x32_bf16(af, f3.v, acc[a][3], 0, 0, 0); }
#pragma unroll
        for (int j = 0; j < 8; ++j) w[j] = wn[j];
    }
}
struct BLGather { const bf16_t* base; size_t rs; int lane;
    __device__ __forceinline__ bf16x8 operator()(int ks, int b) const {
        const int q = lane >> 4; const bf16_t* p = base + (size_t)(ks * 32 + q * 8) * rs + b * 16; bf16x8 v;
#pragma unroll
        for (int j = 0; j < 8; ++j) v[j] = (short)p[(size_t)j * rs];
        return v; }
};
__device__ __forceinline__ int ssm_row(int col, int s) { return col < 512 ? ((col >> 8) * SEQ + (col & 255) * 16 + s) : (MX + ((col - 512) >> 4) * LCX + ((col - 512) & 15) * 16 + s); }
template <int KW, bool YST>
__device__ __forceinline__ void ssm_stage_lds(PREF P, const int l, const int wi, unsigned char* shm, const int tid) {
    const int lane = tid & 63, wv = tid >> 6, r = lane & 15, q = lane >> 4;
    const int g = wi >> 2, mh = (wi >> 1) & 1, half = wi & 1;
    unsigned char* wl = P.ws + l * SZ_LAYER; const bf16_t* parts = (const bf16_t*)(P.ws + O_PARTS);
    const bf16_t* D = (const bf16_t*)(wl + (YST ? LO_M2 : LO_M1)) + ((size_t)g * 256 + mh * 128) * KW;
    LAS unsigned char* lds = (LAS unsigned char*)shm;
    constexpr int CPR = KW / 8, KS = KW / 32;
    for (int ch = tid; ch < 128 * CPR; ch += 512) { const int row = ch / CPR, c = ch % CPR; const u32x4 v = *(const u32x4*)(D + (size_t)row * KW + c * 8);
        *(LAS u32x4*)(lds + row * (KW * 2) + ((c ^ (row & 15)) << 4)) = v; }
    __syncthreads();
    const int nct = (YST && l == 1) ? 16 : 17, hsplit = (nct + 1) / 2;
    const int t0 = half == 0 ? 0 : hsplit, t1 = half == 0 ? hsplit : nct;
    const bf16_t* HS = (const bf16_t*)(P.ws + O_HS);
    for (int ct = t0 + wv; ct < t1; ct += 8) {
        f32x4 acc[8][2];
#pragma unroll
        for (int a = 0; a < 8; ++a) { acc[a][0] = (f32x4){0.f, 0.f, 0.f, 0.f}; acc[a][1] = (f32x4){0.f, 0.f, 0.f, 0.f}; }
        const int colA = ct * 32 + r, colB = colA + 16;
        const bf16_t* pu0 = parts + E_PU + (size_t)(ssm_row(colA, 0) + (q >> 1)) * 1024 + g * 16 + (q & 1) * 8;
        const bf16_t* pu1 = parts + E_PU + (size_t)(ssm_row(colB, 0) + (q >> 1)) * 1024 + g * 16 + (q & 1) * 8;
        const bf16_t* ph0 = HS + ((size_t)g * NCOL + colA) * 256 + q * 8; const bf16_t* ph1 = HS + ((size_t)g * NCOL + colB) * 256 + q * 8;
#pragma unroll
        for (int kh = 0; kh < KS / 8; ++kh) {
            bf16x8 bq[8][2];
#pragma unroll
            for (int k8 = 0; k8 < 8; ++k8) {
                if (kh == 0) { bq[k8][0] = *(const bf16x8*)(pu0 + (size_t)k8 * 2 * 1024); bq[k8][1] = *(const bf16x8*)(pu1 + (size_t)k8 * 2 * 1024); }
                else { bq[k8][0] = *(const bf16x8*)(ph0 + k8 * 32); bq[k8][1] = *(const bf16x8*)(ph1 + k8 * 32); } }
#pragma unroll
            for (int k8 = 0; k8 < 8; ++k8) { const int ks = kh * 8 + k8;
                __builtin_amdgcn_sched_barrier(0);
#pragma unroll
                for (int a = 0; a < 8; ++a) { const bf16x8 af = *(const LAS bf16x8*)(lds + (a * 16 + r) * (KW * 2) + (((ks * 4 + q) ^ r) << 4));
                    acc[a][0] = __builtin_amdgcn_mfma_f32_16x16x32_bf16(af, bq[k8][0], acc[a][0], 0, 0, 0); acc[a][1] = __builtin_amdgcn_mfma_f32_16x16x32_bf16(af, bq[k8][1], acc[a][1], 0, 0, 0); }
            }
            __builtin_amdgcn_sched_barrier(0);
        }
        if (!YST) { float* EB = (float*)(P.ws + O_EB);
#pragma unroll
            for (int a = 0; a < 8; ++a)
#pragma unroll
                for (int b = 0; b < 2; ++b) { const int col = ct * 32 + b * 16 + r; *(f32x4*)(EB + ((size_t)g * NCOL + col) * 256 + mh * 128 + a * 16 + q * 4) = acc[a][b]; }
        } else { bf16_t* GB = (bf16_t*)(P.ws + O_GB); const f32x4 dv = *(const f32x4*)(P.ssm_d + l * 1024 + g * 16 + q * 4);
#pragma unroll
            for (int a = 0; a < 8; ++a)
#pragma unroll
                for (int b = 0; b < 2; ++b) { const int col = ct * 32 + b * 16 + r, t = mh * 8 + a, row = ssm_row(col, t);
                    const u32x2 uu = *(const u32x2*)(parts + E_PU + (size_t)row * 1024 + g * 16 + q * 4);
                    const float y0 = gelu_tanh(acc[a][b][0] + dv[0] * lo_f(uu[0])), y1 = gelu_tanh(acc[a][b][1] + dv[1] * hi_f(uu[0])), y2 = gelu_tanh(acc[a][b][2] + dv[2] * lo_f(uu[1])), y3 = gelu_tanh(acc[a][b][3] + dv[3] * hi_f(uu[1]));
                    u32x2 o; o[0] = cvt_pk_bf16(y0, y1); o[1] = cvt_pk_bf16(y2, y3); *(u32x2*)(GB + (size_t)row * 1024 + g * 16 + q * 4) = o; }
        }
    }
    __syncthreads();
}


template <int MODE>
__device__ __forceinline__ void ctx_small_gemm(PREF P, unsigned char* shm) {
    constexpr int K = MODE >= 2 ? 2048 : 1024, ROWS = MODE >= 2 ? 32 : 64, CPR = K / 8, KS = K / 32, NBR = MODE == 1 ? 3 : 1;
    const int tid = tid_opaque(), bidx = bid_opaque(), lane = tid & 63, w = tid >> 6, r = lane & 15, q = lane >> 4;
    unsigned char* wl = P.ws; const bf16_t* parts = (const bf16_t*)(P.ws + O_PARTS); LAS unsigned char* lds = (LAS unsigned char*)shm;
    for (int it = bidx; it < 256; it += gridDim.x) {
        const int rb = MODE >= 2 ? (it >> 4) : (it >> 5), cb = MODE >= 2 ? (it & 15) : (it & 31);
        const int row_base = MX + rb * ROWS;
        const int rt0 = MODE == 0 ? (w >> 1) : (MODE == 1 ? 2 * (w >> 2) : (MODE == 2 ? 0 : (w >> 2))), rt1 = (MODE == 0 || MODE == 3) ? rt0 : rt0 + 1;
        const int col0 = MODE == 0 ? cb * 32 + (w & 1) * 16 : (MODE == 1 ? cb * 64 + (w & 3) * 16 : (MODE == 2 ? cb * 128 + w * 16 : cb * 64 + (w & 3) * 16));
        float msum[2][4];
#pragma unroll
        for (int t = 0; t < 2; ++t)
#pragma unroll
            for (int i = 0; i < 4; ++i) msum[t][i] = 0.f;
#pragma unroll 1
        for (int br = 0; br < NBR; ++br) {
            const bf16_t* Asrc = MODE == 0 ? (const bf16_t*)(P.ws + O_GB) : (MODE == 1 ? (const bf16_t*)(P.ws + O_AB + (size_t)br * SZ_BR) : (MODE == 2 ? (const bf16_t*)(P.ws + O_HB) : (const bf16_t*)(P.ws + O_YB)));
            for (int ch = tid; ch < ROWS * CPR; ch += 512) { const int row = ch / CPR, c = ch % CPR; const u32x4 v = *(const u32x4*)(Asrc + (size_t)(row_base + row) * K + c * 8);
                *(LAS u32x4*)(lds + row * (K * 2) + ((c ^ (row & 15)) << 4)) = v; }
            __syncthreads();
            const bf16_t* W0; const bf16_t* W1;
            if (MODE == 0) { const int oc = col0 + r; W0 = (const bf16_t*)(wl + LO_GLU) + (size_t)((oc >> 7) * 256 + (oc & 127)) * K + q * 8; W1 = W0 + (size_t)128 * K; }
            else if (MODE == 1) { W0 = (const bf16_t*)(wl + LO_PA + (size_t)br * SZ_P) + (size_t)(col0 + r) * K + q * 8; W1 = W0; }
            else if (MODE == 2) { W0 = (const bf16_t*)(wl + LO_WO) + (size_t)(col0 + r) * K + q * 8; W1 = W0; }
            else { W0 = (const bf16_t*)(wl + LO_WP) + (size_t)(col0 + r) * K + q * 8; W1 = W0; }
            f32x4 acc0 = (f32x4){0.f, 0.f, 0.f, 0.f}, acc1 = (f32x4){0.f, 0.f, 0.f, 0.f};
#pragma unroll 4
            for (int ks = 0; ks < KS; ++ks) {
                const bf16x8 a0 = *(const LAS bf16x8*)(lds + (rt0 * 16 + r) * (K * 2) + (((ks * 4 + q) ^ r) << 4));
                const bf16x8 b0 = *(const bf16x8*)(W0 + ks * 32);
                if (MODE == 0) { const bf16x8 b1 = *(const bf16x8*)(W1 + ks * 32);
                    acc0 = __builtin_amdgcn_mfma_f32_16x16x32_bf16(a0, b0, acc0, 0, 0, 0); acc1 = __builtin_amdgcn_mfma_f32_16x16x32_bf16(a0, b1, acc1, 0, 0, 0); }
                else if (MODE == 3) { acc0 = __builtin_amdgcn_mfma_f32_16x16x32_bf16(a0, b0, acc0, 0, 0, 0); }
                else { const bf16x8 a1 = *(const LAS bf16x8*)(lds + (rt1 * 16 + r) * (K * 2) + (((ks * 4 + q) ^ r) << 4));
                    acc0 = __builtin_amdgcn_mfma_f32_16x16x32_bf16(a0, b0, acc0, 0, 0, 0); acc1 = __builtin_amdgcn_mfma_f32_16x16x32_bf16(a1, b0, acc1, 0, 0, 0); }
            }
            const int col = col0 + r;
            if (MODE == 0) { bf16_t* BBo = (bf16_t*)(P.ws + O_BB);
#pragma unroll
                for (int i = 0; i < 4; ++i) { const int row = row_base + rt0 * 16 + q * 4 + i; const float z = bf2f(parts[E_PZB + (size_t)row * 1024 + col]);
                    BBo[(size_t)row * 1024 + col] = (bf16_t)(cvt_pk_bf16(acc0[i] * sigmoidf_(acc1[i]) * siluf_(z), 0.f) & 0xffffu); }
            } else if (MODE == 1) {
#pragma unroll
                for (int i = 0; i < 4; ++i) { const int rowa = row_base + rt0 * 16 + q * 4 + i, rowb = row_base + rt1 * 16 + q * 4 + i;
                    msum[0][i] += acc0[i] * sigmoidf_(bf2f(parts[E_PGL + (size_t)rowa * 6144 + br * DM + col])); msum[1][i] += acc1[i] * sigmoidf_(bf2f(parts[E_PGL + (size_t)rowb * 6144 + br * DM + col])); }
            } else if (MODE == 3) { bf16_t* CBo = (bf16_t*)(P.ws + O_CB);
#pragma unroll
                for (int i = 0; i < 4; ++i) { const int row = row_base + rt0 * 16 + q * 4 + i; const float z = bf2f(parts[E_PZC + (size_t)row * 1024 + col]);
                    CBo[(size_t)row * 1024 + col] = (bf16_t)(cvt_pk_bf16(acc0[i] * siluf_(z), 0.f) & 0xffffu); }
            } else { bf16_t* OBo = (bf16_t*)(P.ws + O_PARTS);
#pragma unroll
                for (int i = 0; i < 4; ++i) { const int rowa = row_base + rt0 * 16 + q * 4 + i, rowb = row_base + rt1 * 16 + q * 4 + i;
                    OBo[(size_t)rowa * DM + col] = (bf16_t)(cvt_pk_bf16(acc0[i], 0.f) & 0xffffu); OBo[(size_t)rowb * DM + col] = (bf16_t)(cvt_pk_bf16(acc1[i], 0.f) & 0xffffu); }
            }
            __syncthreads();
        }
        if (MODE == 1) { bf16_t* MBo = (bf16_t*)(P.ws + O_HB); const int col = col0 + r;
#pragma unroll
            for (int i = 0; i < 4; ++i) { const int rowa = row_base + rt0 * 16 + q * 4 + i, rowb = row_base + rt1 * 16 + q * 4 + i;
                MBo[(size_t)rowa * DM + col] = (bf16_t)(cvt_pk_bf16(msum[0][i], 0.f) & 0xffffu); MBo[(size_t)rowb * DM + col] = (bf16_t)(cvt_pk_bf16(msum[1][i], 0.f) & 0xffffu); }
        }
    }
}

struct TileJob { const float* src; bf16_t* dst; int N, K, k0, n0, drow0; };
constexpr int TILES_PER_LAYER = 4736 + 512;
__device__ __forceinline__ TileJob tile_job(PREF P, int gt) {
    const int l = gt / TILES_PER_LAYER, tt = gt - l * TILES_PER_LAYER; unsigned char* wl = P.ws + l * SZ_LAYER; TileJob J; int kt, nt;
    if (tt < 3584) { J.src = P.w_in + (size_t)l * DM * INW; J.dst = (bf16_t*)(wl + LO_WIN); J.K = DM; J.N = INW; kt = tt & 15; nt = tt >> 4; J.drow0 = nt * 64; }
    else if (tt < 3584 + 768) { const int e = tt - 3584, w = e >> 8, f = e & 255; J.src = (w == 0 ? P.proj_a : (w == 1 ? P.proj_b : P.proj_c)) + (size_t)l * 1024 * DM;
        J.dst = (bf16_t*)(wl + LO_PA + (size_t)w * SZ_P); J.K = 1024; J.N = DM; kt = f & 7; nt = f >> 3; J.drow0 = nt * 64; }
    else if (tt < 4352 + 256) { const int e = tt - 4352, w = e >> 7, f = e & 127; J.src = (w == 0 ? P.glu_wa : P.glu_wb) + (size_t)l * 1024 * 1024; J.dst = (bf16_t*)(wl + LO_GLU);
        J.K = 1024; J.N = 1024; kt = f & 7; nt = f >> 3; const int n0 = nt * 64; J.drow0 = (n0 >> 7) * 256 + (n0 & 127) + w * 128; }
    else if (tt < 4608 + 128) { const int f = tt - 4608; J.src = P.fourier_w + (size_t)l * 1024 * 1024; J.dst = (bf16_t*)(wl + LO_FW); J.K = 1024; J.N = 1024; kt = f & 7; nt = f >> 3; J.drow0 = nt * 64; }
    else { const int f = tt - 4736; J.src = P.w_out + (size_t)l * DM * DM; J.dst = (bf16_t*)(wl + LO_WO); J.K = DM; J.N = DM; kt = f & 15; nt = f >> 4; J.drow0 = nt * 64; }
    J.k0 = kt * 128; J.n0 = nt * 64; return J;
}


__device__ __forceinline__ void mod_item(PREF P, int l, int nt, float* sm) {
    const int tid = tid_opaque(); float* sc = sm; float* red = sm + 3 * 2048;
    for (int i = tid; i < 3 * 2048; i += 512) { const int r = i >> 11, k = i & 2047; const float v = r < 2 ? P.c[r * 2048 + k] : P.c_ctx[k]; sc[i] = siluf_(v); }
    __syncthreads();
    const int col = tid & 63, kg = tid >> 6; const float* w = P.w_ada + (size_t)l * DM * 6144 + nt * 64 + col;
    float a0 = 0.f, a1 = 0.f, a2 = 0.f;
#pragma unroll 16
    for (int k = kg * 256; k < kg * 256 + 256; ++k) { const float wv = w[(size_t)k * 6144]; a0 += sc[k] * wv; a1 += sc[2048 + k] * wv; a2 += sc[4096 + k] * wv; }
    red[(kg * 3 + 0) * 64 + col] = a0; red[(kg * 3 + 1) * 64 + col] = a1; red[(kg * 3 + 2) * 64 + col] = a2;
    __syncthreads();
    if (tid < 192) { const int r = tid >> 6, c = tid & 63; float s = 0.f;
#pragma unroll
        for (int k = 0; k < 8; ++k) s += red[(k * 3 + r) * 64 + c];
        float* MOD = (float*)(P.ws + l * SZ_LAYER + LO_MOD); MOD[r * 6144 + nt * 64 + c] = s + P.b_ada[l * 6144 + nt * 64 + c]; }
    __syncthreads();
}

__device__ __forceinline__ void tables_item(PREF P, int it) {
    const int tid = tid_opaque(); unsigned char* tb = P.ws + O_TAB;
    if (it < 8) {
        bf16_t* T = (bf16_t*)(tb + T_CS);
        for (int e = tid; e < 64 * 256; e += 512) { const int row = it * 64 + (e >> 8), kc = e & 255, cs = row >> 8, j = row & 255; const int mm = (j * kc) & 255;
            float s, c; sincospif((float)mm * (1.0f / 128.0f), &s, &c); T[row * 256 + kc] = (bf16_t)(cvt_pk_bf16((cs ? s : c) * 0.0625f, 0.f) & 0xffffu); }
    } else if (it < 16) {
        bf16_t* T = (bf16_t*)(tb + T_DCTX); const int i8 = it - 8;
        for (int e = tid; e < 64 * 256; e += 512) { const int row = i8 * 64 + (e >> 8), t = e & 255, cs = row >> 8, k = row & 255; const int mm = (k * t) & 255;
            float s, c; sincospif((float)mm * (1.0f / 128.0f), &s, &c); T[row * 256 + t] = (bf16_t)(cvt_pk_bf16((cs ? -s : c) * 0.0625f, 0.f) & 0xffffu); }
    } else {
        bf16_t* D1 = (bf16_t*)(tb + T_D1); bf16_t* D2 = (bf16_t*)(tb + T_D2); float* TW = (float*)(tb + T_TW);
        for (int e = tid; e < 128 * 64; e += 512) { const int row = e >> 6, t1 = e & 63, cs = row >> 6, k1 = row & 63; const int mm = (k1 * t1) & 63;
            float s, c; sincospif((float)mm * (1.0f / 32.0f), &s, &c); D1[e] = (bf16_t)(cvt_pk_bf16((cs ? -s : c) * 0.125f, 0.f) & 0xffffu); }
        for (int e = tid; e < 128 * 128; e += 512) { const int row = e >> 7, col = e & 127, cso = row >> 6, k2 = row & 63, csi = col >> 6, t2 = col & 63; const int mm = (k2 * t2) & 63;
            float s, c; sincospif((float)mm * (1.0f / 32.0f), &s, &c); const float v = (cso == csi) ? c : (cso == 0 ? s : -s);
            D2[e] = (bf16_t)(cvt_pk_bf16(v * 0.125f, 0.f) & 0xffffu); }
        for (int e = tid; e < 64 * 64; e += 512) { const int k1 = e >> 6, t2 = e & 63; float s, c; sincospif((float)(k1 * t2) * (1.0f / 2048.0f), &s, &c); TW[2 * e] = c; TW[2 * e + 1] = -s; }
    }
}

__device__ __forceinline__ void ssm_build(PREF P, int l, int g, float* sm) {
    float* ap_re = sm; float* ap_im = ap_re + 2 * 17 * 64; float* bb_re = ap_im + 2 * 17 * 64; float* bb_im = bb_re + 2 * 64 * 16;
    float* cc_re = bb_im + 2 * 64 * 16; float* cc_im = cc_re + 2 * 16 * 64; float* Kk = cc_im + 2 * 16 * 64;
    const int tid = tid_opaque(); unsigned char* wl = P.ws + l * SZ_LAYER;
    if (tid < 128) {
        const int d = tid >> 6, p = tid & 63; const size_t gi = (size_t)(l * 2 + d) * 64 + g;
        const double lr = (double)P.lam_re[gi * 64 + p], li = (double)P.lam_im[gi * 64 + p], dt = exp((double)P.log_dt[gi]);
        const double a_re = exp(lr * dt) * cos(li * dt), a_im = exp(lr * dt) * sin(li * dt);
        { double pr = 1.0, pi = 0.0;
          for (int tau = 0; tau <= 16; ++tau) { ap_re[(d * 17 + tau) * 64 + p] = (float)pr; ap_im[(d * 17 + tau) * 64 + p] = (float)pi;
              if (tau == 16) { float* A16 = (float*)(wl + LO_A16); A16[((d * 64 + g) * 64 + p) * 2] = (float)pr; A16[((d * 64 + g) * 64 + p) * 2 + 1] = (float)pi; }
              const double nr = pr * a_re - pi * a_im, ni = pr * a_im + pi * a_re; pr = nr; pi = ni; } }
        const double n_re = a_re - 1.0, n_im = a_im, den = lr * lr + li * li;
        const double q_re = (n_re * lr + n_im * li) / den, q_im = (n_im * lr - n_re * li) / den;
        for (int h = 0; h < 16; ++h) { const double br = (double)P.b_re[(gi * 64 + p) * 16 + h], bi = (double)P.b_im[(gi * 64 + p) * 16 + h];
            bb_re[(d * 64 + p) * 16 + h] = (float)(q_re * br - q_im * bi); bb_im[(d * 64 + p) * 16 + h] = (float)(q_re * bi + q_im * br); }
    }
    for (int i = tid; i < 2048; i += 512) { const int d = i >> 10, rem = i & 1023; const size_t s = ((size_t)(l * 2 + d) * 64 + g) * 1024 + rem; cc_re[i] = P.c_re[s]; cc_im[i] = P.c_im[s]; }
    __syncthreads();
    { const int d = tid >> 8, tau = (tid >> 4) & 15, ho = tid & 15; float sacc[16];
#pragma unroll
      for (int hi = 0; hi < 16; ++hi) sacc[hi] = 0.f;
      for (int p = 0; p < 64; ++p) { const float cr = cc_re[(d * 16 + ho) * 64 + p], ci = cc_im[(d * 16 + ho) * 64 + p], ar = ap_re[(d * 17 + tau) * 64 + p], ai = ap_im[(d * 17 + tau) * 64 + p];
          const float wr = cr * ar - ci * ai, wi = cr * ai + ci * ar; const float* br = bb_re + (d * 64 + p) * 16; const float* bi = bb_im + (d * 64 + p) * 16;
#pragma unroll
          for (int hi = 0; hi < 16; ++hi) sacc[hi] += wr * br[hi] - wi * bi[hi]; }
#pragma unroll
      for (int hi = 0; hi < 16; ++hi) Kk[((d * 16 + tau) * 16 + ho) * 16 + hi] = sacc[hi]; }
    __syncthreads();
    bf16_t* M1 = (bf16_t*)(wl + LO_M1) + (size_t)g * 256 * 256; bf16_t* M2 = (bf16_t*)(wl + LO_M2) + (size_t)g * 256 * 512;
    for (int v = tid; v < 8192; v += 512) { const int mrow = v >> 5, k0 = (v & 31) * 8; const int d = mrow >> 7, reim = (mrow >> 6) & 1, p = mrow & 63, s = k0 >> 4, hi0 = k0 & 15;
        const int tau = d == 0 ? 15 - s : s; const float ar = ap_re[(d * 17 + tau) * 64 + p], ai = ap_im[(d * 17 + tau) * 64 + p]; float f[8];
#pragma unroll
        for (int j = 0; j < 8; ++j) { const float br = bb_re[(d * 64 + p) * 16 + hi0 + j], bi = bb_im[(d * 64 + p) * 16 + hi0 + j]; f[j] = reim == 0 ? ar * br - ai * bi : ar * bi + ai * br; }
        *(u32x4*)(M1 + (size_t)mrow * 256 + k0) = pack8(f); }
    for (int v = tid; v < 16384; v += 512) { const int r = v >> 6, k0 = (v & 63) * 8, t = r >> 4, ho = r & 15; float f[8];
        if (k0 < 256) { const int s = k0 >> 4, hi0 = k0 & 15;
#pragma unroll
            for (int j = 0; j < 8; ++j) f[j] = s < t ? Kk[(t - s) * 256 + ho * 16 + hi0 + j] : (s > t ? Kk[(16 + (s - t)) * 256 + ho * 16 + hi0 + j] : Kk[ho * 16 + hi0 + j] + Kk[16 * 256 + ho * 16 + hi0 + j]);
        } else { const int kk = k0 - 256, d = kk >> 7, reim = (kk >> 6) & 1, p0 = kk & 63, tau = d == 0 ? t + 1 : 16 - t;
#pragma unroll
            for (int j = 0; j < 8; ++j) { const int p = p0 + j; const float cr = cc_re[(d * 16 + ho) * 64 + p], ci = cc_im[(d * 16 + ho) * 64 + p], ar = ap_re[(d * 17 + tau) * 64 + p], ai = ap_im[(d * 17 + tau) * 64 + p];
                f[j] = reim == 0 ? cr * ar - ci * ai : -(cr * ai + ci * ar); } }
        *(u32x4*)(M2 + (size_t)r * 512 + k0) = pack8(f); }
    __syncthreads();
}

__device__ __forceinline__ void phase_prep(PREF P, unsigned char* shm) {
    float* sm = (float*)shm; const int b = bid_opaque(), G = gridDim.x;
    for (int it = b; it < 337; it += G) {
        if (it < 128) ssm_build(P, it >> 6, it & 63, sm);
        else if (it < 320) { const int e = it - 128; mod_item(P, e / 96, e % 96, sm); }
        else tables_item(P, it - 320);
    }
    const int total = 2 * TILES_PER_LAYER; int start, cnt;
    if (G == 256) { if (b < 64) { start = b * 38; cnt = 38; } else if (b < 81) { start = 2432 + (b - 64) * 42; cnt = 42; } else { start = 2432 + 17 * 42 + (b - 81) * 43; cnt = 43; } }
    else { cnt = (total + G - 1) / G; start = b * cnt; }
    const int end = (start + cnt) < total ? (start + cnt) : total;
    const int tid = tid_opaque(), lr = tid >> 4, lc = (tid & 15) * 4;
    if (start < end) {
        int cur = start; TileJob J = tile_job(P, cur); f32x4 v[4];
#pragma unroll
        for (int i = 0; i < 4; ++i) v[i] = *(const f32x4*)(J.src + (size_t)(J.k0 + lr + 32 * i) * J.N + J.n0 + lc);
        for (;;) {
#pragma unroll
            for (int i = 0; i < 4; ++i)
#pragma unroll
                for (int j = 0; j < 4; ++j) sm[(lr + 32 * i) * 65 + lc + j] = v[i][j];
            __syncthreads();
            const TileJob C = J; const bool more = cur + 1 < end;
            if (more) { J = tile_job(P, cur + 1);
#pragma unroll
                for (int i = 0; i < 4; ++i) v[i] = *(const f32x4*)(J.src + (size_t)(J.k0 + lr + 32 * i) * J.N + J.n0 + lc); }
            const int n = tid >> 3, kg = tid & 7;
#pragma unroll
            for (int h = 0; h < 2; ++h) { float f[8];
#pragma unroll
                for (int j = 0; j < 8; ++j) f[j] = sm[(kg * 16 + h * 8 + j) * 65 + n];
                *(u32x4*)(C.dst + (size_t)(C.drow0 + n) * C.K + C.k0 + kg * 16 + h * 8) = pack8(f); }
            __syncthreads();
            if (!more) break;
            ++cur;
        }
    }
}

__device__ __forceinline__ void phase_prenorm0(PREF P) {
    const int tidx = tid_opaque(); const int lane = tidx & 63, gw = (tidx >> 6) * (int)gridDim.x + bid_opaque(), nw = gridDim.x * 8;
    const float* MOD = (const float*)(P.ws + LO_MOD); bf16_t* HB = (bf16_t*)(P.ws + O_HB);
    for (int row = gw; row < MTOT; row += nw) {
        const float* src = row < MX ? P.x + (size_t)row * DM : P.ctx + (size_t)(row - MX) * DM; const float* md = MOD + (row < MX ? (row >> 12) : 2) * 6144;
        f32x4 v[8]; float ss = 0.f;
#pragma unroll
        for (int i = 0; i < 8; ++i) { v[i] = *(const f32x4*)(src + (i * 64 + lane) * 4); ss += v[i][0] * v[i][0] + v[i][1] * v[i][1] + v[i][2] * v[i][2] + v[i][3] * v[i][3]; }
        ss = wave_sum(ss, lane); const float rinv = rsqrtf(ss * (1.0f / DM) + RMS_EPS);
#pragma unroll
        for (int i = 0; i < 8; ++i) { const int c = (i * 64 + lane) * 4; const f32x4 g = *(const f32x4*)(P.g_pre + c), sh = *(const f32x4*)(md + c), sc = *(const f32x4*)(md + 2048 + c); float h[4];
#pragma unroll
            for (int j = 0; j < 4; ++j) h[j] = v[i][j] * rinv * g[j] * (1.0f + sc[j]) + sh[j];
            u32x2 o; o[0] = cvt_pk_bf16(h[0], h[1]); o[1] = cvt_pk_bf16(h[2], h[3]); *(u32x2*)(HB + (size_t)row * DM + c) = o; }
    }
}
__device__ __forceinline__ void phase_postnorm(PREF P, int l) {
    const int tidx = tid_opaque(); const int lane = tidx & 63, gw = (tidx >> 6) * (int)gridDim.x + bid_opaque(), nw = gridDim.x * 8;
    const float* MOD = (const float*)(P.ws + l * SZ_LAYER + LO_MOD); const float* MOD1 = (const float*)(P.ws + SZ_LAYER + LO_MOD);
    bf16_t* HB = (bf16_t*)(P.ws + O_HB); const bf16_t* OB = (const bf16_t*)(P.ws + O_PARTS); float* X1 = (float*)(P.ws + O_X1);
    const int rows = l == 0 ? MTOT : MX;
    for (int row = gw; row < rows; row += nw) {
        const int mr = row < MX ? (row >> 12) : 2; const float* md = MOD + mr * 6144;
        const float* xo = l == 0 ? (row < MX ? P.x + (size_t)row * DM : P.ctx + (size_t)(row - MX) * DM) : X1 + (size_t)row * DM;
        const bf16_t* op = OB + (size_t)row * DM;
        f32x4 o[8], xv[8]; float ss = 0.f;
#pragma unroll
        for (int i = 0; i < 8; ++i) { const u32x2 ob = *(const u32x2*)(op + (i * 64 + lane) * 4); o[i] = (f32x4){lo_f(ob[0]), hi_f(ob[0]), lo_f(ob[1]), hi_f(ob[1])}; xv[i] = *(const f32x4*)(xo + (i * 64 + lane) * 4); ss += o[i][0] * o[i][0] + o[i][1] * o[i][1] + o[i][2] * o[i][2] + o[i][3] * o[i][3]; }
        ss = wave_sum(ss, lane); const float rinv = rsqrtf(ss * (1.0f / DM) + RMS_EPS); float s2 = 0.f;
#pragma unroll
        for (int i = 0; i < 8; ++i) { const int c = (i * 64 + lane) * 4; const f32x4 gp = *(const f32x4*)(P.g_post + l * DM + c), gt = *(const f32x4*)(md + 4096 + c);
#pragma unroll
            for (int j = 0; j < 4; ++j) { xv[i][j] = xv[i][j] + gt[j] * (o[i][j] * rinv * gp[j]); s2 += xv[i][j] * xv[i][j]; }
            if (l == 0) *(f32x4*)(X1 + (size_t)row * DM + c) = xv[i]; else *(f32x4*)(P.out + (size_t)row * DM + c) = xv[i]; }
        if (l == 0) { s2 = wave_sum(s2, lane); const float r2 = rsqrtf(s2 * (1.0f / DM) + RMS_EPS); const float* m1 = MOD1 + mr * 6144;
#pragma unroll
            for (int i = 0; i < 8; ++i) { const int c = (i * 64 + lane) * 4; const f32x4 g = *(const f32x4*)(P.g_pre + DM + c), sh = *(const f32x4*)(m1 + c), sc = *(const f32x4*)(m1 + 2048 + c); float h[4];
#pragma unroll
                for (int j = 0; j < 4; ++j) h[j] = xv[i][j] * r2 * g[j] * (1.0f + sc[j]) + sh[j];
                u32x2 ov; ov[0] = cvt_pk_bf16(h[0], h[1]); ov[1] = cvt_pk_bf16(h[2], h[3]); *(u32x2*)(HB + (size_t)row * DM + c) = ov; } }
    }
}


__device__ __forceinline__ void conv_rows(PREF P, const int l, const int bsub, const int nblk, const int tidx) {
    const bf16_t* parts = (const bf16_t*)(P.ws + O_PARTS); bf16_t* AB = (bf16_t*)(P.ws + O_AB);
    const int rows = l == 0 ? MTOT : MX; const float* cw = P.conv_w + (size_t)l * 3 * 1024;
    for (int idx = bsub * 512 + tidx; idx < (rows >> 2) * 128; idx += nblk * 512) {
        const int r0 = (idx >> 7) * 4, c0 = (idx & 127) * 8; bool lv, rv;
        if (r0 < MX) { const int cp = r0 & 63; lv = cp > 0; rv = cp < 60; } else { const int t = (r0 - MX) & 255; lv = t > 0; rv = t < 252; }
        const bf16_t* pr = parts + E_PC + (size_t)r0 * 4096 + c0;
        u32x4 xr[6], cr[6], br[4], zr[4];
#pragma unroll
        for (int k = 0; k < 6; ++k) { const bool ok = (k == 0) ? lv : ((k == 5) ? rv : true);
            if (ok) { xr[k] = *(const u32x4*)(pr + (ptrdiff_t)(k - 1) * 4096 + C_XA); cr[k] = *(const u32x4*)(pr + (ptrdiff_t)(k - 1) * 4096 + C_CA); }
            else { xr[k] = (u32x4){0u, 0u, 0u, 0u}; cr[k] = (u32x4){0u, 0u, 0u, 0u}; } }
#pragma unroll
        for (int k = 0; k < 4; ++k) { br[k] = *(const u32x4*)(pr + (size_t)k * 4096 + C_BA); zr[k] = *(const u32x4*)(pr + (size_t)k * 4096 + C_ZA); }
        float w0[8], w1[8], w2[8];
#pragma unroll
        for (int j = 0; j < 8; ++j) { w0[j] = cw[c0 + j]; w1[j] = cw[1024 + c0 + j]; w2[j] = cw[2048 + c0 + j]; }
        float v[6][8];
#pragma unroll
        for (int k = 0; k < 6; ++k) { float xa[8], ca[8]; unpack8(xr[k], xa); unpack8(cr[k], ca);
#pragma unroll
            for (int j = 0; j < 8; ++j) v[k][j] = xa[j] * ca[j]; }
#pragma unroll
        for (int k = 0; k < 4; ++k) { float ba[8], za[8], o[8]; unpack8(br[k], ba); unpack8(zr[k], za);
#pragma unroll
            for (int j = 0; j < 8; ++j) { const float y = w0[j] * v[k][j] + w1[j] * v[k + 1][j] + w2[j] * v[k + 2][j]; o[j] = ba[j] * y * siluf_(za[j]); }
            *(u32x4*)(AB + (size_t)(r0 + k) * 1024 + c0) = pack8(o); }
    }
}

__device__ __forceinline__ void phase_mix1(PREF P, int l, unsigned char* shm) {
    const bf16_t* parts = (const bf16_t*)(P.ws + O_PARTS); unsigned char* wl = P.ws + l * SZ_LAYER;
    const int tidx = tid_opaque(), bidx = bid_opaque(); const int lane = tidx & 63, wv = tidx >> 6, r = lane & 15, q = lane >> 4;
    const int gw = bidx * 8 + wv, nw = gridDim.x * 8;
    for (int wi = bidx; wi < 256; wi += gridDim.x) ssm_stage_lds<256, false>(P, l, wi, shm, tidx);
    {
        bf16_t* ZB = (bf16_t*)(P.ws + O_ZB); const bf16_t* D1 = (const bf16_t*)(P.ws + O_TAB + T_D1); const float* TW = (const float*)(P.ws + O_TAB + T_TW);
        for (int it = gw; it < 2048; it += nw) {
            const int cg = it & 15, t2 = (it >> 4) & 63, b = it >> 10;
            f32x4 acc[8][4];
            lmul_g4<8>(D1, 64, 2, parts + E_PF + (size_t)(b * SEQ + t2) * 1024 + cg * 64 + r * 4, (size_t)64 * 1024, acc, lane);
#pragma unroll
            for (int a = 0; a < 4; ++a)
#pragma unroll
                for (int i = 0; i < 4; ++i) { const int k1 = a * 16 + q * 4 + i; const float twr = TW[(k1 * 64 + t2) * 2], twi = TW[(k1 * 64 + t2) * 2 + 1];
                    bf16_t* zr = ZB + ((size_t)((b * 64 + k1) * 128 + t2)) * 1024 + cg * 64 + r * 4; bf16_t* zi = zr + (size_t)64 * 1024; float vr[4], vi[4];
#pragma unroll
                    for (int nb = 0; nb < 4; ++nb) { const float re = acc[a][nb][i], im = acc[a + 4][nb][i]; vr[nb] = re * twr - im * twi; vi[nb] = re * twi + im * twr; }
                    u32x2 o; o[0] = cvt_pk_bf16(vr[0], vr[1]); o[1] = cvt_pk_bf16(vr[2], vr[3]); *(u32x2*)zr = o; o[0] = cvt_pk_bf16(vi[0], vi[1]); o[1] = cvt_pk_bf16(vi[2], vi[3]); *(u32x2*)zi = o; }
        }
    }
}


__device__ __forceinline__ void ctx_dft_item(PREF P, const int it, const int lane) {
    const int r = lane & 15, q = lane >> 4; const bf16_t* parts = (const bf16_t*)(P.ws + O_PARTS);
    bf16_t* YB = (bf16_t*)(P.ws + O_YB); const bf16_t* DC = (const bf16_t*)(P.ws + O_TAB + T_DCTX);
    const int cg = it & 15, mc = (it >> 4) & 3, b = it >> 6;
    f32x4 acc[8][4];
    lmul_g4<8>(DC + (size_t)mc * 128 * 256, 256, 8, parts + E_PF + (size_t)(MX + b * LCX) * 1024 + cg * 64 + r * 4, (size_t)1024, acc, lane);
#pragma unroll
    for (int a = 0; a < 8; ++a)
#pragma unroll
        for (int i = 0; i < 4; ++i) { const int mrow = mc * 128 + a * 16 + q * 4 + i, cs = mrow >> 8, k = mrow & 255;
            bf16_t* yp = YB + (size_t)(MX + b * LCX + k) * 2048 + cs * 1024 + cg * 64 + r * 4;
            u32x2 o; o[0] = cvt_pk_bf16(acc[a][0][i], acc[a][1][i]); o[1] = cvt_pk_bf16(acc[a][2][i], acc[a][3][i]); *(u32x2*)yp = o; }
}

__device__ __forceinline__ void phase_mix2(PREF P, int l) {
    unsigned char* wl = P.ws + l * SZ_LAYER;
    const int tidx = tid_opaque(), bidx = bid_opaque(); const int lane = tidx & 63, wv = tidx >> 6, r = lane & 15, q = lane >> 4;
    const int gw = bidx * 8 + wv, nw = gridDim.x * 8;
    if (wv == 0) {
        const float* EB = (const float*)(P.ws + O_EB); bf16_t* HS = (bf16_t*)(P.ws + O_HS); const float* A16 = (const float*)(wl + LO_A16);
        for (int it = bidx; it < 256; it += gridDim.x) {
            const int d = it & 1, g = (it >> 1) & 63, b = it >> 7, p = lane;
            const float ar = A16[((d * 64 + g) * 64 + p) * 2], ai = A16[((d * 64 + g) * 64 + p) * 2 + 1];
            float hr = 0.f, hi = 0.f;
#define SCAN_COL(j) ((j) < 16 ? 512 + b * 16 + (d ? 15 - (j) : (j)) : b * 256 + (d ? 255 - ((j) - 16) : ((j) - 16)))
#define SCAN_LOAD(er, ei, j0) _Pragma("unroll") for (int jj = 0; jj < 16; ++jj) { const int col = SCAN_COL((j0) + jj); const float* ep = EB + ((size_t)g * NCOL + col) * 256 + d * 128 + p; er[jj] = ep[0]; ei[jj] = ep[64]; }
#define SCAN_STEP(er, ei, j0) _Pragma("unroll") for (int jj = 0; jj < 16; ++jj) { const int col = SCAN_COL((j0) + jj); \
                bf16_t* hp = HS + ((size_t)g * NCOL + col) * 256 + d * 128 + p; const unsigned pk = cvt_pk_bf16(hr, hi); hp[0] = (bf16_t)(pk & 0xffffu); hp[64] = (bf16_t)(pk >> 16); \
                const float nr = ar * hr - ai * hi + er[jj], ni = ar * hi + ai * hr + ei[jj]; hr = nr; hi = ni; }
            float era[16], eia[16], erb[16], eib[16];
            SCAN_LOAD(era, eia, 0)
            for (int it2 = 0; it2 < 8; ++it2) {
                SCAN_LOAD(erb, eib, it2 * 32 + 16)
                SCAN_STEP(era, eia, it2 * 32)
                SCAN_LOAD(era, eia, it2 * 32 + 32)
                SCAN_STEP(erb, eib, it2 * 32 + 16)
            }
            SCAN_STEP(era, eia, 256)
#undef SCAN_COL
#undef SCAN_LOAD
#undef SCAN_STEP
        }
    }
    {
        const bf16_t* ZB = (const bf16_t*)(P.ws + O_ZB); bf16_t* YB = (bf16_t*)(P.ws + O_YB); const bf16_t* D2 = (const bf16_t*)(P.ws + O_TAB + T_D2);
        for (int it = gw; it < 2048; it += nw) {
            const int cg = it & 15, k1 = (it >> 4) & 63, b = it >> 10;
            f32x4 acc[8][4];
            lmul_g4<8>(D2, 128, 4, ZB + (size_t)(b * 64 + k1) * 128 * 1024 + cg * 64 + r * 4, (size_t)1024, acc, lane);
#pragma unroll
            for (int a = 0; a < 8; ++a)
#pragma unroll
                for (int i = 0; i < 4; ++i) { const int mrow = a * 16 + q * 4 + i, cs = mrow >> 6, k2 = mrow & 63;
                    bf16_t* yp = YB + (size_t)(b * SEQ + k1 + 64 * k2) * 2048 + cs * 1024 + cg * 64 + r * 4;
                    u32x2 o; o[0] = cvt_pk_bf16(acc[a][0][i], acc[a][1][i]); o[1] = cvt_pk_bf16(acc[a][2][i], acc[a][3][i]); *(u32x2*)yp = o; }
        }
    }
    if (l == 0 && wv >= 1) { for (int it = bidx * 7 + (wv - 1); it < 128; it += gridDim.x * 7) ctx_dft_item(P, it, lane); }
}

template <int ph>
__device__ __forceinline__ void run_phase(KPtr kp, unsigned char* shm) {
    asm volatile("" : "+s"(kp)); PREF P = *kp;
    LAS unsigned char* lds = (LAS unsigned char*)shm; const int G = gridDim.x, c = bid_opaque();
    if constexpr (ph == 0) { phase_prep(P, shm); return; }
    if constexpr (ph == 1) {
        phase_prenorm0(P);
        return;
    }
    constexpr int l = ph >= 2 ? ((ph - 2) >> 3) : 0, sp = ph >= 2 ? ((ph - 2) & 7) : 0; unsigned char* wl = P.ws + l * SZ_LAYER; constexpr int nM = 32, nh = l == 0 ? 4 : 0;
    const bf16_t* parts = (const bf16_t*)(P.ws + O_PARTS);
    switch (sp) {
    case 0: { EpiParts E{(bf16_t*)(P.ws + O_PARTS)};
        if (l == 0) { SchedGrid S{(const char*)(P.ws + O_HB), (const char*)(wl + LO_WIN), 32, 56, DM, DM, G, c, 4, MX, 1 << 20}; gemm_phase(lds, S, E, DM, DM, DM);
            { const int c3 = bid_opaque(); const int first = G > 224 ? 224 : 0; if (c3 >= first) { SchedWp SW{P.ws, G - first, c3 - first}; EpiWp EW{P.ws}; gemm_phase(lds, SW, EW, 256, 1024, 256); } } }
        else {
            {
                const int tq = tid_opaque(), lane = tq & 63, r = lane & 15, q = lane >> 4; const bf16_t* HB = (const bf16_t*)(P.ws + O_HB); const bf16_t* WT = (const bf16_t*)(wl + LO_WIN); bf16_t* po = (bf16_t*)(P.ws + O_PARTS);
                for (int it = c * 8 + (tq >> 6); it < 2048; it += G * 8) { const int tr = it >> 6, tc = it & 63;
                    const bf16_t* ap = HB + (size_t)(MX + tr * 16 + r) * DM + q * 8; const bf16_t* bp = WT + (size_t)(C_U + tc * 16 + r) * DM + q * 8; f32x4 a4 = (f32x4){0.f, 0.f, 0.f, 0.f};
#pragma unroll 8
                    for (int ks = 0; ks < 64; ++ks) a4 = __builtin_amdgcn_mfma_f32_16x16x32_bf16(*(const bf16x8*)(ap + ks * 32), *(const bf16x8*)(bp + ks * 32), a4, 0, 0, 0);
#pragma unroll
                    for (int i = 0; i < 4; ++i) po[E_PU + (size_t)(MX + tr * 16 + q * 4 + i) * 1024 + tc * 16 + r] = (bf16_t)(cvt_pk_bf16(a4[i], 0.f) & 0xffffu); }
            }
            SchedGrid S{(const char*)(P.ws + O_HB), (const char*)(wl + LO_WIN), 32, 56, DM, DM, G, c, 0, MX, 1 << 20}; gemm_phase(lds, S, E, DM, DM, DM); }
    } break;
    case 1: phase_mix1(P, l, shm); break;
    case 2: phase_mix2(P, l); break;
    case 3: { const int tq = tid_opaque(), c2 = bid_opaque();
        for (int wi = c2; wi < 256; wi += G) ssm_stage_lds<512, true>(P, l, wi, shm, tq);
        conv_rows(P, l, c2, G, tq);
    } break;
    case 4: {
        if (l == 0) { ctx_small_gemm<0>(P, shm); ctx_small_gemm<3>(P, shm); }
        const int nf = nM * 4;
        { const int c1 = bid_opaque(); SchedGrid S{(const char*)(P.ws + O_YB), (const char*)(wl + LO_WP), nM, 4, 2048, 2048, nf, c1, 0, MX, c1 < nf ? 1 : 0}; EpiFourier E{parts, (bf16_t*)(P.ws + O_CB)}; gemm_phase(lds, S, E, 2048, 2048, 2048); }
        { const int c2 = bid_opaque(); const int ng = nM * 8, two = 2 * (G - nf);
          int L0, dL, cn;
          if (G > nf && two <= ng) { if (c2 >= nf) { L0 = 2 * (c2 - nf); dL = 1; cn = 2; } else { L0 = two + c2; dL = nf; cn = (ng - two - c2 + nf - 1) / nf; if (cn < 0) cn = 0; } }
          else { L0 = c2; dL = G; cn = 1 << 20; }
          SchedGrid S{(const char*)(P.ws + O_GB), (const char*)(wl + LO_GLU), nM, 8, 1024, 1024, dL, L0, 0, MX, cn}; EpiGlu E{parts, (bf16_t*)(P.ws + O_BB)}; gemm_phase(lds, S, E, 1024, 1024, 1024); }
    } break;
    case 5: { if (l == 0) ctx_small_gemm<1>(P, shm);
        SchedMerge S{(const char*)(P.ws + O_AB), (const char*)(wl + LO_PA), nM, G, c, 0, MX};
        EpiMerge E{parts, (bf16_t*)(P.ws + O_HB)}; gemm_phase(lds, S, E, 1024, 1024, 1024); } break;
    case 6: { if (l == 0) ctx_small_gemm<2>(P, shm);
        SchedGrid S{(const char*)(P.ws + O_HB), (const char*)(wl + LO_WO), nM, 8, DM, DM, G, c, 0, MX, 1 << 20}; EpiStoreBf16 E{(bf16_t*)(P.ws + O_PARTS), DM}; gemm_phase(lds, S, E, DM, DM, DM); } break;
    default: phase_postnorm(P, l); break;
    }
}

#define XB_TMO      128
#define XB_XCNT(j)  (256  + 64 * (j))
#define XB_XSUB(j)  (1280 + 64 * (j))
#define XB_XGEN(j)  (2304 + 64 * (j))
#define XB_TOP      3328
#define XB_TOPGEN   3392
#define XCD_BAR_WORDS 3456
#define XB_SPIN_CAP (1u << 18)
__device__ __forceinline__ unsigned xb_ld(unsigned* p)              { return __hip_atomic_load(p, __ATOMIC_RELAXED, __HIP_MEMORY_SCOPE_AGENT); }
__device__ __forceinline__ unsigned xb_add(unsigned* p, unsigned v) { return __hip_atomic_fetch_add(p, v, __ATOMIC_RELAXED, __HIP_MEMORY_SCOPE_AGENT); }
__device__ __forceinline__ unsigned xb_xcc_id() { return (unsigned)__builtin_amdgcn_s_getreg((3 << 11) | 20) & 0xFu; }
#define XB_SPIN(cond, bar) do { unsigned _sp = 0; while (cond) { __builtin_amdgcn_s_sleep(1); \
    if ((++_sp & 255u) == 0u) { if (xb_ld(&(bar)[XB_TMO])) break; if (_sp > XB_SPIN_CAP) { atomicAdd(&(bar)[XB_TMO], 1u); break; } } } } while (0)
struct XcdBarrier { unsigned* bar; unsigned x; volatile LAS unsigned* st; };
__device__ __forceinline__ XcdBarrier xcd_barrier_post(unsigned* bar, volatile LAS unsigned* st) {
    XcdBarrier b; b.bar = bar; b.x = xb_xcc_id(); b.st = st;
    if (threadIdx.x == 0) (void)xb_add(&bar[XB_XCNT(b.x)], 1u);
    return b;
}
__device__ __forceinline__ void xcd_barrier_complete(unsigned* bar, unsigned x, unsigned& nloc, unsigned& nx) {
    const unsigned G = gridDim.x * gridDim.y * gridDim.z;
    unsigned sum, cnt, mine, sp = 0u;
    for (;;) {
        sum = 0u; cnt = 0u; mine = 0u;
#pragma unroll
        for (unsigned j = 0; j < 16; ++j) { const unsigned c = xb_ld(&bar[XB_XCNT(j)]); sum += c; cnt += (c > 0u) ? 1u : 0u; mine = (j == x) ? c : mine; }
        if (sum == G) break;
        __builtin_amdgcn_s_sleep(1);
        if ((++sp & 255u) == 0u) { if (xb_ld(&bar[XB_TMO])) break; if (sp > XB_SPIN_CAP) { atomicAdd(&bar[XB_TMO], 1u); break; } }
    }
    nloc = mine > 0u ? mine : 1u; nx = cnt > 0u ? cnt : 1u;
}
__device__ __forceinline__ void xcd_barrier(const XcdBarrier& b) {
    asm volatile("s_waitcnt vmcnt(0)" ::: "memory");
    __syncthreads();
    if (threadIdx.x == 0) {
        unsigned* bar = b.bar;
        __builtin_amdgcn_s_waitcnt(0);
        unsigned nloc = b.st[0], nx = b.st[1];
        if (nloc == 0u) { xcd_barrier_complete(bar, b.x, nloc, nx); b.st[0] = nloc; b.st[1] = nx; }
        const unsigned old = xb_add(&bar[XB_XSUB(b.x)], 1u);
        const unsigned gen = old / nloc;
        if (old + 1u == (gen + 1u) * nloc) {
            __builtin_amdgcn_fence(__ATOMIC_RELEASE, "agent");
            asm volatile("s_waitcnt vmcnt(0)" ::: "memory");
            const unsigned og = xb_add(&bar[XB_TOP], 1u);
            const unsigned tg = og / nx;
            if (og + 1u == (tg + 1u) * nx) xb_add(&bar[XB_TOPGEN], 1u);
            else XB_SPIN(xb_ld(&bar[XB_TOPGEN]) == tg, bar);
            __builtin_amdgcn_fence(__ATOMIC_ACQUIRE, "agent");
            xb_add(&bar[XB_XGEN(b.x)], 1u);
            asm volatile("s_waitcnt vmcnt(0)" ::: "memory");
        } else {
            XB_SPIN(xb_ld(&bar[XB_XGEN(b.x)]) == gen, bar);
            __builtin_amdgcn_fence(__ATOMIC_ACQUIRE, "agent");
            asm volatile("s_waitcnt vmcnt(0)" ::: "memory");
        }
    }
    __syncthreads();
}

constexpr int N_PHASES = 18;

__global__ void __launch_bounds__(512, 2) mega(Params P, int ph0, int ph1) {
    extern __shared__ __attribute__((aligned(16))) unsigned char shm[];
    __shared__ uint4 xb_words;
    if (threadIdx.x == 0) xb_words = make_uint4(0u, 0u, 0u, 0u);
    __syncthreads();
    const XcdBarrier xb = xcd_barrier_post((unsigned*)(P.ws + O_BAR), (volatile LAS unsigned*)&xb_words);
    const KPtr kp = (KPtr)__builtin_amdgcn_kernarg_segment_ptr();
#define RUN_PH(k) if (ph0 <= (k) && (k) < ph1) { if ((k) != ph0) xcd_barrier(xb); run_phase<(k)>(kp, shm); }
    RUN_PH(0) RUN_PH(1) RUN_PH(2) RUN_PH(3) RUN_PH(4) RUN_PH(5) RUN_PH(6) RUN_PH(7) RUN_PH(8) RUN_PH(9)
    RUN_PH(10) RUN_PH(11) RUN_PH(12) RUN_PH(13) RUN_PH(14) RUN_PH(15) RUN_PH(16) RUN_PH(17)
#undef RUN_PH
}

extern "C" void kernel_launch(void* const* d_in, const int* in_sizes, int n_in, void* d_out, int out_size, void* d_ws, size_t ws_size, hipStream_t stream) {
    static int grid_blocks = 0;
    if (!grid_blocks) {
        int dev = 0, cus = 0, per_cu = 0;
        hipGetDevice(&dev); hipDeviceGetAttribute(&cus, hipDeviceAttributeMultiprocessorCount, dev);
        hipFuncSetAttribute((const void*)mega, hipFuncAttributeMaxDynamicSharedMemorySize, STAGE_BYTES);
        hipOccupancyMaxActiveBlocksPerMultiprocessor(&per_cu, (const void*)mega, 512, STAGE_BYTES);
        if (per_cu < 1) { fprintf(stderr, "occupancy query says %d blocks/CU\n", per_cu); per_cu = 1; }
        grid_blocks = cus;
        if (ws_size < WS_END) { fprintf(stderr, "workspace too small: %zu < %zu\n", ws_size, (size_t)WS_END); grid_blocks = -1; }
    }
    if (grid_blocks < 0) return;
    if (hipMemsetAsync((char*)d_ws + O_BAR, 0, SZ_BAR, stream) != hipSuccess) { fprintf(stderr, "memset of barrier words failed\n"); return; }
    Params p{};
    const float** pp = (const float**)&p;
    for (int i = 0; i < 25; ++i) pp[i] = (const float*)d_in[i];
    p.out = (float*)d_out; p.ws = (unsigned char*)d_ws;
    int ph0 = 0, ph1 = N_PHASES;
    void* args[] = {&p, &ph0, &ph1};
    hipError_t e = hipLaunchCooperativeKernel((const void*)mega, dim3(grid_blocks), dim3(512), args, STAGE_BYTES, stream);
    if (e != hipSuccess) fprintf(stderr, "cooperative launch failed: %s (grid %d)\n", hipGetErrorString(e), grid_blocks);
}
```

```cpp
#include <hip/hip_runtime.h>
#include <hip/hip_cooperative_groups.h>
#include <cstdio>
namespace cg = cooperative_groups;

#define LAS __attribute__((address_space(3)))
typedef unsigned short bf16_t;
typedef short bf16x8 __attribute__((ext_vector_type(8)));
typedef float f32x4 __attribute__((ext_vector_type(4)));
typedef unsigned u32x4 __attribute__((ext_vector_type(4)));
typedef unsigned u32x2 __attribute__((ext_vector_type(2)));

constexpr int DM = 2048, NB = 2, SEQ = 4096, LCX = 256, MX = NB * SEQ, MCT = NB * LCX, MTOT = MX + MCT;
constexpr int INW = 14336;
constexpr int C_XA = 0, C_BA = 1024, C_CA = 2048, C_ZA = 3072, C_U = 4096, C_ZB = 5120, C_F = 6144, C_ZC = 7168, C_GL = 8192;
constexpr size_t E_PC = 0, E_PU = (size_t)8704 * 4096, E_PZB = E_PU + (size_t)8704 * 1024, E_PF = E_PZB + (size_t)8704 * 1024, E_PZC = E_PF + (size_t)8704 * 1024, E_PGL = E_PZC + (size_t)8704 * 1024;
constexpr int NCOL = 544;
constexpr float RMS_EPS = 1e-6f;

constexpr size_t AL(size_t x) { return (x + 255) & ~(size_t)255; }
constexpr size_t SZ_WIN = (size_t)INW * DM * 2, SZ_P = (size_t)DM * 1024 * 2, SZ_GLU = (size_t)2048 * 1024 * 2, SZ_FW = (size_t)1024 * 1024 * 2,
                 SZ_WP = (size_t)1024 * 2048 * 2, SZ_WO = (size_t)DM * DM * 2, SZ_M1 = (size_t)64 * 256 * 256 * 2, SZ_M2 = (size_t)64 * 256 * 512 * 2,
                 SZ_A16 = (size_t)2 * 64 * 64 * 2 * 4, SZ_MOD = (size_t)3 * 6144 * 4;
constexpr size_t LO_WIN = 0, LO_PA = LO_WIN + SZ_WIN, LO_PB = LO_PA + SZ_P, LO_PC = LO_PB + SZ_P, LO_GLU = LO_PC + SZ_P, LO_FW = LO_GLU + SZ_GLU,
                 LO_WP = LO_FW + SZ_FW, LO_WO = LO_WP + SZ_WP, LO_M1 = LO_WO + SZ_WO, LO_M2 = LO_M1 + SZ_M1, LO_A16 = LO_M2 + SZ_M2, LO_MOD = LO_A16 + SZ_A16,
                 SZ_LAYER = AL(LO_MOD + SZ_MOD);
constexpr size_t O_TAB = 2 * SZ_LAYER;
constexpr size_t T_CS = 0, T_D1 = T_CS + 512 * 256 * 2, T_D2 = T_D1 + 128 * 64 * 2, T_DCTX = T_D2 + 128 * 128 * 2, T_TW = T_DCTX + 512 * 256 * 2, SZ_TAB = AL(T_TW + 64 * 64 * 8);
constexpr size_t O_X1 = O_TAB + SZ_TAB, SZ_X1 = (size_t)MTOT * DM * 4;
constexpr size_t O_HB = O_X1 + SZ_X1, SZ_HB = (size_t)MTOT * DM * 2;
constexpr size_t O_PARTS = O_HB + SZ_HB, SZ_PARTS = (size_t)MTOT * INW * 2;
constexpr size_t O_AB = O_PARTS + SZ_PARTS, SZ_BR = (size_t)MTOT * 1024 * 2;
constexpr size_t O_BB = O_AB + SZ_BR, O_CB = O_BB + SZ_BR, O_GB = O_CB + SZ_BR;
constexpr size_t O_ZB = O_GB + SZ_BR, SZ_ZB = (size_t)2 * 64 * 128 * 1024 * 2;
constexpr size_t O_YB = O_ZB + SZ_ZB, SZ_YB = (size_t)MTOT * 2048 * 2;
constexpr size_t O_EB = O_YB + SZ_YB, SZ_EB = (size_t)64 * NCOL * 256 * 4;
constexpr size_t O_HS = O_EB + SZ_EB, SZ_HS = (size_t)64 * NCOL * 256 * 2;
constexpr size_t O_MP = O_ZB;
constexpr size_t O_BAR = O_HS + SZ_HS, SZ_BAR = 16384;
constexpr size_t WS_END = O_BAR + SZ_BAR;
constexpr int MODCNT_WORD = 3520;
static_assert(SZ_ZB + SZ_YB + SZ_EB >= (size_t)MTOT * DM * 4, "alias");
static_assert(SZ_PARTS >= (size_t)MTOT * DM * 4, "alias");

struct Params {
    const float *x, *c, *ctx, *c_ctx, *w_ada, *b_ada, *g_pre, *g_post, *w_in, *conv_w, *lam_re, *lam_im, *log_dt, *b_re, *b_im, *c_re, *c_im,
        *ssm_d, *glu_wa, *glu_wb, *fourier_w, *proj_a, *proj_b, *proj_c, *w_out;
    float* out; unsigned char* ws;
};
typedef const __attribute__((address_space(4))) Params* KPtr;
#define PREF const __attribute__((address_space(4))) Params&

__device__ __forceinline__ int tid_opaque() { int t = threadIdx.x; asm volatile("" : "+v"(t)); return t; }
__device__ __forceinline__ int bid_opaque() { int b = blockIdx.x; asm volatile("" : "+s"(b)); return b; }
__device__ __forceinline__ float bf2f(unsigned v) { return __uint_as_float(v << 16); }
__device__ __forceinline__ unsigned cvt_pk_bf16(float lo, float hi) { unsigned r; asm volatile("v_cvt_pk_bf16_f32 %0, %1, %2" : "=v"(r) : "v"(lo), "v"(hi)); return r; }
__device__ __forceinline__ float lo_f(unsigned u) { return __uint_as_float(u << 16); }
__device__ __forceinline__ float hi_f(unsigned u) { return __uint_as_float(u & 0xffff0000u); }
__device__ __forceinline__ float sigmoidf_(float x) { return __builtin_amdgcn_rcpf(1.0f + __expf(-x)); }
__device__ __forceinline__ float siluf_(float x) { return x * __builtin_amdgcn_rcpf(1.0f + __expf(-x)); }
__device__ __forceinline__ float gelu_tanh(float x) { const float z = 0.7978845608028654f * (x + 0.044715f * x * x * x); const float t = 1.0f - 2.0f * __builtin_amdgcn_rcpf(__expf(2.0f * z) + 1.0f); return 0.5f * x * (1.0f + t); }
__device__ __forceinline__ float wave_sum(float v, const int lane) {
#pragma unroll
    for (int o = 32; o; o >>= 1) v += __int_as_float(__builtin_amdgcn_ds_bpermute((lane ^ o) << 2, __float_as_int(v)));
    return v;
}
__device__ __forceinline__ void unpack8(const u32x4 u, float (&f)[8]) {
    f[0] = lo_f(u[0]); f[1] = hi_f(u[0]); f[2] = lo_f(u[1]); f[3] = hi_f(u[1]); f[4] = lo_f(u[2]); f[5] = hi_f(u[2]); f[6] = lo_f(u[3]); f[7] = hi_f(u[3]);
}
__device__ __forceinline__ u32x4 pack8(const float (&f)[8]) { u32x4 r; r[0] = cvt_pk_bf16(f[0], f[1]); r[1] = cvt_pk_bf16(f[2], f[3]); r[2] = cvt_pk_bf16(f[4], f[5]); r[3] = cvt_pk_bf16(f[6], f[7]); return r; }

constexpr int BM = 256, BK = 64, HALF = 128, HTB = HALF * BK * 2, STAGE_BYTES = 8 * HTB;
__device__ __forceinline__ int lds_byte(int r, int c) { const int st = (r >> 4) * 2 + (c >> 5), rr = r & 15, cc = c & 31, ob = rr * 64 + cc * 2; return st * 1024 + (ob ^ (((ob >> 9) & 1) << 5)); }
__device__ __forceinline__ void stage_rc(int b, int& R, int& C) { const int st = b / 1024, sb = b % 1024, swz = sb ^ (((sb >> 9) & 1) << 5); R = (st >> 1) * 16 + swz / 64; C = (st & 1) * 32 + (swz % 64) / 2; }
__device__ __forceinline__ int perm32(int rho) { const int n = rho >> 4, i = rho & 15; return 8 * (i >> 2) + 4 * n + (i & 3); }

struct Unit { const char* A; const char* B; int row0, pn, z, half; };

__device__ __forceinline__ void tile_of(int L, int nM, int nN, int& pm, int& pn) {
    const int nwg = nM * nN; int wgid = L;
    { const int q = nwg / 8, r = nwg % 8, xcd = wgid % 8, off = wgid / 8; wgid = (xcd < r ? xcd * (q + 1) : r * (q + 1) + (xcd - r) * q) + off; }
    const int nig = 8 * nN, gid = wgid / nig, fm = gid * 8, gsz = (nM - fm) < 8 ? (nM - fm) : 8;
    pm = fm + ((wgid % nig) % gsz); pn = (wgid % nig) / gsz;
}

template <class Sched, class Epi>
__device__ __forceinline__ void gemm_phase(LAS unsigned char* lds, const Sched& S, const Epi& E, const int K, const int lda, const int ldb) {
    const int tid = tid_opaque(), wid = __builtin_amdgcn_readfirstlane(tid >> 6), lane = tid & 63, wr = wid >> 2, wc = wid & 3, fr = lane & 15, fq = lane >> 4;
    const int nt = K / BK;
    unsigned voffA[2], voffB[2];
#pragma unroll
    for (int i = 0; i < 2; ++i) { int R, C; stage_rc(tid * 16 + i * 8192, R, C); const int Rb = (R & ~31) + perm32(R & 31);
        voffA[i] = (unsigned)(R * lda + C) * 2u; voffB[i] = (unsigned)(Rb * ldb + C) * 2u; }
    const size_t kstep = (size_t)(BK * 2);
    const size_t hstepA = (size_t)HALF * lda * 2, hstepB = (size_t)HALF * ldb * 2;
    const unsigned ldsw = (unsigned)wid * 1024u;
    const int aoff = lds_byte(wr * 64 + fr, fq * 8), boff = lds_byte(wc * 32 + fr, fq * 8);
#define PG8_SA(b, h) (((b) * 2 + (h)) * HTB)
#define PG8_SB(b, h) ((4 + (b) * 2 + (h)) * HTB)
#define PG8_STAGE(bufoff, gbase, voff) do { _Pragma("unroll") for (int _i = 0; _i < 2; ++_i) \
        __builtin_amdgcn_global_load_lds((const unsigned*)((const char*)(gbase) + (voff)[_i]), (LAS unsigned*)(lds + (bufoff) + ldsw + _i * 8192), 16, 0, 0); } while (0)
#define PG8_LDA(dst, b, h) do { _Pragma("unroll") for (int m = 0; m < 4; ++m) _Pragma("unroll") for (int k = 0; k < 2; ++k) dst[m][k] = *(const LAS bf16x8*)(lds + PG8_SA(b, h) + aoff + m * 2048 + k * 1024); } while (0)
#define PG8_LDB(dst, b, h) do { _Pragma("unroll") for (int n = 0; n < 2; ++n) _Pragma("unroll") for (int k = 0; k < 2; ++k) dst[n][k] = *(const LAS bf16x8*)(lds + PG8_SB(b, h) + boff + n * 2048 + k * 1024); } while (0)
#define PG8_MMA(ai, bj, At, Bt) do { __builtin_amdgcn_s_setprio(1); _Pragma("unroll") for (int m = 0; m < 4; ++m) _Pragma("unroll") for (int n = 0; n < 2; ++n) _Pragma("unroll") for (int k = 0; k < 2; ++k) \
        acc[ai][bj][m][n] = __builtin_amdgcn_mfma_f32_16x16x32_bf16(Bt[n][k], At[m][k], acc[ai][bj][m][n], 0, 0, 0); __builtin_amdgcn_s_setprio(0); } while (0)
#define PG8_WAIT_V(n) asm volatile("s_waitcnt vmcnt(" #n ")" ::: "memory")
#define PG8_WAIT_L(n) asm volatile("s_waitcnt lgkmcnt(" #n ")" ::: "memory")
#define PG8_BAR __builtin_amdgcn_s_barrier()
#define PG8_SCHED __builtin_amdgcn_sched_barrier(0)
    Unit cur, nxt; int ui = 0;
    if (!S.next(0, cur)) return;
    f32x4 acc[2][2][4][2];
#pragma unroll
    for (int a = 0; a < 2; ++a)
#pragma unroll
        for (int b = 0; b < 2; ++b)
#pragma unroll
            for (int m = 0; m < 4; ++m)
#pragma unroll
                for (int n = 0; n < 2; ++n) acc[a][b][m][n] = (f32x4){0.f, 0.f, 0.f, 0.f};
    bf16x8 At[4][2], B0[2][2], B1[2][2];
    const char* cA = cur.A; const char* cB = cur.B;
    PG8_STAGE(PG8_SB(0, 0), cB, voffB); PG8_STAGE(PG8_SA(0, 0), cA, voffA); PG8_STAGE(PG8_SB(0, 1), cB + hstepB, voffB); PG8_STAGE(PG8_SA(0, 1), cA + hstepA, voffA);
    if (wr == 1) PG8_BAR;
    PG8_WAIT_V(4); PG8_BAR;
    PG8_STAGE(PG8_SB(1, 0), cB + kstep, voffB); PG8_STAGE(PG8_SA(1, 0), cA + kstep, voffA); PG8_STAGE(PG8_SB(1, 1), cB + hstepB + kstep, voffB);
    PG8_WAIT_V(6); PG8_BAR;
    for (;;) {
        const bool has_next = S.next(ui + 1, nxt);
        const char* nA = has_next ? nxt.A : cA; const char* nB = has_next ? nxt.B : cB;
        const bool chalf = cur.half != 0;
        for (int t = 0; t < nt; t += 2) {
            const bool last = (t == nt - 2);
            const char* a1 = cA + (size_t)(t + 1) * kstep;
            const char* a2 = last ? nA : cA + (size_t)(t + 2) * kstep; const char* b2 = last ? nB : cB + (size_t)(t + 2) * kstep;
            const char* a3 = a2 + kstep; const char* b3 = b2 + kstep;
            PG8_LDB(B0, 0, 0); PG8_SCHED; PG8_LDA(At, 0, 0); PG8_STAGE(PG8_SA(1, 1), a1 + hstepA, voffA);
            PG8_WAIT_L(8); PG8_BAR; PG8_WAIT_L(0); PG8_MMA(0, 0, At, B0); PG8_BAR; PG8_SCHED;
            PG8_LDB(B1, 0, 1); PG8_STAGE(PG8_SB(0, 0), b2, voffB);
            PG8_BAR; PG8_WAIT_L(0); PG8_MMA(0, 1, At, B1); PG8_BAR;
            PG8_LDA(At, 0, 1); PG8_STAGE(PG8_SA(0, 0), a2, voffA);
            PG8_BAR; PG8_WAIT_L(0); if (!chalf) PG8_MMA(1, 0, At, B0); PG8_BAR; PG8_SCHED;
            PG8_STAGE(PG8_SB(0, 1), b2 + hstepB, voffB);
            PG8_WAIT_V(6); PG8_BAR; if (!chalf) PG8_MMA(1, 1, At, B1); PG8_BAR;
            PG8_LDB(B0, 1, 0); PG8_SCHED; PG8_LDA(At, 1, 0); PG8_STAGE(PG8_SA(0, 1), a2 + hstepA, voffA);
            PG8_WAIT_L(8); PG8_BAR; PG8_WAIT_L(0); PG8_MMA(0, 0, At, B0); PG8_BAR; PG8_SCHED;
            PG8_LDB(B1, 1, 1); PG8_STAGE(PG8_SB(1, 0), b3, voffB);
            PG8_BAR; PG8_WAIT_L(0); PG8_MMA(0, 1, At, B1); PG8_BAR;
            PG8_LDA(At, 1, 1); PG8_STAGE(PG8_SA(1, 0), a3, voffA);
            PG8_BAR; PG8_WAIT_L(0); if (!chalf) PG8_MMA(1, 0, At, B0); PG8_BAR; PG8_SCHED;
            PG8_STAGE(PG8_SB(1, 1), b3 + hstepB, voffB);
            PG8_WAIT_V(6); PG8_BAR; if (!chalf) PG8_MMA(1, 1, At, B1); PG8_BAR;
        }
        E(acc, cur, wr, wc, fr, fq);
        if (!has_next) break;
#pragma unroll
        for (int a = 0; a < 2; ++a)
#pragma unroll
            for (int b = 0; b < 2; ++b)
#pragma unroll
                for (int m = 0; m < 4; ++m)
#pragma unroll
                    for (int n = 0; n < 2; ++n) acc[a][b][m][n] = (f32x4){0.f, 0.f, 0.f, 0.f};
        cur = nxt; cA = nA; cB = nB; ++ui;
    }
    PG8_WAIT_V(0);
    if (wr == 0) PG8_BAR;
    PG8_BAR;
#undef PG8_SA
#undef PG8_SB
#undef PG8_STAGE
#undef PG8_LDA
#undef PG8_LDB
#undef PG8_MMA
#undef PG8_WAIT_V
#undef PG8_WAIT_L
#undef PG8_BAR
#undef PG8_SCHED
}

typedef f32x4 AccT[2][2][4][2];
#define EPI_ARGS const AccT& acc, const Unit& u, int wr, int wc, int fr, int fq
#define EPI_FOR_ROWS _Pragma("unroll") for (int ai = 0; ai < 2; ++ai) if (ai == 0 || !u.half) _Pragma("unroll") for (int m = 0; m < 4; ++m)
#define EPI_ROW (u.row0 + wr * 64 + fr + ai * 128 + m * 16)
#define EPI_COL(bj) (u.pn * 256 + wc * 32 + 8 * fq + (bj) * 128)

struct SchedGrid {
    const char* A; const char* B; int nM, nN, lda, ldb, G, c, nh, hrow0, cnt;
    __device__ __forceinline__ bool next(int i, Unit& u) const {
        const long L = (long)i * G + c; const int nfull = nM * nN; if (i >= cnt || L >= (long)nfull + nh * nN) return false;
        int pm;
        if (L < nfull) { tile_of((int)L, nM, nN, pm, u.pn); u.row0 = pm * 256; u.half = 0; }
        else { const int e = (int)L - nfull; u.pn = e % nN; u.row0 = hrow0 + (e / nN) * 128; u.half = 1; }
        u.z = 0; u.A = A + (size_t)u.row0 * lda * 2; u.B = B + (size_t)u.pn * 256 * ldb * 2; return true;
    }
};
struct SchedMerge {
    const char* A0; const char* B0; int nM, G, c, nh, hrow0;
    __device__ __forceinline__ bool next(int i, Unit& u) const {
        const int j = i / 3, br = i - 3 * j; const long L = (long)j * G + c; const int nfull = nM * 8; if (L >= (long)nfull + nh * 8) return false;
        int pm;
        if (L < nfull) { tile_of((int)L, nM, 8, pm, u.pn); u.row0 = pm * 256; u.half = 0; }
        else { const int e = (int)L - nfull; u.pn = e & 7; u.row0 = hrow0 + (e >> 3) * 128; u.half = 1; }
        u.z = br;
        u.A = A0 + (size_t)br * SZ_BR + (size_t)u.row0 * 1024 * 2; u.B = B0 + (size_t)br * SZ_P + (size_t)u.pn * 256 * 1024 * 2; return true;
    }
};
struct SchedWp {
    const unsigned char* ws; int G, c;
    __device__ __forceinline__ bool next(int i, Unit& u) const {
        const long L = (long)i * G + c; if (L >= 64) return false;
        const int l = (int)L >> 5, grp = ((int)L >> 3) & 3, pm = ((int)L >> 1) & 3; u.row0 = pm * 256; u.half = 0; u.pn = (int)L & 1; u.z = l * 4 + grp;
        u.A = (const char*)ws + l * SZ_LAYER + LO_FW + ((size_t)pm * 256 * 1024 + grp * 256) * 2;
        u.B = (const char*)ws + O_TAB + T_CS + (size_t)u.pn * 256 * 256 * 2; return true;
    }
};

struct EpiStoreBf16 { bf16_t* O; int ldc;
    __device__ __forceinline__ void operator()(EPI_ARGS) const {
        EPI_FOR_ROWS { bf16_t* rp = O + (size_t)EPI_ROW * ldc;
#pragma unroll
            for (int bj = 0; bj < 2; ++bj) { const f32x4 v0 = acc[ai][bj][m][0], v1 = acc[ai][bj][m][1]; u32x4 o;
                o[0] = cvt_pk_bf16(v0[0], v0[1]); o[1] = cvt_pk_bf16(v0[2], v0[3]); o[2] = cvt_pk_bf16(v1[0], v1[1]); o[3] = cvt_pk_bf16(v1[2], v1[3]);
                *(u32x4*)(rp + EPI_COL(bj)) = o; } }
    }
};
struct EpiParts { bf16_t* O;
    __device__ __forceinline__ void operator()(EPI_ARGS) const {
        const int c0 = u.pn * 256; size_t eb; int pitch, cl;
        if (c0 < C_U) { eb = E_PC; pitch = 4096; cl = c0; } else if (c0 < C_ZB) { eb = E_PU; pitch = 1024; cl = c0 - C_U; } else if (c0 < C_F) { eb = E_PZB; pitch = 1024; cl = c0 - C_ZB; }
        else if (c0 < C_ZC) { eb = E_PF; pitch = 1024; cl = c0 - C_F; } else if (c0 < C_GL) { eb = E_PZC; pitch = 1024; cl = c0 - C_ZC; } else { eb = E_PGL; pitch = 6144; cl = c0 - C_GL; }
        bf16_t* base = O + eb + cl + wc * 32 + 8 * fq;
        EPI_FOR_ROWS { bf16_t* rp = base + (size_t)EPI_ROW * pitch;
#pragma unroll
            for (int bj = 0; bj < 2; ++bj) { const f32x4 v0 = acc[ai][bj][m][0], v1 = acc[ai][bj][m][1]; u32x4 o;
                o[0] = cvt_pk_bf16(v0[0], v0[1]); o[1] = cvt_pk_bf16(v0[2], v0[3]); o[2] = cvt_pk_bf16(v1[0], v1[1]); o[3] = cvt_pk_bf16(v1[2], v1[3]);
                *(u32x4*)(rp + bj * 128) = o; } }
    }
};
struct EpiStoreF32 { float* O; int ldc;
    __device__ __forceinline__ void operator()(EPI_ARGS) const {
        EPI_FOR_ROWS { float* rp = O + (size_t)EPI_ROW * ldc;
#pragma unroll
            for (int bj = 0; bj < 2; ++bj) { *(f32x4*)(rp + EPI_COL(bj)) = acc[ai][bj][m][0]; *(f32x4*)(rp + EPI_COL(bj) + 4) = acc[ai][bj][m][1]; } }
    }
};
struct EpiWp { unsigned char* ws;
    __device__ __forceinline__ void operator()(EPI_ARGS) const {
        const int l = u.z >> 2, grp = u.z & 3; bf16_t* O = (bf16_t*)(ws + l * SZ_LAYER + LO_WP);
        EPI_FOR_ROWS { bf16_t* rp = O + (size_t)EPI_ROW * 2048 + u.pn * 1024 + grp * 256;
#pragma unroll
            for (int bj = 0; bj < 2; ++bj) { const f32x4 v0 = acc[ai][bj][m][0], v1 = acc[ai][bj][m][1]; u32x4 o;
                o[0] = cvt_pk_bf16(v0[0], v0[1]); o[1] = cvt_pk_bf16(v0[2], v0[3]); o[2] = cvt_pk_bf16(v1[0], v1[1]); o[3] = cvt_pk_bf16(v1[2], v1[3]);
                *(u32x4*)(rp + wc * 32 + 8 * fq + bj * 128) = o; } }
    }
};
struct EpiFourier { const bf16_t* parts; bf16_t* O;
    __device__ __forceinline__ void operator()(EPI_ARGS) const {
#pragma unroll
        for (int ai = 0; ai < 2; ++ai) if (ai == 0 || !u.half) { u32x4 zz[4][2];
#pragma unroll
            for (int m = 0; m < 4; ++m)
#pragma unroll
                for (int bj = 0; bj < 2; ++bj) zz[m][bj] = *(const u32x4*)(parts + E_PZC + (size_t)EPI_ROW * 1024 + EPI_COL(bj));
#pragma unroll
            for (int m = 0; m < 4; ++m)
#pragma unroll
                for (int bj = 0; bj < 2; ++bj) { const f32x4 v0 = acc[ai][bj][m][0], v1 = acc[ai][bj][m][1]; float z[8]; unpack8(zz[m][bj], z); float o[8];
#pragma unroll
                    for (int j = 0; j < 4; ++j) { o[j] = v0[j] * siluf_(z[j]); o[4 + j] = v1[j] * siluf_(z[4 + j]); }
                    *(u32x4*)(O + (size_t)EPI_ROW * 1024 + EPI_COL(bj)) = pack8(o); } }
    }
};
struct EpiGlu { const bf16_t* parts; bf16_t* O;
    __device__ __forceinline__ void operator()(EPI_ARGS) const {
        const int col = u.pn * 128 + wc * 32 + 8 * fq;
#pragma unroll
        for (int ai = 0; ai < 2; ++ai) if (ai == 0 || !u.half) { u32x4 zz[4];
#pragma unroll
            for (int m = 0; m < 4; ++m) zz[m] = *(const u32x4*)(parts + E_PZB + (size_t)EPI_ROW * 1024 + col);
#pragma unroll
            for (int m = 0; m < 4; ++m) { float z[8]; unpack8(zz[m], z);
                const f32x4 a0 = acc[ai][0][m][0], a1 = acc[ai][0][m][1], b0 = acc[ai][1][m][0], b1 = acc[ai][1][m][1]; float o[8];
#pragma unroll
                for (int j = 0; j < 4; ++j) { o[j] = a0[j] * z[j] * __builtin_amdgcn_rcpf((1.0f + __expf(-b0[j])) * (1.0f + __expf(-z[j]))); o[4 + j] = a1[j] * z[4 + j] * __builtin_amdgcn_rcpf((1.0f + __expf(-b1[j])) * (1.0f + __expf(-z[4 + j]))); }
                *(u32x4*)(O + (size_t)EPI_ROW * 1024 + col) = pack8(o); } }
    }
};
struct EpiMerge { const bf16_t* parts; bf16_t* MB;
    __device__ __forceinline__ void operator()(EPI_ARGS) const {
        const int br = u.z; const int nb = u.half ? 2 : 4;
        u32x4 gg[2][4], pp[2][4];
#define MRG_LOAD(slot, bidx_) { const int ai = (bidx_) >> 1, bj = (bidx_) & 1; _Pragma("unroll") for (int m = 0; m < 4; ++m) { \
            gg[slot][m] = *(const u32x4*)(parts + E_PGL + (size_t)EPI_ROW * 6144 + br * DM + EPI_COL(bj)); \
            pp[slot][m] = br > 0 ? *(const u32x4*)(MB + (size_t)EPI_ROW * DM + EPI_COL(bj)) : (u32x4){0u, 0u, 0u, 0u}; } }
#define MRG_EMIT(slot, bidx_) { const int ai = (bidx_) >> 1, bj = (bidx_) & 1; _Pragma("unroll") for (int m = 0; m < 4; ++m) { \
            const f32x4 v0 = acc[ai][bj][m][0], v1 = acc[ai][bj][m][1]; float g[8], pv[8], o[8]; unpack8(gg[slot][m], g); unpack8(pp[slot][m], pv); \
            _Pragma("unroll") for (int j = 0; j < 4; ++j) { o[j] = v0[j] * sigmoidf_(g[j]) + pv[j]; o[4 + j] = v1[j] * sigmoidf_(g[4 + j]) + pv[4 + j]; } \
            *(u32x4*)(MB + (size_t)EPI_ROW * DM + EPI_COL(bj)) = pack8(o); } }
        MRG_LOAD(0, 0)
        MRG_LOAD(1, 1)
        MRG_EMIT(0, 0)
        if (nb > 2) MRG_LOAD(0, 2)
        MRG_EMIT(1, 1)
        if (nb > 2) { MRG_LOAD(1, 3) MRG_EMIT(0, 2) MRG_EMIT(1, 3) }
#undef MRG_LOAD
#undef MRG_EMIT
    }
};

template <int MTL, int NT, class BL>
__device__ __forceinline__ void lmul_core(const bf16_t* __restrict__ D, const int ldd, const int ksteps, const BL& bl, f32x4 (&acc)[MTL][NT], const int lane) {
    const int r = lane & 15, q = lane >> 4;
    const bf16_t* dp = D + (size_t)r * ldd + q * 8;
#pragma unroll
    for (int a = 0; a < MTL; ++a)
#pragma unroll
        for (int b = 0; b < NT; ++b) acc[a][b] = (f32x4){0.f, 0.f, 0.f, 0.f};
#pragma unroll 1
    for (int ks = 0; ks < ksteps; ++ks) {
        bf16x8 bf[NT];
#pragma unroll
        for (int b = 0; b < NT; ++b) bf[b] = bl(ks, b);
#pragma unroll
        for (int a = 0; a < MTL; ++a) { const bf16x8 af = *(const bf16x8*)(dp + (size_t)a * 16 * ldd + ks * 32);
#pragma unroll
            for (int b = 0; b < NT; ++b) acc[a][b] = __builtin_amdgcn_mfma_f32_16x16x32_bf16(af, bf[b], acc[a][b], 0, 0, 0); }
    }
}
template <int MTL>
__device__ __forceinline__ void lmul_g4(const bf16_t* __restrict__ D, const int ldd, const int ksteps, const bf16_t* __restrict__ base, const size_t rs, f32x4 (&acc)[MTL][4], const int lane) {
    const int r = lane & 15, q = lane >> 4;
    const bf16_t* dp = D + (size_t)r * ldd + q * 8;
#pragma unroll
    for (int a = 0; a < MTL; ++a)
#pragma unroll
        for (int b = 0; b < 4; ++b) acc[a][b] = (f32x4){0.f, 0.f, 0.f, 0.f};
    u32x2 w[8];
    { const bf16_t* p = base + (size_t)(q * 8) * rs;
#pragma unroll
      for (int j = 0; j < 8; ++j) w[j] = *(const u32x2*)(p + (size_t)j * rs); }
#pragma unroll 1
    for (int ks = 0; ks < ksteps; ++ks) {
        u32x2 wn[8];
        if (ks + 1 < ksteps) { const bf16_t* p = base + (size_t)((ks + 1) * 32 + q * 8) * rs;
#pragma unroll
            for (int j = 0; j < 8; ++j) wn[j] = *(const u32x2*)(p + (size_t)j * rs); }
        else {
#pragma unroll
            for (int j = 0; j < 8; ++j) wn[j] = w[j]; }
        union { bf16x8 v; unsigned d[4]; } f0, f1, f2, f3;
#pragma unroll
        for (int d = 0; d < 4; ++d) { const unsigned a0 = w[2 * d][0], a1 = w[2 * d + 1][0], c0 = w[2 * d][1], c1 = w[2 * d + 1][1];
            f0.d[d] = (a0 & 0xffffu) | (a1 << 16); f1.d[d] = (a0 >> 16) | (a1 & 0xffff0000u); f2.d[d] = (c0 & 0xffffu) | (c1 << 16); f3.d[d] = (c0 >> 16) | (c1 & 0xffff0000u); }
#pragma unroll
        for (int a = 0; a < MTL; ++a) { const bf16x8 af = *(const bf16x8*)(dp + (size_t)a * 16 * ldd + ks * 32);
            acc[a][0] = __builtin_amdgcn_mfma_f32_16x16x32_bf16(af, f0.v, acc[a][0], 0, 0, 0); acc[a][1] = __builtin_amdgcn_mfma_f32_16x16x32_bf16(af, f1.v, acc[a][1], 0, 0, 0);
            acc[a][2] = __builtin_amdgcn_mfma_f32_16x16x32_bf16(af, f2.v, acc[a][2], 0, 0, 0); acc[a][3] = __builtin_amdgcn_mfma_f32_16x16x32_bf16(af, f3.v, acc[a][3], 0, 0, 0); }
#pragma unroll
        for (int j = 0; j < 8; ++j) w[j] = wn[j];
    }
}
struct BLGather { const bf16_t* base; size_t rs; int lane;
    __device__ __forceinline__ bf16x8 operator()(int ks, int b) const {
        const int q = lane >> 4; const bf16_t* p = base + (size_t)(ks * 32 + q * 8) * rs + b * 16; bf16x8 v;
#pragma unroll
        for (int j = 0; j < 8; ++j) v[j] = (short)p[(size_t)j * rs];
        return v; }
};
__device__ __forceinline__ int ssm_row(int col, int s) { return col < 512 ? ((col >> 8) * SEQ + (col & 255) * 16 + s) : (MX + ((col - 512) >> 4) * LCX + ((col - 512) & 15) * 16 + s); }
template <int KW, bool YST>
__device__ __forceinline__ void ssm_stage_lds(PREF P, const int l, const int wi, unsigned char* shm, const int tid) {
    const int lane = tid & 63, wv = tid >> 6, r = lane & 15, q = lane >> 4;
    const int g = wi >> 2, mh = (wi >> 1) & 1, half = wi & 1;
    unsigned char* wl = P.ws + l * SZ_LAYER; const bf16_t* parts = (const bf16_t*)(P.ws + O_PARTS);
    const bf16_t* D = (const bf16_t*)(wl + (YST ? LO_M2 : LO_M1)) + ((size_t)g * 256 + mh * 128) * KW;
    LAS unsigned char* lds = (LAS unsigned char*)shm;
    constexpr int CPR = KW / 8, KS = KW / 32;
    for (int ch = tid; ch < 128 * CPR; ch += 512) { const int row = ch / CPR, c = ch % CPR; const u32x4 v = *(const u32x4*)(D + (size_t)row * KW + c * 8);
        *(LAS u32x4*)(lds + row * (KW * 2) + ((c ^ (row & 15)) << 4)) = v; }
    __syncthreads();
    const int nct = (YST && l == 1) ? 16 : 17, hsplit = (nct + 1) / 2;
    const int t0 = half == 0 ? 0 : hsplit, t1 = half == 0 ? hsplit : nct;
    const bf16_t* HS = (const bf16_t*)(P.ws + O_HS);
    for (int ct = t0 + wv; ct < t1; ct += 8) {
        f32x4 acc[8][2];
#pragma unroll
        for (int a = 0; a < 8; ++a) { acc[a][0] = (f32x4){0.f, 0.f, 0.f, 0.f}; acc[a][1] = (f32x4){0.f, 0.f, 0.f, 0.f}; }
        const int colA = ct * 32 + r, colB = colA + 16;
        const bf16_t* pu0 = parts + E_PU + (size_t)(ssm_row(colA, 0) + (q >> 1)) * 1024 + g * 16 + (q & 1) * 8;
        const bf16_t* pu1 = parts + E_PU + (size_t)(ssm_row(colB, 0) + (q >> 1)) * 1024 + g * 16 + (q & 1) * 8;
        const bf16_t* ph0 = HS + ((size_t)g * NCOL + colA) * 256 + q * 8; const bf16_t* ph1 = HS + ((size_t)g * NCOL + colB) * 256 + q * 8;
#pragma unroll
        for (int kh = 0; kh < KS / 8; ++kh) {
            bf16x8 bq[8][2];
#pragma unroll
            for (int k8 = 0; k8 < 8; ++k8) {
                if (kh == 0) { bq[k8][0] = *(const bf16x8*)(pu0 + (size_t)k8 * 2 * 1024); bq[k8][1] = *(const bf16x8*)(pu1 + (size_t)k8 * 2 * 1024); }
                else { bq[k8][0] = *(const bf16x8*)(ph0 + k8 * 32); bq[k8][1] = *(const bf16x8*)(ph1 + k8 * 32); } }
#pragma unroll
            for (int k8 = 0; k8 < 8; ++k8) { const int ks = kh * 8 + k8;
                __builtin_amdgcn_sched_barrier(0);
#pragma unroll
                for (int a = 0; a < 8; ++a) { const bf16x8 af = *(const LAS bf16x8*)(lds + (a * 16 + r) * (KW * 2) + (((ks * 4 + q) ^ r) << 4));
                    acc[a][0] = __builtin_amdgcn_mfma_f32_16x16x32_bf16(af, bq[k8][0], acc[a][0], 0, 0, 0); acc[a][1] = __builtin_amdgcn_mfma_f32_16x16x32_bf16(af, bq[k8][1], acc[a][1], 0, 0, 0); }
            }
            __builtin_amdgcn_sched_barrier(0);
        }
        if (!YST) { float* EB = (float*)(P.ws + O_EB);
#pragma unroll
            for (int a = 0; a < 8; ++a)
#pragma unroll
                for (int b = 0; b < 2; ++b) { const int col = ct * 32 + b * 16 + r; *(f32x4*)(EB + ((size_t)g * NCOL + col) * 256 + mh * 128 + a * 16 + q * 4) = acc[a][b]; }
        } else { bf16_t* GB = (bf16_t*)(P.ws + O_GB); const f32x4 dv = *(const f32x4*)(P.ssm_d + l * 1024 + g * 16 + q * 4);
#pragma unroll
            for (int a = 0; a < 8; ++a)
#pragma unroll
                for (int b = 0; b < 2; ++b) { const int col = ct * 32 + b * 16 + r, t = mh * 8 + a, row = ssm_row(col, t);
                    const u32x2 uu = *(const u32x2*)(parts + E_PU + (size_t)row * 1024 + g * 16 + q * 4);
                    const float y0 = gelu_tanh(acc[a][b][0] + dv[0] * lo_f(uu[0])), y1 = gelu_tanh(acc[a][b][1] + dv[1] * hi_f(uu[0])), y2 = gelu_tanh(acc[a][b][2] + dv[2] * lo_f(uu[1])), y3 = gelu_tanh(acc[a][b][3] + dv[3] * hi_f(uu[1]));
                    u32x2 o; o[0] = cvt_pk_bf16(y0, y1); o[1] = cvt_pk_bf16(y2, y3); *(u32x2*)(GB + (size_t)row * 1024 + g * 16 + q * 4) = o; }
        }
    }
    __syncthreads();
}


template <int MODE>
__device__ __forceinline__ void ctx_small_gemm(PREF P, unsigned char* shm) {
    constexpr int K = MODE >= 2 ? 2048 : 1024, ROWS = MODE >= 2 ? 32 : 64, CPR = K / 8, KS = K / 32, NBR = MODE == 1 ? 3 : 1;
    const int tid = tid_opaque(), bidx = bid_opaque(), lane = tid & 63, w = tid >> 6, r = lane & 15, q = lane >> 4;
    unsigned char* wl = P.ws; const bf16_t* parts = (const bf16_t*)(P.ws + O_PARTS); LAS unsigned char* lds = (LAS unsigned char*)shm;
    for (int it = bidx; it < 256; it += gridDim.x) {
        const int rb = MODE >= 2 ? (it >> 4) : (it >> 5), cb = MODE >= 2 ? (it & 15) : (it & 31);
        const int row_base = MX + rb * ROWS;
        const int rt0 = MODE == 0 ? (w >> 1) : (MODE == 1 ? 2 * (w >> 2) : (MODE == 2 ? 0 : (w >> 2))), rt1 = (MODE == 0 || MODE == 3) ? rt0 : rt0 + 1;
        const int col0 = MODE == 0 ? cb * 32 + (w & 1) * 16 : (MODE == 1 ? cb * 64 + (w & 3) * 16 : (MODE == 2 ? cb * 128 + w * 16 : cb * 64 + (w & 3) * 16));
        float msum[2][4];
#pragma unroll
        for (int t = 0; t < 2; ++t)
#pragma unroll
            for (int i = 0; i < 4; ++i) msum[t][i] = 0.f;
#pragma unroll 1
        for (int br = 0; br < NBR; ++br) {
            const bf16_t* Asrc = MODE == 0 ? (const bf16_t*)(P.ws + O_GB) : (MODE == 1 ? (const bf16_t*)(P.ws + O_AB + (size_t)br * SZ_BR) : (MODE == 2 ? (const bf16_t*)(P.ws + O_HB) : (const bf16_t*)(P.ws + O_YB)));
            for (int ch = tid; ch < ROWS * CPR; ch += 512) { const int row = ch / CPR, c = ch % CPR; const u32x4 v = *(const u32x4*)(Asrc + (size_t)(row_base + row) * K + c * 8);
                *(LAS u32x4*)(lds + row * (K * 2) + ((c ^ (row & 15)) << 4)) = v; }
            __syncthreads();
            const bf16_t* W0; const bf16_t* W1;
            if (MODE == 0) { const int oc = col0 + r; W0 = (const bf16_t*)(wl + LO_GLU) + (size_t)((oc >> 7) * 256 + (oc & 127)) * K + q * 8; W1 = W0 + (size_t)128 * K; }
            else if (MODE == 1) { W0 = (const bf16_t*)(wl + LO_PA + (size_t)br * SZ_P) + (size_t)(col0 + r) * K + q * 8; W1 = W0; }
            else if (MODE == 2) { W0 = (const bf16_t*)(wl + LO_WO) + (size_t)(col0 + r) * K + q * 8; W1 = W0; }
            else { W0 = (const bf16_t*)(wl + LO_WP) + (size_t)(col0 + r) * K + q * 8; W1 = W0; }
            f32x4 acc0 = (f32x4){0.f, 0.f, 0.f, 0.f}, acc1 = (f32x4){0.f, 0.f, 0.f, 0.f};
#pragma unroll 4
            for (int ks = 0; ks < KS; ++ks) {
                const bf16x8 a0 = *(const LAS bf16x8*)(lds + (rt0 * 16 + r) * (K * 2) + (((ks * 4 + q) ^ r) << 4));
                const bf16x8 b0 = *(const bf16x8*)(W0 + ks * 32);
                if (MODE == 0) { const bf16x8 b1 = *(const bf16x8*)(W1 + ks * 32);
                    acc0 = __builtin_amdgcn_mfma_f32_16x16x32_bf16(a0, b0, acc0, 0, 0, 0); acc1 = __builtin_amdgcn_mfma_f32_16x16x32_bf16(a0, b1, acc1, 0, 0, 0); }
                else if (MODE == 3) { acc0 = __builtin_amdgcn_mfma_f32_16x16x32_bf16(a0, b0, acc0, 0, 0, 0); }
                else { const bf16x8 a1 = *(const LAS bf16x8*)(lds + (rt1 * 16 + r) * (K * 2) + (((ks * 4 + q) ^ r) << 4));
                    acc0 = __builtin_amdgcn_mfma_f32_16x16x32_bf16(a0, b0, acc0, 0, 0, 0); acc1 = __builtin_amdgcn_mfma_f32_16x16x32_bf16(a1, b0, acc1, 0, 0, 0); }
            }
            const int col = col0 + r;
            if (MODE == 0) { bf16_t* BBo = (bf16_t*)(P.ws + O_BB);
#pragma unroll
                for (int i = 0; i < 4; ++i) { const int row = row_base + rt0 * 16 + q * 4 + i; const float z = bf2f(parts[E_PZB + (size_t)row * 1024 + col]);
                    BBo[(size_t)row * 1024 + col] = (bf16_t)(cvt_pk_bf16(acc0[i] * sigmoidf_(acc1[i]) * siluf_(z), 0.f) & 0xffffu); }
            } else if (MODE == 1) {
#pragma unroll
                for (int i = 0; i < 4; ++i) { const int rowa = row_base + rt0 * 16 + q * 4 + i, rowb = row_base + rt1 * 16 + q * 4 + i;
                    msum[0][i] += acc0[i] * sigmoidf_(bf2f(parts[E_PGL + (size_t)rowa * 6144 + br * DM + col])); msum[1][i] += acc1[i] * sigmoidf_(bf2f(parts[E_PGL + (size_t)rowb * 6144 + br * DM + col])); }
            } else if (MODE == 3) { bf16_t* CBo = (bf16_t*)(P.ws + O_CB);
#pragma unroll
                for (int i = 0; i < 4; ++i) { const int row = row_base + rt0 * 16 + q * 4 + i; const float z = bf2f(parts[E_PZC + (size_t)row * 1024 + col]);
                    CBo[(size_t)row * 1024 + col] = (bf16_t)(cvt_pk_bf16(acc0[i] * siluf_(z), 0.f) & 0xffffu); }
            } else { bf16_t* OBo = (bf16_t*)(P.ws + O_PARTS);
#pragma unroll
                for (int i = 0; i < 4; ++i) { const int rowa = row_base + rt0 * 16 + q * 4 + i, rowb = row_base + rt1 * 16 + q * 4 + i;
                    OBo[(size_t)rowa * DM + col] = (bf16_t)(cvt_pk_bf16(acc0[i], 0.f) & 0xffffu); OBo[(size_t)rowb * DM + col] = (bf16_t)(cvt_pk_bf16(acc1[i], 0.f) & 0xffffu); }
            }
            __syncthreads();
        }
        if (MODE == 1) { bf16_t* MBo = (bf16_t*)(P.ws + O_HB); const int col = col0 + r;
#pragma unroll
            for (int i = 0; i < 4; ++i) { const int rowa = row_base + rt0 * 16 + q * 4 + i, rowb = row_base + rt1 * 16 + q * 4 + i;
                MBo[(size_t)rowa * DM + col] = (bf16_t)(cvt_pk_bf16(msum[0][i], 0.f) & 0xffffu); MBo[(size_t)rowb * DM + col] = (bf16_t)(cvt_pk_bf16(msum[1][i], 0.f) & 0xffffu); }
        }
    }
}

struct TileJob { const float* src; bf16_t* dst; int N, K, k0, n0, drow0; };
constexpr int TILES_PER_LAYER = 4736 + 512;
__device__ __forceinline__ TileJob tile_job(PREF P, int gt) {
    const int l = gt / TILES_PER_LAYER, tt = gt - l * TILES_PER_LAYER; unsigned char* wl = P.ws + l * SZ_LAYER; TileJob J; int kt, nt;
    if (tt < 3584) { J.src = P.w_in + (size_t)l * DM * INW; J.dst = (bf16_t*)(wl + LO_WIN); J.K = DM; J.N = INW; kt = tt & 15; nt = tt >> 4; J.drow0 = nt * 64; }
    else if (tt < 3584 + 768) { const int e = tt - 3584, w = e >> 8, f = e & 255; J.src = (w == 0 ? P.proj_a : (w == 1 ? P.proj_b : P.proj_c)) + (size_t)l * 1024 * DM;
        J.dst = (bf16_t*)(wl + LO_PA + (size_t)w * SZ_P); J.K = 1024; J.N = DM; kt = f & 7; nt = f >> 3; J.drow0 = nt * 64; }
    else if (tt < 4352 + 256) { const int e = tt - 4352, w = e >> 7, f = e & 127; J.src = (w == 0 ? P.glu_wa : P.glu_wb) + (size_t)l * 1024 * 1024; J.dst = (bf16_t*)(wl + LO_GLU);
        J.K = 1024; J.N = 1024; kt = f & 7; nt = f >> 3; const int n0 = nt * 64; J.drow0 = (n0 >> 7) * 256 + (n0 & 127) + w * 128; }
    else if (tt < 4608 + 128) { const int f = tt - 4608; J.src = P.fourier_w + (size_t)l * 1024 * 1024; J.dst = (bf16_t*)(wl + LO_FW); J.K = 1024; J.N = 1024; kt = f & 7; nt = f >> 3; J.drow0 = nt * 64; }
    else { const int f = tt - 4736; J.src = P.w_out + (size_t)l * DM * DM; J.dst = (bf16_t*)(wl + LO_WO); J.K = DM; J.N = DM; kt = f & 15; nt = f >> 4; J.drow0 = nt * 64; }
    J.k0 = kt * 128; J.n0 = nt * 64; return J;
}


__device__ __forceinline__ void mod_item(PREF P, int l, int nt, float* sm) {
    const int tid = tid_opaque(); float* sc = sm; float* red = sm + 3 * 2048;
    for (int i = tid; i < 3 * 2048; i += 512) { const int r = i >> 11, k = i & 2047; const float v = r < 2 ? P.c[r * 2048 + k] : P.c_ctx[k]; sc[i] = siluf_(v); }
    __syncthreads();
    const int col = tid & 63, kg = tid >> 6; const float* w = P.w_ada + (size_t)l * DM * 6144 + nt * 64 + col;
    float a0 = 0.f, a1 = 0.f, a2 = 0.f;
#pragma unroll 16
    for (int k = kg * 256; k < kg * 256 + 256; ++k) { const float wv = w[(size_t)k * 6144]; a0 += sc[k] * wv; a1 += sc[2048 + k] * wv; a2 += sc[4096 + k] * wv; }
    red[(kg * 3 + 0) * 64 + col] = a0; red[(kg * 3 + 1) * 64 + col] = a1; red[(kg * 3 + 2) * 64 + col] = a2;
    __syncthreads();
    if (tid < 192) { const int r = tid >> 6, c = tid & 63; float s = 0.f;
#pragma unroll
        for (int k = 0; k < 8; ++k) s += red[(k * 3 + r) * 64 + c];
        float* MOD = (float*)(P.ws + l * SZ_LAYER + LO_MOD); MOD[r * 6144 + nt * 64 + c] = s + P.b_ada[l * 6144 + nt * 64 + c]; }
    asm volatile("s_waitcnt vmcnt(0)" ::: "memory");
    __syncthreads();
    if (l == 0 && tid == 0) {
        __builtin_amdgcn_fence(__ATOMIC_RELEASE, "agent"); asm volatile("s_waitcnt vmcnt(0)" ::: "memory");
        __hip_atomic_fetch_add((unsigned*)(P.ws + O_BAR) + MODCNT_WORD, 1u, __ATOMIC_RELAXED, __HIP_MEMORY_SCOPE_AGENT); }
}

__device__ __forceinline__ void tables_item(PREF P, int it) {
    const int tid = tid_opaque(); unsigned char* tb = P.ws + O_TAB;
    if (it < 8) {
        bf16_t* T = (bf16_t*)(tb + T_CS);
        for (int e = tid; e < 64 * 256; e += 512) { const int row = it * 64 + (e >> 8), kc = e & 255, cs = row >> 8, j = row & 255; const int mm = (j * kc) & 255;
            float s, c; sincospif((float)mm * (1.0f / 128.0f), &s, &c); T[row * 256 + kc] = (bf16_t)(cvt_pk_bf16((cs ? s : c) * 0.0625f, 0.f) & 0xffffu); }
    } else if (it < 16) {
        bf16_t* T = (bf16_t*)(tb + T_DCTX); const int i8 = it - 8;
        for (int e = tid; e < 64 * 256; e += 512) { const int row = i8 * 64 + (e >> 8), t = e & 255, cs = row >> 8, k = row & 255; const int mm = (k * t) & 255;
            float s, c; sincospif((float)mm * (1.0f / 128.0f), &s, &c); T[row * 256 + t] = (bf16_t)(cvt_pk_bf16((cs ? -s : c) * 0.0625f, 0.f) & 0xffffu); }
    } else {
        bf16_t* D1 = (bf16_t*)(tb + T_D1); bf16_t* D2 = (bf16_t*)(tb + T_D2); float* TW = (float*)(tb + T_TW);
        for (int e = tid; e < 128 * 64; e += 512) { const int row = e >> 6, t1 = e & 63, cs = row >> 6, k1 = row & 63; const int mm = (k1 * t1) & 63;
            float s, c; sincospif((float)mm * (1.0f / 32.0f), &s, &c); D1[e] = (bf16_t)(cvt_pk_bf16((cs ? -s : c) * 0.125f, 0.f) & 0xffffu); }
        for (int e = tid; e < 128 * 128; e += 512) { const int row = e >> 7, col = e & 127, cso = row >> 6, k2 = row & 63, csi = col >> 6, t2 = col & 63; const int mm = (k2 * t2) & 63;
            float s, c; sincospif((float)mm * (1.0f / 32.0f), &s, &c); const float v = (cso == csi) ? c : (cso == 0 ? s : -s);
            D2[e] = (bf16_t)(cvt_pk_bf16(v * 0.125f, 0.f) & 0xffffu); }
        for (int e = tid; e < 64 * 64; e += 512) { const int k1 = e >> 6, t2 = e & 63; float s, c; sincospif((float)(k1 * t2) * (1.0f / 2048.0f), &s, &c); TW[2 * e] = c; TW[2 * e + 1] = -s; }
    }
}

__device__ __forceinline__ void ssm_build(PREF P, int l, int g, float* sm) {
    float* ap_re = sm; float* ap_im = ap_re + 2 * 17 * 64; float* bb_re = ap_im + 2 * 17 * 64; float* bb_im = bb_re + 2 * 64 * 16;
    float* cc_re = bb_im + 2 * 64 * 16; float* cc_im = cc_re + 2 * 16 * 64; float* Kk = cc_im + 2 * 16 * 64;
    const int tid = tid_opaque(); unsigned char* wl = P.ws + l * SZ_LAYER;
    if (tid < 128) {
        const int d = tid >> 6, p = tid & 63; const size_t gi = (size_t)(l * 2 + d) * 64 + g;
        const double lr = (double)P.lam_re[gi * 64 + p], li = (double)P.lam_im[gi * 64 + p], dt = exp((double)P.log_dt[gi]);
        const double a_re = exp(lr * dt) * cos(li * dt), a_im = exp(lr * dt) * sin(li * dt);
        { double pr = 1.0, pi = 0.0;
          for (int tau = 0; tau <= 16; ++tau) { ap_re[(d * 17 + tau) * 64 + p] = (float)pr; ap_im[(d * 17 + tau) * 64 + p] = (float)pi;
              if (tau == 16) { float* A16 = (float*)(wl + LO_A16); A16[((d * 64 + g) * 64 + p) * 2] = (float)pr; A16[((d * 64 + g) * 64 + p) * 2 + 1] = (float)pi; }
              const double nr = pr * a_re - pi * a_im, ni = pr * a_im + pi * a_re; pr = nr; pi = ni; } }
        const double n_re = a_re - 1.0, n_im = a_im, den = lr * lr + li * li;
        const double q_re = (n_re * lr + n_im * li) / den, q_im = (n_im * lr - n_re * li) / den;
        for (int h = 0; h < 16; ++h) { const double br = (double)P.b_re[(gi * 64 + p) * 16 + h], bi = (double)P.b_im[(gi * 64 + p) * 16 + h];
            bb_re[(d * 64 + p) * 16 + h] = (float)(q_re * br - q_im * bi); bb_im[(d * 64 + p) * 16 + h] = (float)(q_re * bi + q_im * br); }
    }
    for (int i = tid; i < 2048; i += 512) { const int d = i >> 10, rem = i & 1023; const size_t s = ((size_t)(l * 2 + d) * 64 + g) * 1024 + rem; cc_re[i] = P.c_re[s]; cc_im[i] = P.c_im[s]; }
    __syncthreads();
    { const int d = tid >> 8, tau = (tid >> 4) & 15, ho = tid & 15; float sacc[16];
#pragma unroll
      for (int hi = 0; hi < 16; ++hi) sacc[hi] = 0.f;
      for (int p = 0; p < 64; ++p) { const float cr = cc_re[(d * 16 + ho) * 64 + p], ci = cc_im[(d * 16 + ho) * 64 + p], ar = ap_re[(d * 17 + tau) * 64 + p], ai = ap_im[(d * 17 + tau) * 64 + p];
          const float wr = cr * ar - ci * ai, wi = cr * ai + ci * ar; const float* br = bb_re + (d * 64 + p) * 16; const float* bi = bb_im + (d * 64 + p) * 16;
#pragma unroll
          for (int hi = 0; hi < 16; ++hi) sacc[hi] += wr * br[hi] - wi * bi[hi]; }
#pragma unroll
      for (int hi = 0; hi < 16; ++hi) Kk[((d * 16 + tau) * 16 + ho) * 16 + hi] = sacc[hi]; }
    __syncthreads();
    bf16_t* M1 = (bf16_t*)(wl + LO_M1) + (size_t)g * 256 * 256; bf16_t* M2 = (bf16_t*)(wl + LO_M2) + (size_t)g * 256 * 512;
    for (int v = tid; v < 8192; v += 512) { const int mrow = v >> 5, k0 = (v & 31) * 8; const int d = mrow >> 7, reim = (mrow >> 6) & 1, p = mrow & 63, s = k0 >> 4, hi0 = k0 & 15;
        const int tau = d == 0 ? 15 - s : s; const float ar = ap_re[(d * 17 + tau) * 64 + p], ai = ap_im[(d * 17 + tau) * 64 + p]; float f[8];
#pragma unroll
        for (int j = 0; j < 8; ++j) { const float br = bb_re[(d * 64 + p) * 16 + hi0 + j], bi = bb_im[(d * 64 + p) * 16 + hi0 + j]; f[j] = reim == 0 ? ar * br - ai * bi : ar * bi + ai * br; }
        *(u32x4*)(M1 + (size_t)mrow * 256 + k0) = pack8(f); }
    for (int v = tid; v < 16384; v += 512) { const int r = v >> 6, k0 = (v & 63) * 8, t = r >> 4, ho = r & 15; float f[8];
        if (k0 < 256) { const int s = k0 >> 4, hi0 = k0 & 15;
#pragma unroll
            for (int j = 0; j < 8; ++j) f[j] = s < t ? Kk[(t - s) * 256 + ho * 16 + hi0 + j] : (s > t ? Kk[(16 + (s - t)) * 256 + ho * 16 + hi0 + j] : Kk[ho * 16 + hi0 + j] + Kk[16 * 256 + ho * 16 + hi0 + j]);
        } else { const int kk = k0 - 256, d = kk >> 7, reim = (kk >> 6) & 1, p0 = kk & 63, tau = d == 0 ? t + 1 : 16 - t;
#pragma unroll
            for (int j = 0; j < 8; ++j) { const int p = p0 + j; const float cr = cc_re[(d * 16 + ho) * 64 + p], ci = cc_im[(d * 16 + ho) * 64 + p], ar = ap_re[(d * 17 + tau) * 64 + p], ai = ap_im[(d * 17 + tau) * 64 + p];
                f[j] = reim == 0 ? cr * ar - ci * ai : -(cr * ai + ci * ar); } }
        *(u32x4*)(M2 + (size_t)r * 512 + k0) = pack8(f); }
    __syncthreads();
}

__device__ __forceinline__ void phase_prenorm0(PREF P);
__device__ __forceinline__ void phase_prep(PREF P, unsigned char* shm) {
    float* sm = (float*)shm; const int b = bid_opaque(), G = gridDim.x;
    for (int it = b; it < 337; it += G) {
        if (it < 128) ssm_build(P, it >> 6, it & 63, sm);
        else if (it < 320) { const int e = it - 128; mod_item(P, e / 96, e % 96, sm); }
        else tables_item(P, it - 320);
    }
    const int total = 2 * TILES_PER_LAYER; int start, cnt;
    if (G == 256) { if (b < 64) { start = b * 38; cnt = 38; } else if (b < 81) { start = 2432 + (b - 64) * 42; cnt = 42; } else { start = 2432 + 17 * 42 + (b - 81) * 43; cnt = 43; } }
    else { cnt = (total + G - 1) / G; start = b * cnt; }
    const int end = (start + cnt) < total ? (start + cnt) : total;
    const int tid = tid_opaque(), lr = tid >> 4, lc = (tid & 15) * 4;
    if (start < end) {
        int cur = start; TileJob J = tile_job(P, cur); f32x4 v[4];
#pragma unroll
        for (int i = 0; i < 4; ++i) v[i] = *(const f32x4*)(J.src + (size_t)(J.k0 + lr + 32 * i) * J.N + J.n0 + lc);
        for (;;) {
#pragma unroll
            for (int i = 0; i < 4; ++i)
#pragma unroll
                for (int j = 0; j < 4; ++j) sm[(lr + 32 * i) * 65 + lc + j] = v[i][j];
            __syncthreads();
            const TileJob C = J; const bool more = cur + 1 < end;
            if (more) { J = tile_job(P, cur + 1);
#pragma unroll
                for (int i = 0; i < 4; ++i) v[i] = *(const f32x4*)(J.src + (size_t)(J.k0 + lr + 32 * i) * J.N + J.n0 + lc); }
            const int n = tid >> 3, kg = tid & 7;
#pragma unroll
            for (int h = 0; h < 2; ++h) { float f[8];
#pragma unroll
                for (int j = 0; j < 8; ++j) f[j] = sm[(kg * 16 + h * 8 + j) * 65 + n];
                *(u32x4*)(C.dst + (size_t)(C.drow0 + n) * C.K + C.k0 + kg * 16 + h * 8) = pack8(f); }
            __syncthreads();
            if (!more) break;
            ++cur;
        }
    }
    { unsigned* cnt = (unsigned*)(P.ws + O_BAR) + MODCNT_WORD;
      if (tid == 0) { unsigned sp = 0u; while (__hip_atomic_load(cnt, __ATOMIC_RELAXED, __HIP_MEMORY_SCOPE_AGENT) < 96u) { __builtin_amdgcn_s_sleep(2); if (++sp > (1u << 22)) break; }
          __builtin_amdgcn_fence(__ATOMIC_ACQUIRE, "agent"); asm volatile("s_waitcnt vmcnt(0)" ::: "memory"); }
      __syncthreads(); }
    phase_prenorm0(P);
}

__device__ __forceinline__ void phase_prenorm0(PREF P) {
    const int tidx = tid_opaque(); const int lane = tidx & 63, gw = (tidx >> 6) * (int)gridDim.x + bid_opaque(), nw = gridDim.x * 8;
    const float* MOD = (const float*)(P.ws + LO_MOD); bf16_t* HB = (bf16_t*)(P.ws + O_HB);
    for (int row = gw; row < MTOT; row += nw) {
        const float* src = row < MX ? P.x + (size_t)row * DM : P.ctx + (size_t)(row - MX) * DM; const float* md = MOD + (row < MX ? (row >> 12) : 2) * 6144;
        f32x4 v[8]; float ss = 0.f;
#pragma unroll
        for (int i = 0; i < 8; ++i) { v[i] = *(const f32x4*)(src + (i * 64 + lane) * 4); ss += v[i][0] * v[i][0] + v[i][1] * v[i][1] + v[i][2] * v[i][2] + v[i][3] * v[i][3]; }
        ss = wave_sum(ss, lane); const float rinv = rsqrtf(ss * (1.0f / DM) + RMS_EPS);
#pragma unroll
        for (int i = 0; i < 8; ++i) { const int c = (i * 64 + lane) * 4; const f32x4 g = *(const f32x4*)(P.g_pre + c), sh = *(const f32x4*)(md + c), sc = *(const f32x4*)(md + 2048 + c); float h[4];
#pragma unroll
            for (int j = 0; j < 4; ++j) h[j] = v[i][j] * rinv * g[j] * (1.0f + sc[j]) + sh[j];
            u32x2 o; o[0] = cvt_pk_bf16(h[0], h[1]); o[1] = cvt_pk_bf16(h[2], h[3]); *(u32x2*)(HB + (size_t)row * DM + c) = o; }
    }
}
__device__ __forceinline__ void phase_postnorm(PREF P, int l) {
    const int tidx = tid_opaque(); const int lane = tidx & 63, gw = (tidx >> 6) * (int)gridDim.x + bid_opaque(), nw = gridDim.x * 8;
    const float* MOD = (const float*)(P.ws + l * SZ_LAYER + LO_MOD); const float* MOD1 = (const float*)(P.ws + SZ_LAYER + LO_MOD);
    bf16_t* HB = (bf16_t*)(P.ws + O_HB); const bf16_t* OB = (const bf16_t*)(P.ws + O_PARTS); float* X1 = (float*)(P.ws + O_X1);
    const int rows = l == 0 ? MTOT : MX;
    for (int row = gw; row < rows; row += nw) {
        const int mr = row < MX ? (row >> 12) : 2; const float* md = MOD + mr * 6144;
        const float* xo = l == 0 ? (row < MX ? P.x + (size_t)row * DM : P.ctx + (size_t)(row - MX) * DM) : X1 + (size_t)row * DM;
        const bf16_t* op = OB + (size_t)row * DM;
        f32x4 o[8], xv[8]; float ss = 0.f;
#pragma unroll
        for (int i = 0; i < 8; ++i) { const u32x2 ob = *(const u32x2*)(op + (i * 64 + lane) * 4); o[i] = (f32x4){lo_f(ob[0]), hi_f(ob[0]), lo_f(ob[1]), hi_f(ob[1])}; xv[i] = *(const f32x4*)(xo + (i * 64 + lane) * 4); ss += o[i][0] * o[i][0] + o[i][1] * o[i][1] + o[i][2] * o[i][2] + o[i][3] * o[i][3]; }
        ss = wave_sum(ss, lane); const float rinv = rsqrtf(ss * (1.0f / DM) + RMS_EPS); float s2 = 0.f;
#pragma unroll
        for (int i = 0; i < 8; ++i) { const int c = (i * 64 + lane) * 4; const f32x4 gp = *(const f32x4*)(P.g_post + l * DM + c), gt = *(const f32x4*)(md + 4096 + c);
#pragma unroll
            for (int j = 0; j < 4; ++j) { xv[i][j] = xv[i][j] + gt[j] * (o[i][j] * rinv * gp[j]); s2 += xv[i][j] * xv[i][j]; }
            if (l == 0) *(f32x4*)(X1 + (size_t)row * DM + c) = xv[i]; else *(f32x4*)(P.out + (size_t)row * DM + c) = xv[i]; }
        if (l == 0) { s2 = wave_sum(s2, lane); const float r2 = rsqrtf(s2 * (1.0f / DM) + RMS_EPS); const float* m1 = MOD1 + mr * 6144;
#pragma unroll
            for (int i = 0; i < 8; ++i) { const int c = (i * 64 + lane) * 4; const f32x4 g = *(const f32x4*)(P.g_pre + DM + c), sh = *(const f32x4*)(m1 + c), sc = *(const f32x4*)(m1 + 2048 + c); float h[4];
#pragma unroll
                for (int j = 0; j < 4; ++j) h[j] = xv[i][j] * r2 * g[j] * (1.0f + sc[j]) + sh[j];
                u32x2 ov; ov[0] = cvt_pk_bf16(h[0], h[1]); ov[1] = cvt_pk_bf16(h[2], h[3]); *(u32x2*)(HB + (size_t)row * DM + c) = ov; } }
    }
}


__device__ __forceinline__ void conv_rows(PREF P, const int l, const int bsub, const int nblk, const int tidx) {
    const bf16_t* parts = (const bf16_t*)(P.ws + O_PARTS); bf16_t* AB = (bf16_t*)(P.ws + O_AB);
    const int rows = l == 0 ? MTOT : MX; const float* cw = P.conv_w + (size_t)l * 3 * 1024;
    for (int ch = (tidx >> 6) * nblk + bsub; ch < (rows >> 2) * 2; ch += 8 * nblk) { const int idx = ch * 64 + (tidx & 63);
        const int r0 = (idx >> 7) * 4, c0 = (idx & 127) * 8; bool lv, rv;
        if (r0 < MX) { const int cp = r0 & 63; lv = cp > 0; rv = cp < 60; } else { const int t = (r0 - MX) & 255; lv = t > 0; rv = t < 252; }
        const bf16_t* pr = parts + E_PC + (size_t)r0 * 4096 + c0;
        u32x4 xr[6], cr[6], br[4], zr[4];
#pragma unroll
        for (int k = 0; k < 6; ++k) { const bool ok = (k == 0) ? lv : ((k == 5) ? rv : true);
            if (ok) { xr[k] = *(const u32x4*)(pr + (ptrdiff_t)(k - 1) * 4096 + C_XA); cr[k] = *(const u32x4*)(pr + (ptrdiff_t)(k - 1) * 4096 + C_CA); }
            else { xr[k] = (u32x4){0u, 0u, 0u, 0u}; cr[k] = (u32x4){0u, 0u, 0u, 0u}; } }
#pragma unroll
        for (int k = 0; k < 4; ++k) { br[k] = *(const u32x4*)(pr + (size_t)k * 4096 + C_BA); zr[k] = *(const u32x4*)(pr + (size_t)k * 4096 + C_ZA); }
        float w0[8], w1[8], w2[8];
#pragma unroll
        for (int j = 0; j < 8; ++j) { w0[j] = cw[c0 + j]; w1[j] = cw[1024 + c0 + j]; w2[j] = cw[2048 + c0 + j]; }
        float v[6][8];
#pragma unroll
        for (int k = 0; k < 6; ++k) { float xa[8], ca[8]; unpack8(xr[k], xa); unpack8(cr[k], ca);
#pragma unroll
            for (int j = 0; j < 8; ++j) v[k][j] = xa[j] * ca[j]; }
#pragma unroll
        for (int k = 0; k < 4; ++k) { float ba[8], za[8], o[8]; unpack8(br[k], ba); unpack8(zr[k], za);
#pragma unroll
            for (int j = 0; j < 8; ++j) { const float y = w0[j] * v[k][j] + w1[j] * v[k + 1][j] + w2[j] * v[k + 2][j]; o[j] = ba[j] * y * siluf_(za[j]); }
            *(u32x4*)(AB + (size_t)(r0 + k) * 1024 + c0) = pack8(o); }
    }
}

__device__ __forceinline__ void phase_mix1(PREF P, int l, unsigned char* shm) {
    const bf16_t* parts = (const bf16_t*)(P.ws + O_PARTS); unsigned char* wl = P.ws + l * SZ_LAYER;
    const int tidx = tid_opaque(), bidx = bid_opaque(); const int lane = tidx & 63, wv = tidx >> 6, r = lane & 15, q = lane >> 4;
    const int gw = bidx * 8 + wv, nw = gridDim.x * 8;
    for (int wi = bidx; wi < 256; wi += gridDim.x) ssm_stage_lds<256, false>(P, l, wi, shm, tidx);
    {
        bf16_t* ZB = (bf16_t*)(P.ws + O_ZB); const bf16_t* D1 = (const bf16_t*)(P.ws + O_TAB + T_D1); const float* TW = (const float*)(P.ws + O_TAB + T_TW);
        for (int it = gw; it < 2048; it += nw) {
            const int cg = it & 15, t2 = (it >> 4) & 63, b = it >> 10;
            f32x4 acc[8][4];
            lmul_g4<8>(D1, 64, 2, parts + E_PF + (size_t)(b * SEQ + t2) * 1024 + cg * 64 + r * 4, (size_t)64 * 1024, acc, lane);
#pragma unroll
            for (int a = 0; a < 4; ++a)
#pragma unroll
                for (int i = 0; i < 4; ++i) { const int k1 = a * 16 + q * 4 + i; const float twr = TW[(k1 * 64 + t2) * 2], twi = TW[(k1 * 64 + t2) * 2 + 1];
                    bf16_t* zr = ZB + ((size_t)((b * 64 + k1) * 128 + t2)) * 1024 + cg * 64 + r * 4; bf16_t* zi = zr + (size_t)64 * 1024; float vr[4], vi[4];
#pragma unroll
                    for (int nb = 0; nb < 4; ++nb) { const float re = acc[a][nb][i], im = acc[a + 4][nb][i]; vr[nb] = re * twr - im * twi; vi[nb] = re * twi + im * twr; }
                    u32x2 o; o[0] = cvt_pk_bf16(vr[0], vr[1]); o[1] = cvt_pk_bf16(vr[2], vr[3]); *(u32x2*)zr = o; o[0] = cvt_pk_bf16(vi[0], vi[1]); o[1] = cvt_pk_bf16(vi[2], vi[3]); *(u32x2*)zi = o; }
        }
    }
}


__device__ __forceinline__ void ctx_dft_item(PREF P, const int it, const int lane) {
    const int r = lane & 15, q = lane >> 4; const bf16_t* parts = (const bf16_t*)(P.ws + O_PARTS);
    bf16_t* YB = (bf16_t*)(P.ws + O_YB); const bf16_t* DC = (const bf16_t*)(P.ws + O_TAB + T_DCTX);
    const int cg = it & 15, mc = (it >> 4) & 3, b = it >> 6;
    f32x4 acc[8][4];
    lmul_g4<8>(DC + (size_t)mc * 128 * 256, 256, 8, parts + E_PF + (size_t)(MX + b * LCX) * 1024 + cg * 64 + r * 4, (size_t)1024, acc, lane);
#pragma unroll
    for (int a = 0; a < 8; ++a)
#pragma unroll
        for (int i = 0; i < 4; ++i) { const int mrow = mc * 128 + a * 16 + q * 4 + i, cs = mrow >> 8, k = mrow & 255;
            bf16_t* yp = YB + (size_t)(MX + b * LCX + k) * 2048 + cs * 1024 + cg * 64 + r * 4;
            u32x2 o; o[0] = cvt_pk_bf16(acc[a][0][i], acc[a][1][i]); o[1] = cvt_pk_bf16(acc[a][2][i], acc[a][3][i]); *(u32x2*)yp = o; }
}

__device__ __forceinline__ void phase_mix2(PREF P, int l) {
    unsigned char* wl = P.ws + l * SZ_LAYER;
    const int tidx = tid_opaque(), bidx = bid_opaque(); const int lane = tidx & 63, wv = tidx >> 6, r = lane & 15, q = lane >> 4;
    const int gw = bidx * 8 + wv, nw = gridDim.x * 8;
    if (wv == 0) {
        const float* EB = (const float*)(P.ws + O_EB); bf16_t* HS = (bf16_t*)(P.ws + O_HS); const float* A16 = (const float*)(wl + LO_A16);
        for (int it = bidx; it < 256; it += gridDim.x) {
            const int d = it & 1, g = (it >> 1) & 63, b = it >> 7, p = lane;
            const float ar = A16[((d * 64 + g) * 64 + p) * 2], ai = A16[((d * 64 + g) * 64 + p) * 2 + 1];
            float hr = 0.f, hi = 0.f;
#define SCAN_COL(j) ((j) < 16 ? 512 + b * 16 + (d ? 15 - (j) : (j)) : b * 256 + (d ? 255 - ((j) - 16) : ((j) - 16)))
#define SCAN_LOAD(er, ei, j0) _Pragma("unroll") for (int jj = 0; jj < 16; ++jj) { const int col = SCAN_COL((j0) + jj); const float* ep = EB + ((size_t)g * NCOL + col) * 256 + d * 128 + p; er[jj] = ep[0]; ei[jj] = ep[64]; }
#define SCAN_STEP(er, ei, j0) _Pragma("unroll") for (int jj = 0; jj < 16; ++jj) { const int col = SCAN_COL((j0) + jj); \
                bf16_t* hp = HS + ((size_t)g * NCOL + col) * 256 + d * 128 + p; const unsigned pk = cvt_pk_bf16(hr, hi); hp[0] = (bf16_t)(pk & 0xffffu); hp[64] = (bf16_t)(pk >> 16); \
                const float nr = ar * hr - ai * hi + er[jj], ni = ar * hi + ai * hr + ei[jj]; hr = nr; hi = ni; }
            float era[16], eia[16], erb[16], eib[16];
            SCAN_LOAD(era, eia, 0)
            for (int it2 = 0; it2 < 8; ++it2) {
                SCAN_LOAD(erb, eib, it2 * 32 + 16)
                SCAN_STEP(era, eia, it2 * 32)
                SCAN_LOAD(era, eia, it2 * 32 + 32)
                SCAN_STEP(erb, eib, it2 * 32 + 16)
            }
            SCAN_STEP(era, eia, 256)
#undef SCAN_COL
#undef SCAN_LOAD
#undef SCAN_STEP
        }
    }
    {
        const bf16_t* ZB = (const bf16_t*)(P.ws + O_ZB); bf16_t* YB = (bf16_t*)(P.ws + O_YB); const bf16_t* D2 = (const bf16_t*)(P.ws + O_TAB + T_D2);
        for (int it = gw; it < 2048; it += nw) {
            const int cg = it & 15, k1 = (it >> 4) & 63, b = it >> 10;
            f32x4 acc[8][4];
            lmul_g4<8>(D2, 128, 4, ZB + (size_t)(b * 64 + k1) * 128 * 1024 + cg * 64 + r * 4, (size_t)1024, acc, lane);
#pragma unroll
            for (int a = 0; a < 8; ++a)
#pragma unroll
                for (int i = 0; i < 4; ++i) { const int mrow = a * 16 + q * 4 + i, cs = mrow >> 6, k2 = mrow & 63;
                    bf16_t* yp = YB + (size_t)(b * SEQ + k1 + 64 * k2) * 2048 + cs * 1024 + cg * 64 + r * 4;
                    u32x2 o; o[0] = cvt_pk_bf16(acc[a][0][i], acc[a][1][i]); o[1] = cvt_pk_bf16(acc[a][2][i], acc[a][3][i]); *(u32x2*)yp = o; }
        }
    }
    if (l == 0 && wv >= 1) { for (int it = bidx * 7 + (wv - 1); it < 128; it += gridDim.x * 7) ctx_dft_item(P, it, lane); }
}

template <int ph>
__device__ __forceinline__ void run_phase(KPtr kp, unsigned char* shm) {
    asm volatile("" : "+s"(kp)); PREF P = *kp;
    LAS unsigned char* lds = (LAS unsigned char*)shm; const int G = gridDim.x, c = bid_opaque();
    if constexpr (ph == 0) { phase_prep(P, shm); return; }
    if constexpr (ph == 1) {
        phase_prenorm0(P);
        return;
    }
    constexpr int l = ph >= 2 ? ((ph - 2) >> 3) : 0, sp = ph >= 2 ? ((ph - 2) & 7) : 0; unsigned char* wl = P.ws + l * SZ_LAYER; constexpr int nM = 32, nh = l == 0 ? 4 : 0;
    const bf16_t* parts = (const bf16_t*)(P.ws + O_PARTS);
    switch (sp) {
    case 0: { EpiParts E{(bf16_t*)(P.ws + O_PARTS)};
        if (l == 0) { SchedGrid S{(const char*)(P.ws + O_HB), (const char*)(wl + LO_WIN), 32, 56, DM, DM, G, c, 4, MX, 1 << 20}; gemm_phase(lds, S, E, DM, DM, DM);
            { const int c3 = bid_opaque(); const int first = G > 224 ? 224 : 0; if (c3 >= first) { SchedWp SW{P.ws, G - first, c3 - first}; EpiWp EW{P.ws}; gemm_phase(lds, SW, EW, 256, 1024, 256); } } }
        else {
            {
                const int tq = tid_opaque(), lane = tq & 63, r = lane & 15, q = lane >> 4; const bf16_t* HB = (const bf16_t*)(P.ws + O_HB); const bf16_t* WT = (const bf16_t*)(wl + LO_WIN); bf16_t* po = (bf16_t*)(P.ws + O_PARTS);
                for (int it = c * 8 + (tq >> 6); it < 2048; it += G * 8) { const int tr = it >> 6, tc = it & 63;
                    const bf16_t* ap = HB + (size_t)(MX + tr * 16 + r) * DM + q * 8; const bf16_t* bp = WT + (size_t)(C_U + tc * 16 + r) * DM + q * 8; f32x4 a4 = (f32x4){0.f, 0.f, 0.f, 0.f};
#pragma unroll 8
                    for (int ks = 0; ks < 64; ++ks) a4 = __builtin_amdgcn_mfma_f32_16x16x32_bf16(*(const bf16x8*)(ap + ks * 32), *(const bf16x8*)(bp + ks * 32), a4, 0, 0, 0);
#pragma unroll
                    for (int i = 0; i < 4; ++i) po[E_PU + (size_t)(MX + tr * 16 + q * 4 + i) * 1024 + tc * 16 + r] = (bf16_t)(cvt_pk_bf16(a4[i], 0.f) & 0xffffu); }
            }
            SchedGrid S{(const char*)(P.ws + O_HB), (const char*)(wl + LO_WIN), 32, 56, DM, DM, G, c, 0, MX, 1 << 20}; gemm_phase(lds, S, E, DM, DM, DM); }
    } break;
    case 1: phase_mix1(P, l, shm); break;
    case 2: phase_mix2(P, l); break;
    case 3: { const int tq = tid_opaque(), c2 = bid_opaque();
        for (int wi = c2; wi < 256; wi += G) ssm_stage_lds<512, true>(P, l, wi, shm, tq);
        conv_rows(P, l, c2, G, tq);
    } break;
    case 4: {
        if (l == 0) { ctx_small_gemm<0>(P, shm); ctx_small_gemm<3>(P, shm); }
        const int nf = nM * 4;
        { const int c1 = bid_opaque(); SchedGrid S{(const char*)(P.ws + O_YB), (const char*)(wl + LO_WP), nM, 4, 2048, 2048, nf, c1, 0, MX, c1 < nf ? 1 : 0}; EpiFourier E{parts, (bf16_t*)(P.ws + O_CB)}; gemm_phase(lds, S, E, 2048, 2048, 2048); }
        { const int c2 = bid_opaque(); const int ng = nM * 8, two = 2 * (G - nf);
          int L0, dL, cn;
          if (G > nf && two <= ng) { if (c2 >= nf) { L0 = 2 * (c2 - nf); dL = 1; cn = 2; } else { L0 = two + c2; dL = nf; cn = (ng - two - c2 + nf - 1) / nf; if (cn < 0) cn = 0; } }
          else { L0 = c2; dL = G; cn = 1 << 20; }
          SchedGrid S{(const char*)(P.ws + O_GB), (const char*)(wl + LO_GLU), nM, 8, 1024, 1024, dL, L0, 0, MX, cn}; EpiGlu E{parts, (bf16_t*)(P.ws + O_BB)}; gemm_phase(lds, S, E, 1024, 1024, 1024); }
    } break;
    case 5: { if (l == 0) ctx_small_gemm<1>(P, shm);
        SchedMerge S{(const char*)(P.ws + O_AB), (const char*)(wl + LO_PA), nM, G, c, 0, MX};
        EpiMerge E{parts, (bf16_t*)(P.ws + O_HB)}; gemm_phase(lds, S, E, 1024, 1024, 1024); } break;
    case 6: { if (l == 0) ctx_small_gemm<2>(P, shm);
        SchedGrid S{(const char*)(P.ws + O_HB), (const char*)(wl + LO_WO), nM, 8, DM, DM, G, c, 0, MX, 1 << 20}; EpiStoreBf16 E{(bf16_t*)(P.ws + O_PARTS), DM}; gemm_phase(lds, S, E, DM, DM, DM); } break;
    default: phase_postnorm(P, l); break;
    }
}

#define XB_TMO      128
#define XB_XCNT(j)  (256  + 64 * (j))
#define XB_XSUB(j)  (1280 + 64 * (j))
#define XB_XGEN(j)  (2304 + 64 * (j))
#define XB_TOP      3328
#define XB_TOPGEN   3392
#define XCD_BAR_WORDS 3456
#define XB_SPIN_CAP (1u << 18)
__device__ __forceinline__ unsigned xb_ld(unsigned* p)              { return __hip_atomic_load(p, __ATOMIC_RELAXED, __HIP_MEMORY_SCOPE_AGENT); }
__device__ __forceinline__ unsigned xb_add(unsigned* p, unsigned v) { return __hip_atomic_fetch_add(p, v, __ATOMIC_RELAXED, __HIP_MEMORY_SCOPE_AGENT); }
__device__ __forceinline__ unsigned xb_xcc_id() { return (unsigned)__builtin_amdgcn_s_getreg((3 << 11) | 20) & 0xFu; }
#define XB_SPIN(cond, bar) do { unsigned _sp = 0; while (cond) { __builtin_amdgcn_s_sleep(1); \
    if ((++_sp & 255u) == 0u) { if (xb_ld(&(bar)[XB_TMO])) break; if (_sp > XB_SPIN_CAP) { atomicAdd(&(bar)[XB_TMO], 1u); break; } } } } while (0)
struct XcdBarrier { unsigned* bar; unsigned x; volatile LAS unsigned* st; };
__device__ __forceinline__ XcdBarrier xcd_barrier_post(unsigned* bar, volatile LAS unsigned* st) {
    XcdBarrier b; b.bar = bar; b.x = xb_xcc_id(); b.st = st;
    if (threadIdx.x == 0) (void)xb_add(&bar[XB_XCNT(b.x)], 1u);
    return b;
}
__device__ __forceinline__ void xcd_barrier_complete(unsigned* bar, unsigned x, unsigned& nloc, unsigned& nx) {
    const unsigned G = gridDim.x * gridDim.y * gridDim.z;
    unsigned sum, cnt, mine, sp = 0u;
    for (;;) {
        sum = 0u; cnt = 0u; mine = 0u;
#pragma unroll
        for (unsigned j = 0; j < 16; ++j) { const unsigned c = xb_ld(&bar[XB_XCNT(j)]); sum += c; cnt += (c > 0u) ? 1u : 0u; mine = (j == x) ? c : mine; }
        if (sum == G) break;
        __builtin_amdgcn_s_sleep(1);
        if ((++sp & 255u) == 0u) { if (xb_ld(&bar[XB_TMO])) break; if (sp > XB_SPIN_CAP) { atomicAdd(&bar[XB_TMO], 1u); break; } }
    }
    nloc = mine > 0u ? mine : 1u; nx = cnt > 0u ? cnt : 1u;
}
__device__ __forceinline__ void xcd_barrier(const XcdBarrier& b) {
    asm volatile("s_waitcnt vmcnt(0)" ::: "memory");
    __syncthreads();
    if (threadIdx.x == 0) {
        unsigned* bar = b.bar;
        __builtin_amdgcn_s_waitcnt(0);
        unsigned nloc = b.st[0], nx = b.st[1];
        if (nloc == 0u) { xcd_barrier_complete(bar, b.x, nloc, nx); b.st[0] = nloc; b.st[1] = nx; }
        const unsigned old = xb_add(&bar[XB_XSUB(b.x)], 1u);
        const unsigned gen = old / nloc;
        if (old + 1u == (gen + 1u) * nloc) {
            __builtin_amdgcn_fence(__ATOMIC_RELEASE, "agent");
            asm volatile("s_waitcnt vmcnt(0)" ::: "memory");
            const unsigned og = xb_add(&bar[XB_TOP], 1u);
            const unsigned tg = og / nx;
            if (og + 1u == (tg + 1u) * nx) xb_add(&bar[XB_TOPGEN], 1u);
            else XB_SPIN(xb_ld(&bar[XB_TOPGEN]) == tg, bar);
            __builtin_amdgcn_fence(__ATOMIC_ACQUIRE, "agent");
            xb_add(&bar[XB_XGEN(b.x)], 1u);
            asm volatile("s_waitcnt vmcnt(0)" ::: "memory");
        } else {
            XB_SPIN(xb_ld(&bar[XB_XGEN(b.x)]) == gen, bar);
            __builtin_amdgcn_fence(__ATOMIC_ACQUIRE, "agent");
            asm volatile("s_waitcnt vmcnt(0)" ::: "memory");
        }
    }
    __syncthreads();
}

constexpr int N_PHASES = 18;

__global__ void __launch_bounds__(512, 2) mega(Params P, int ph0, int ph1) {
    extern __shared__ __attribute__((aligned(16))) unsigned char shm[];
    __shared__ uint4 xb_words;
    if (threadIdx.x == 0) xb_words = make_uint4(0u, 0u, 0u, 0u);
    __syncthreads();
    const XcdBarrier xb = xcd_barrier_post((unsigned*)(P.ws + O_BAR), (volatile LAS unsigned*)&xb_words);
    const KPtr kp = (KPtr)__builtin_amdgcn_kernarg_segment_ptr();
#define RUN_PH(k) if (ph0 <= (k) && (k) < ph1) { if ((k) != ph0) xcd_barrier(xb); run_phase<(k)>(kp, shm); }
    RUN_PH(0) RUN_PH(2) RUN_PH(3) RUN_PH(4) RUN_PH(5) RUN_PH(6) RUN_PH(7) RUN_PH(8) RUN_PH(9)
    RUN_PH(10) RUN_PH(11) RUN_PH(12) RUN_PH(13) RUN_PH(14) RUN_PH(15) RUN_PH(16) RUN_PH(17)
#undef RUN_PH
}

extern "C" void kernel_launch(void* const* d_in, const int* in_sizes, int n_in, void* d_out, int out_size, void* d_ws, size_t ws_size, hipStream_t stream) {
    static int grid_blocks = 0;
    if (!grid_blocks) {
        int dev = 0, cus = 0, per_cu = 0;
        hipGetDevice(&dev); hipDeviceGetAttribute(&cus, hipDeviceAttributeMultiprocessorCount, dev);
        hipFuncSetAttribute((const void*)mega, hipFuncAttributeMaxDynamicSharedMemorySize, STAGE_BYTES);
        hipOccupancyMaxActiveBlocksPerMultiprocessor(&per_cu, (const void*)mega, 512, STAGE_BYTES);
        if (per_cu < 1) { fprintf(stderr, "occupancy query says %d blocks/CU\n", per_cu); per_cu = 1; }
        grid_blocks = cus;
        if (ws_size < WS_END) { fprintf(stderr, "workspace too small: %zu < %zu\n", ws_size, (size_t)WS_END); grid_blocks = -1; }
    }
    if (grid_blocks < 0) return;
    if (hipMemsetAsync((char*)d_ws + O_BAR, 0, SZ_BAR, stream) != hipSuccess) { fprintf(stderr, "memset of barrier words failed\n"); return; }
    Params p{};
    const float** pp = (const float**)&p;
    for (int i = 0; i < 25; ++i) pp[i] = (const float*)d_in[i];
    p.out = (float*)d_out; p.ws = (unsigned char*)d_ws;
    int ph0 = 0, ph1 = N_PHASES;
    void* args[] = {&p, &ph0, &ph1};
    hipError_t e = hipLaunchCooperativeKernel((const void*)mega, dim3(grid_blocks), dim3(512), args, STAGE_BYTES, stream);
    if (e != hipSuccess) fprintf(stderr, "cooperative launch failed: %s (grid %d)\n", hipGetErrorString(e), grid_blocks);
}
```

```cpp
#include <hip/hip_runtime.h>
#include <hip/hip_cooperative_groups.h>
#include <cstdio>
namespace cg = cooperative_groups;

#define LAS __attribute__((address_space(3)))
typedef unsigned short bf16_t;
typedef short bf16x8 __attribute__((ext_vector_type(8)));
typedef float f32x4 __attribute__((ext_vector_type(4)));
typedef unsigned u32x4 __attribute__((ext_vector_type(4)));
typedef unsigned u32x2 __attribute__((ext_vector_type(2)));

constexpr int DM = 2048, NB = 2, SEQ = 4096, LCX = 256, MX = NB * SEQ, MCT = NB * LCX, MTOT = MX + MCT;
constexpr int INW = 14336;
constexpr int C_XA = 0, C_BA = 1024, C_CA = 2048, C_ZA = 3072, C_U = 4096, C_ZB = 5120, C_F = 6144, C_ZC = 7168, C_GL = 8192;
constexpr size_t E_PC = 0, E_PU = (size_t)8704 * 4096, E_PZB = E_PU + (size_t)8704 * 1024, E_PF = E_PZB + (size_t)8704 * 1024, E_PZC = E_PF + (size_t)8704 * 1024, E_PGL = E_PZC + (size_t)8704 * 1024;
constexpr int NCOL = 544;
constexpr float RMS_EPS = 1e-6f;

constexpr size_t AL(size_t x) { return (x + 255) & ~(size_t)255; }
constexpr size_t SZ_WIN = (size_t)INW * DM * 2, SZ_P = (size_t)DM * 1024 * 2, SZ_GLU = (size_t)2048 * 1024 * 2, SZ_FW = (size_t)1024 * 1024 * 2,
                 SZ_WP = (size_t)1024 * 2048 * 2, SZ_WO = (size_t)DM * DM * 2, SZ_M1 = (size_t)64 * 256 * 256 * 2, SZ_M2 = (size_t)64 * 256 * 512 * 2,
                 SZ_A16 = (size_t)2 * 64 * 64 * 2 * 4, SZ_MOD = (size_t)3 * 6144 * 4;
constexpr size_t LO_WIN = 0, LO_PA = LO_WIN + SZ_WIN, LO_PB = LO_PA + SZ_P, LO_PC = LO_PB + SZ_P, LO_GLU = LO_PC + SZ_P, LO_FW = LO_GLU + SZ_GLU,
                 LO_WP = LO_FW + SZ_FW, LO_WO = LO_WP + SZ_WP, LO_M1 = LO_WO + SZ_WO, LO_M2 = LO_M1 + SZ_M1, LO_A16 = LO_M2 + SZ_M2, LO_MOD = LO_A16 + SZ_A16,
                 SZ_LAYER = AL(LO_MOD + SZ_MOD);
constexpr size_t O_TAB = 2 * SZ_LAYER;
constexpr size_t T_CS = 0, T_D1 = T_CS + 512 * 256 * 2, T_D2 = T_D1 + 128 * 64 * 2, T_DCTX = T_D2 + 128 * 128 * 2, T_TW = T_DCTX + 512 * 256 * 2, SZ_TAB = AL(T_TW + 64 * 64 * 8);
constexpr size_t O_X1 = O_TAB + SZ_TAB, SZ_X1 = (size_t)MTOT * DM * 4;
constexpr size_t O_HB = O_X1 + SZ_X1, SZ_HB = (size_t)MTOT * DM * 2;
constexpr size_t O_PARTS = O_HB + SZ_HB, SZ_PARTS = (size_t)MTOT * INW * 2;
constexpr size_t O_AB = O_PARTS + SZ_PARTS, SZ_BR = (size_t)MTOT * 1024 * 2;
constexpr size_t O_BB = O_AB + SZ_BR, O_CB = O_BB + SZ_BR, O_GB = O_CB + SZ_BR;
constexpr size_t O_ZB = O_GB + SZ_BR, SZ_ZB = (size_t)2 * 64 * 128 * 1024 * 2;
constexpr size_t O_YB = O_ZB + SZ_ZB, SZ_YB = (size_t)MTOT * 2048 * 2;
constexpr size_t O_EB = O_YB + SZ_YB, SZ_EB = (size_t)64 * NCOL * 256 * 4;
constexpr size_t O_HS = O_EB + SZ_EB, SZ_HS = (size_t)64 * NCOL * 256 * 2;
constexpr size_t O_MP = O_ZB;
constexpr size_t O_BAR = O_HS + SZ_HS, SZ_BAR = 16384;
constexpr size_t WS_END = O_BAR + SZ_BAR;
static_assert(SZ_ZB + SZ_YB + SZ_EB >= (size_t)MTOT * DM * 4, "alias");
static_assert(SZ_PARTS >= (size_t)MTOT * DM * 4, "alias");

struct Params {
    const float *x, *c, *ctx, *c_ctx, *w_ada, *b_ada, *g_pre, *g_post, *w_in, *conv_w, *lam_re, *lam_im, *log_dt, *b_re, *b_im, *c_re, *c_im,
        *ssm_d, *glu_wa, *glu_wb, *fourier_w, *proj_a, *proj_b, *proj_c, *w_out;
    float* out; unsigned char* ws;
};
typedef const __attribute__((address_space(4))) Params* KPtr;
#define PREF const __attribute__((address_space(4))) Params&

__device__ __forceinline__ int tid_opaque() { int t = threadIdx.x; asm volatile("" : "+v"(t)); return t; }
__device__ __forceinline__ int bid_opaque() { int b = blockIdx.x; asm volatile("" : "+s"(b)); return b; }
__device__ __forceinline__ float bf2f(unsigned v) { return __uint_as_float(v << 16); }
__device__ __forceinline__ unsigned cvt_pk_bf16(float lo, float hi) { unsigned r; asm volatile("v_cvt_pk_bf16_f32 %0, %1, %2" : "=v"(r) : "v"(lo), "v"(hi)); return r; }
__device__ __forceinline__ float lo_f(unsigned u) { return __uint_as_float(u << 16); }
__device__ __forceinline__ float hi_f(unsigned u) { return __uint_as_float(u & 0xffff0000u); }
__device__ __forceinline__ float sigmoidf_(float x) { return __builtin_amdgcn_rcpf(1.0f + __expf(-x)); }
__device__ __forceinline__ float siluf_(float x) { return x * __builtin_amdgcn_rcpf(1.0f + __expf(-x)); }
__device__ __forceinline__ float gelu_tanh(float x) { const float z = 0.7978845608028654f * (x + 0.044715f * x * x * x); const float t = 1.0f - 2.0f * __builtin_amdgcn_rcpf(__expf(2.0f * z) + 1.0f); return 0.5f * x * (1.0f + t); }
__device__ __forceinline__ float wave_sum(float v, const int lane) {
#pragma unroll
    for (int o = 32; o; o >>= 1) v += __int_as_float(__builtin_amdgcn_ds_bpermute((lane ^ o) << 2, __float_as_int(v)));
    return v;
}
__device__ __forceinline__ void unpack8(const u32x4 u, float (&f)[8]) {
    f[0] = lo_f(u[0]); f[1] = hi_f(u[0]); f[2] = lo_f(u[1]); f[3] = hi_f(u[1]); f[4] = lo_f(u[2]); f[5] = hi_f(u[2]); f[6] = lo_f(u[3]); f[7] = hi_f(u[3]);
}
__device__ __forceinline__ u32x4 pack8(const float (&f)[8]) { u32x4 r; r[0] = cvt_pk_bf16(f[0], f[1]); r[1] = cvt_pk_bf16(f[2], f[3]); r[2] = cvt_pk_bf16(f[4], f[5]); r[3] = cvt_pk_bf16(f[6], f[7]); return r; }

constexpr int BM = 256, BK = 64, HALF = 128, HTB = HALF * BK * 2, STAGE_BYTES = 8 * HTB;
__device__ __forceinline__ int lds_byte(int r, int c) { const int st = (r >> 4) * 2 + (c >> 5), rr = r & 15, cc = c & 31, ob = rr * 64 + cc * 2; return st * 1024 + (ob ^ (((ob >> 9) & 1) << 5)); }
__device__ __forceinline__ void stage_rc(int b, int& R, int& C) { const int st = b / 1024, sb = b % 1024, swz = sb ^ (((sb >> 9) & 1) << 5); R = (st >> 1) * 16 + swz / 64; C = (st & 1) * 32 + (swz % 64) / 2; }
__device__ __forceinline__ int perm32(int rho) { const int n = rho >> 4, i = rho & 15; return 8 * (i >> 2) + 4 * n + (i & 3); }

struct Unit { const char* A; const char* B; int row0, pn, z, half; };

__device__ __forceinline__ void tile_of(int L, int nM, int nN, int& pm, int& pn) {
    const int nwg = nM * nN; int wgid = L;
    { const int q = nwg / 8, r = nwg % 8, xcd = wgid % 8, off = wgid / 8; wgid = (xcd < r ? xcd * (q + 1) : r * (q + 1) + (xcd - r) * q) + off; }
    const int nig = 8 * nN, gid = wgid / nig, fm = gid * 8, gsz = (nM - fm) < 8 ? (nM - fm) : 8;
    pm = fm + ((wgid % nig) % gsz); pn = (wgid % nig) / gsz;
}

template <class Sched, class Epi>
__device__ __forceinline__ void gemm_phase(LAS unsigned char* lds, const Sched& S, const Epi& E, const int K, const int lda, const int ldb) {
    const int tid = tid_opaque(), wid = __builtin_amdgcn_readfirstlane(tid >> 6), lane = tid & 63, wr = wid >> 2, wc = wid & 3, fr = lane & 15, fq = lane >> 4;
    const int nt = K / BK;
    unsigned voffA[2], voffB[2];
#pragma unroll
    for (int i = 0; i < 2; ++i) { int R, C; stage_rc(tid * 16 + i * 8192, R, C); const int Rb = (R & ~31) + perm32(R & 31);
        voffA[i] = (unsigned)(R * lda + C) * 2u; voffB[i] = (unsigned)(Rb * ldb + C) * 2u; }
    const size_t kstep = (size_t)(BK * 2);
    const size_t hstepA = (size_t)HALF * lda * 2, hstepB = (size_t)HALF * ldb * 2;
    const unsigned ldsw = (unsigned)wid * 1024u;
    const int aoff = lds_byte(wr * 64 + fr, fq * 8), boff = lds_byte(wc * 32 + fr, fq * 8);
#define PG8_SA(b, h) (((b) * 2 + (h)) * HTB)
#define PG8_SB(b, h) ((4 + (b) * 2 + (h)) * HTB)
#define PG8_STAGE(bufoff, gbase, voff) do { _Pragma("unroll") for (int _i = 0; _i < 2; ++_i) \
        __builtin_amdgcn_global_load_lds((const unsigned*)((const char*)(gbase) + (voff)[_i]), (LAS unsigned*)(lds + (bufoff) + ldsw + _i * 8192), 16, 0, 0); } while (0)
#define PG8_LDA(dst, b, h) do { _Pragma("unroll") for (int m = 0; m < 4; ++m) _Pragma("unroll") for (int k = 0; k < 2; ++k) dst[m][k] = *(const LAS bf16x8*)(lds + PG8_SA(b, h) + aoff + m * 2048 + k * 1024); } while (0)
#define PG8_LDB(dst, b, h) do { _Pragma("unroll") for (int n = 0; n < 2; ++n) _Pragma("unroll") for (int k = 0; k < 2; ++k) dst[n][k] = *(const LAS bf16x8*)(lds + PG8_SB(b, h) + boff + n * 2048 + k * 1024); } while (0)
#define PG8_MMA(ai, bj, At, Bt) do { __builtin_amdgcn_s_setprio(1); _Pragma("unroll") for (int m = 0; m < 4; ++m) _Pragma("unroll") for (int n = 0; n < 2; ++n) _Pragma("unroll") for (int k = 0; k < 2; ++k) \
        acc[ai][bj][m][n] = __builtin_amdgcn_mfma_f32_16x16x32_bf16(Bt[n][k], At[m][k], acc[ai][bj][m][n], 0, 0, 0); __builtin_amdgcn_s_setprio(0); } while (0)
#define PG8_WAIT_V(n) asm volatile("s_waitcnt vmcnt(" #n ")" ::: "memory")
#define PG8_WAIT_L(n) asm volatile("s_waitcnt lgkmcnt(" #n ")" ::: "memory")
#define PG8_BAR __builtin_amdgcn_s_barrier()
#define PG8_SCHED __builtin_amdgcn_sched_barrier(0)
    Unit cur, nxt; int ui = 0;
    if (!S.next(0, cur)) return;
    f32x4 acc[2][2][4][2];
#pragma unroll
    for (int a = 0; a < 2; ++a)
#pragma unroll
        for (int b = 0; b < 2; ++b)
#pragma unroll
            for (int m = 0; m < 4; ++m)
#pragma unroll
                for (int n = 0; n < 2; ++n) acc[a][b][m][n] = (f32x4){0.f, 0.f, 0.f, 0.f};
    bf16x8 At[4][2], B0[2][2], B1[2][2];
    const char* cA = cur.A; const char* cB = cur.B;
    PG8_STAGE(PG8_SB(0, 0), cB, voffB); PG8_STAGE(PG8_SA(0, 0), cA, voffA); PG8_STAGE(PG8_SB(0, 1), cB + hstepB, voffB); PG8_STAGE(PG8_SA(0, 1), cA + hstepA, voffA);
    if (wr == 1) PG8_BAR;
    PG8_WAIT_V(4); PG8_BAR;
    PG8_STAGE(PG8_SB(1, 0), cB + kstep, voffB); PG8_STAGE(PG8_SA(1, 0), cA + kstep, voffA); PG8_STAGE(PG8_SB(1, 1), cB + hstepB + kstep, voffB);
    PG8_WAIT_V(6); PG8_BAR;
    for (;;) {
        const bool has_next = S.next(ui + 1, nxt);
        const char* nA = has_next ? nxt.A : cA; const char* nB = has_next ? nxt.B : cB;
        const bool chalf = cur.half != 0;
        for (int t = 0; t < nt; t += 2) {
            const bool last = (t == nt - 2);
            const char* a1 = cA + (size_t)(t + 1) * kstep;
            const char* a2 = last ? nA : cA + (size_t)(t + 2) * kstep; const char* b2 = last ? nB : cB + (size_t)(t + 2) * kstep;
            const char* a3 = a2 + kstep; const char* b3 = b2 + kstep;
            PG8_LDB(B0, 0, 0); PG8_SCHED; PG8_LDA(At, 0, 0); PG8_STAGE(PG8_SA(1, 1), a1 + hstepA, voffA);
            PG8_WAIT_L(8); PG8_BAR; PG8_WAIT_L(0); PG8_MMA(0, 0, At, B0); PG8_BAR; PG8_SCHED;
            PG8_LDB(B1, 0, 1); PG8_STAGE(PG8_SB(0, 0), b2, voffB);
            PG8_BAR; PG8_WAIT_L(0); PG8_MMA(0, 1, At, B1); PG8_BAR;
            PG8_LDA(At, 0, 1); PG8_STAGE(PG8_SA(0, 0), a2, voffA);
            PG8_BAR; PG8_WAIT_L(0); if (!chalf) PG8_MMA(1, 0, At, B0); PG8_BAR; PG8_SCHED;
            PG8_STAGE(PG8_SB(0, 1), b2 + hstepB, voffB);
            PG8_WAIT_V(6); PG8_BAR; if (!chalf) PG8_MMA(1, 1, At, B1); PG8_BAR;
            PG8_LDB(B0, 1, 0); PG8_SCHED; PG8_LDA(At, 1, 0); PG8_STAGE(PG8_SA(0, 1), a2 + hstepA, voffA);
            PG8_WAIT_L(8); PG8_BAR; PG8_WAIT_L(0); PG8_MMA(0, 0, At, B0); PG8_BAR; PG8_SCHED;
            PG8_LDB(B1, 1, 1); PG8_STAGE(PG8_SB(1, 0), b3, voffB);
            PG8_BAR; PG8_WAIT_L(0); PG8_MMA(0, 1, At, B1); PG8_BAR;
            PG8_LDA(At, 1, 1); PG8_STAGE(PG8_SA(1, 0), a3, voffA);
            PG8_BAR; PG8_WAIT_L(0); if (!chalf) PG8_MMA(1, 0, At, B0); PG8_BAR; PG8_SCHED;
            PG8_STAGE(PG8_SB(1, 1), b3 + hstepB, voffB);
            PG8_WAIT_V(6); PG8_BAR; if (!chalf) PG8_MMA(1, 1, At, B1); PG8_BAR;
        }
        E(acc, cur, wr, wc, fr, fq);
        if (!has_next) break;
#pragma unroll
        for (int a = 0; a < 2; ++a)
#pragma unroll
            for (int b = 0; b < 2; ++b)
#pragma unroll
                for (int m = 0; m < 4; ++m)
#pragma unroll
                    for (int n = 0; n < 2; ++n) acc[a][b][m][n] = (f32x4){0.f, 0.f, 0.f, 0.f};
        cur = nxt; cA = nA; cB = nB; ++ui;
    }
    PG8_WAIT_V(0);
    if (wr == 0) PG8_BAR;
    PG8_BAR;
#undef PG8_SA
#undef PG8_SB
#undef PG8_STAGE
#undef PG8_LDA
#undef PG8_LDB
#undef PG8_MMA
#undef PG8_WAIT_V
#undef PG8_WAIT_L
#undef PG8_BAR
#undef PG8_SCHED
}

typedef f32x4 AccT[2][2][4][2];
#define EPI_ARGS const AccT& acc, const Unit& u, int wr, int wc, int fr, int fq
#define EPI_FOR_ROWS _Pragma("unroll") for (int ai = 0; ai < 2; ++ai) if (ai == 0 || !u.half) _Pragma("unroll") for (int m = 0; m < 4; ++m)
#define EPI_ROW (u.row0 + wr * 64 + fr + ai * 128 + m * 16)
#define EPI_COL(bj) (u.pn * 256 + wc * 32 + 8 * fq + (bj) * 128)

struct SchedGrid {
    const char* A; const char* B; int nM, nN, lda, ldb, G, c, nh, hrow0, cnt;
    __device__ __forceinline__ bool next(int i, Unit& u) const {
        const long L = (long)i * G + c; const int nfull = nM * nN; if (i >= cnt || L >= (long)nfull + nh * nN) return false;
        int pm;
        if (L < nfull) { tile_of((int)L, nM, nN, pm, u.pn); u.row0 = pm * 256; u.half = 0; }
        else { const int e = (int)L - nfull; u.pn = e % nN; u.row0 = hrow0 + (e / nN) * 128; u.half = 1; }
        u.z = 0; u.A = A + (size_t)u.row0 * lda * 2; u.B = B + (size_t)u.pn * 256 * ldb * 2; return true;
    }
};
struct SchedMerge {
    const char* A0; const char* B0; int nM, G, c, nh, hrow0;
    __device__ __forceinline__ bool next(int i, Unit& u) const {
        const int j = i / 3, br = i - 3 * j; const long L = (long)j * G + c; const int nfull = nM * 8; if (L >= (long)nfull + nh * 8) return false;
        int pm;
        if (L < nfull) { tile_of((int)L, nM, 8, pm, u.pn); u.row0 = pm * 256; u.half = 0; }
        else { const int e = (int)L - nfull; u.pn = e & 7; u.row0 = hrow0 + (e >> 3) * 128; u.half = 1; }
        u.z = br;
        u.A = A0 + (size_t)br * SZ_BR + (size_t)u.row0 * 1024 * 2; u.B = B0 + (size_t)br * SZ_P + (size_t)u.pn * 256 * 1024 * 2; return true;
    }
};
struct SchedWp {
    const unsigned char* ws; int G, c;
    __device__ __forceinline__ bool next(int i, Unit& u) const {
        const long L = (long)i * G + c; if (L >= 64) return false;
        const int l = (int)L >> 5, grp = ((int)L >> 3) & 3, pm = ((int)L >> 1) & 3; u.row0 = pm * 256; u.half = 0; u.pn = (int)L & 1; u.z = l * 4 + grp;
        u.A = (const char*)ws + l * SZ_LAYER + LO_FW + ((size_t)pm * 256 * 1024 + grp * 256) * 2;
        u.B = (const char*)ws + O_TAB + T_CS + (size_t)u.pn * 256 * 256 * 2; return true;
    }
};

struct EpiStoreBf16 { bf16_t* O; int ldc;
    __device__ __forceinline__ void operator()(EPI_ARGS) const {
        EPI_FOR_ROWS { bf16_t* rp = O + (size_t)EPI_ROW * ldc;
#pragma unroll
            for (int bj = 0; bj < 2; ++bj) { const f32x4 v0 = acc[ai][bj][m][0], v1 = acc[ai][bj][m][1]; u32x4 o;
                o[0] = cvt_pk_bf16(v0[0], v0[1]); o[1] = cvt_pk_bf16(v0[2], v0[3]); o[2] = cvt_pk_bf16(v1[0], v1[1]); o[3] = cvt_pk_bf16(v1[2], v1[3]);
                *(u32x4*)(rp + EPI_COL(bj)) = o; } }
    }
};
struct EpiParts { bf16_t* O;
    __device__ __forceinline__ void operator()(EPI_ARGS) const {
        const int c0 = u.pn * 256; size_t eb; int pitch, cl;
        if (c0 < C_U) { eb = E_PC; pitch = 4096; cl = c0; } else if (c0 < C_ZB) { eb = E_PU; pitch = 1024; cl = c0 - C_U; } else if (c0 < C_F) { eb = E_PZB; pitch = 1024; cl = c0 - C_ZB; }
        else if (c0 < C_ZC) { eb = E_PF; pitch = 1024; cl = c0 - C_F; } else if (c0 < C_GL) { eb = E_PZC; pitch = 1024; cl = c0 - C_ZC; } else { eb = E_PGL; pitch = 6144; cl = c0 - C_GL; }
        bf16_t* base = O + eb + cl + wc * 32 + 8 * fq;
        EPI_FOR_ROWS { bf16_t* rp = base + (size_t)EPI_ROW * pitch;
#pragma unroll
            for (int bj = 0; bj < 2; ++bj) { const f32x4 v0 = acc[ai][bj][m][0], v1 = acc[ai][bj][m][1]; u32x4 o;
                o[0] = cvt_pk_bf16(v0[0], v0[1]); o[1] = cvt_pk_bf16(v0[2], v0[3]); o[2] = cvt_pk_bf16(v1[0], v1[1]); o[3] = cvt_pk_bf16(v1[2], v1[3]);
                *(u32x4*)(rp + bj * 128) = o; } }
    }
};
struct EpiStoreF32 { float* O; int ldc;
    __device__ __forceinline__ void operator()(EPI_ARGS) const {
        EPI_FOR_ROWS { float* rp = O + (size_t)EPI_ROW * ldc;
#pragma unroll
            for (int bj = 0; bj < 2; ++bj) { *(f32x4*)(rp + EPI_COL(bj)) = acc[ai][bj][m][0]; *(f32x4*)(rp + EPI_COL(bj) + 4) = acc[ai][bj][m][1]; } }
    }
};
struct EpiWp { unsigned char* ws;
    __device__ __forceinline__ void operator()(EPI_ARGS) const {
        const int l = u.z >> 2, grp = u.z & 3; bf16_t* O = (bf16_t*)(ws + l * SZ_LAYER + LO_WP);
        EPI_FOR_ROWS { bf16_t* rp = O + (size_t)EPI_ROW * 2048 + u.pn * 1024 + grp * 256;
#pragma unroll
            for (int bj = 0; bj < 2; ++bj) { const f32x4 v0 = acc[ai][bj][m][0], v1 = acc[ai][bj][m][1]; u32x4 o;
                o[0] = cvt_pk_bf16(v0[0], v0[1]); o[1] = cvt_pk_bf16(v0[2], v0[3]); o[2] = cvt_pk_bf16(v1[0], v1[1]); o[3] = cvt_pk_bf16(v1[2], v1[3]);
                *(u32x4*)(rp + wc * 32 + 8 * fq + bj * 128) = o; } }
    }
};
struct EpiFourier { const bf16_t* parts; bf16_t* O;
    __device__ __forceinline__ void operator()(EPI_ARGS) const {
#pragma unroll
        for (int ai = 0; ai < 2; ++ai) if (ai == 0 || !u.half) { u32x4 zz[4][2];
#pragma unroll
            for (int m = 0; m < 4; ++m)
#pragma unroll
                for (int bj = 0; bj < 2; ++bj) zz[m][bj] = *(const u32x4*)(parts + E_PZC + (size_t)EPI_ROW * 1024 + EPI_COL(bj));
#pragma unroll
            for (int m = 0; m < 4; ++m)
#pragma unroll
                for (int bj = 0; bj < 2; ++bj) { const f32x4 v0 = acc[ai][bj][m][0], v1 = acc[ai][bj][m][1]; float z[8]; unpack8(zz[m][bj], z); float o[8];
#pragma unroll
                    for (int j = 0; j < 4; ++j) { o[j] = v0[j] * siluf_(z[j]); o[4 + j] = v1[j] * siluf_(z[4 + j]); }
                    *(u32x4*)(O + (size_t)EPI_ROW * 1024 + EPI_COL(bj)) = pack8(o); } }
    }
};
struct EpiGlu { const bf16_t* parts; bf16_t* O;
    __device__ __forceinline__ void operator()(EPI_ARGS) const {
        const int col = u.pn * 128 + wc * 32 + 8 * fq;
#pragma unroll
        for (int ai = 0; ai < 2; ++ai) if (ai == 0 || !u.half) { u32x4 zz[4];
#pragma unroll
            for (int m = 0; m < 4; ++m) zz[m] = *(const u32x4*)(parts + E_PZB + (size_t)EPI_ROW * 1024 + col);
#pragma unroll
            for (int m = 0; m < 4; ++m) { float z[8]; unpack8(zz[m], z);
                const f32x4 a0 = acc[ai][0][m][0], a1 = acc[ai][0][m][1], b0 = acc[ai][1][m][0], b1 = acc[ai][1][m][1]; float o[8];
#pragma unroll
                for (int j = 0; j < 4; ++j) { o[j] = a0[j] * z[j] * __builtin_amdgcn_rcpf((1.0f + __expf(-b0[j])) * (1.0f + __expf(-z[j]))); o[4 + j] = a1[j] * z[4 + j] * __builtin_amdgcn_rcpf((1.0f + __expf(-b1[j])) * (1.0f + __expf(-z[4 + j]))); }
                *(u32x4*)(O + (size_t)EPI_ROW * 1024 + col) = pack8(o); } }
    }
};
struct EpiMerge { const bf16_t* parts; bf16_t* MB;
    __device__ __forceinline__ void operator()(EPI_ARGS) const {
        const int br = u.z; const int nb = u.half ? 2 : 4;
        u32x4 gg[2][4], pp[2][4];
#define MRG_LOAD(slot, bidx_) { const int ai = (bidx_) >> 1, bj = (bidx_) & 1; _Pragma("unroll") for (int m = 0; m < 4; ++m) { \
            gg[slot][m] = *(const u32x4*)(parts + E_PGL + (size_t)EPI_ROW * 6144 + br * DM + EPI_COL(bj)); \
            pp[slot][m] = br > 0 ? *(const u32x4*)(MB + (size_t)EPI_ROW * DM + EPI_COL(bj)) : (u32x4){0u, 0u, 0u, 0u}; } }
#define MRG_EMIT(slot, bidx_) { const int ai = (bidx_) >> 1, bj = (bidx_) & 1; _Pragma("unroll") for (int m = 0; m < 4; ++m) { \
            const f32x4 v0 = acc[ai][bj][m][0], v1 = acc[ai][bj][m][1]; float g[8], pv[8], o[8]; unpack8(gg[slot][m], g); unpack8(pp[slot][m], pv); \
            _Pragma("unroll") for (int j = 0; j < 4; ++j) { o[j] = v0[j] * sigmoidf_(g[j]) + pv[j]; o[4 + j] = v1[j] * sigmoidf_(g[4 + j]) + pv[4 + j]; } \
            *(u32x4*)(MB + (size_t)EPI_ROW * DM + EPI_COL(bj)) = pack8(o); } }
        MRG_LOAD(0, 0)
        MRG_LOAD(1, 1)
        MRG_EMIT(0, 0)
        if (nb > 2) MRG_LOAD(0, 2)
        MRG_EMIT(1, 1)
        if (nb > 2) { MRG_LOAD(1, 3) MRG_EMIT(0, 2) MRG_EMIT(1, 3) }
#undef MRG_LOAD
#undef MRG_EMIT
    }
};

template <int MTL, int NT, class BL>
__device__ __forceinline__ void lmul_core(const bf16_t* __restrict__ D, const int ldd, const int ksteps, const BL& bl, f32x4 (&acc)[MTL][NT], const int lane) {
    const int r = lane & 15, q = lane >> 4;
    const bf16_t* dp = D + (size_t)r * ldd + q * 8;
#pragma unroll
    for (int a = 0; a < MTL; ++a)
#pragma unroll
        for (int b = 0; b < NT; ++b) acc[a][b] = (f32x4){0.f, 0.f, 0.f, 0.f};
#pragma unroll 1
    for (int ks = 0; ks < ksteps; ++ks) {
        bf16x8 bf[NT];
#pragma unroll
        for (int b = 0; b < NT; ++b) bf[b] = bl(ks, b);
#pragma unroll
        for (int a = 0; a < MTL; ++a) { const bf16x8 af = *(const bf16x8*)(dp + (size_t)a * 16 * ldd + ks * 32);
#pragma unroll
            for (int b = 0; b < NT; ++b) acc[a][b] = __builtin_amdgcn_mfma_f32_16x16x32_bf16(af, bf[b], acc[a][b], 0, 0, 0); }
    }
}
template <int MTL>
__device__ __forceinline__ void lmul_g4(const bf16_t* __restrict__ D, const int ldd, const int ksteps, const bf16_t* __restrict__ base, const size_t rs, f32x4 (&acc)[MTL][4], const int lane) {
    const int r = lane & 15, q = lane >> 4;
    const bf16_t* dp = D + (size_t)r * ldd + q * 8;
#pragma unroll
    for (int a = 0; a < MTL; ++a)
#pragma unroll
        for (int b = 0; b < 4; ++b) acc[a][b] = (f32x4){0.f, 0.f, 0.f, 0.f};
    u32x2 w[8];
    { const bf16_t* p = base + (size_t)(q * 8) * rs;
#pragma unroll
      for (int j = 0; j < 8; ++j) w[j] = *(const u32x2*)(p + (size_t)j * rs); }
#pragma unroll 1
    for (int ks = 0; ks < ksteps; ++ks) {
        u32x2 wn[8];
        if (ks + 1 < ksteps) { const bf16_t* p = base + (size_t)((ks + 1) * 32 + q * 8) * rs;
#pragma unroll
            for (int j = 0; j < 8; ++j) wn[j] = *(const u32x2*)(p + (size_t)j * rs); }
        else {
#pragma unroll
            for (int j = 0; j < 8; ++j) wn[j] = w[j]; }
        union { bf16x8 v; unsigned d[4]; } f0, f1, f2, f3;
#pragma unroll
        for (int d = 0; d < 4; ++d) { const unsigned a0 = w[2 * d][0], a1 = w[2 * d + 1][0], c0 = w[2 * d][1], c1 = w[2 * d + 1][1];
            f0.d[d] = (a0 & 0xffffu) | (a1 << 16); f1.d[d] = (a0 >> 16) | (a1 & 0xffff0000u); f2.d[d] = (c0 & 0xffffu) | (c1 << 16); f3.d[d] = (c0 >> 16) | (c1 & 0xffff0000u); }
#pragma unroll
        for (int a = 0; a < MTL; ++a) { const bf16x8 af = *(const bf16x8*)(dp + (size_t)a * 16 * ldd + ks * 32);
            acc[a][0] = __builtin_amdgcn_mfma_f32_16x16x32_bf16(af, f0.v, acc[a][0], 0, 0, 0); acc[a][1] = __builtin_amdgcn_mfma_f32_16x16x32_bf16(af, f1.v, acc[a][1], 0, 0, 0);
            acc[a][2] = __builtin_amdgcn_mfma_f32_16x16x32_bf16(af, f2.v, acc[a][2], 0, 0, 0); acc[a][3] = __builtin_amdgcn_mfma_f32_16x16x32_bf16(af, f3.v, acc[a][3], 0, 0, 0); }
#pragma unroll
        for (int j = 0; j < 8; ++j) w[j] = wn[j];
    }
}
struct BLGather { const bf16_t* base; size_t rs; int lane;
    __device__ __forceinline__ bf16x8 operator()(int ks, int b) const {
        const int q = lane >> 4; const bf16_t* p = base + (size_t)(ks * 32 + q * 8) * rs + b * 16; bf16x8 v;
#pragma unroll
        for (int j = 0; j < 8; ++j) v[j] = (short)p[(size_t)j * rs];
        return v; }
};
__device__ __forceinline__ int ssm_row(int col, int s) { return col < 512 ? ((col >> 8) * SEQ + (col & 255) * 16 + s) : (MX + ((col - 512) >> 4) * LCX + ((col - 512) & 15) * 16 + s); }
template <int KW, bool YST>
__device__ __forceinline__ void ssm_stage_lds(PREF P, const int l, const int wi, unsigned char* shm, const int tid) {
    const int lane = tid & 63, wv = tid >> 6, r = lane & 15, q = lane >> 4;
    const int g = wi >> 2, mh = (wi >> 1) & 1, half = wi & 1;
    unsigned char* wl = P.ws + l * SZ_LAYER; const bf16_t* parts = (const bf16_t*)(P.ws + O_PARTS);
    const bf16_t* D = (const bf16_t*)(wl + (YST ? LO_M2 : LO_M1)) + ((size_t)g * 256 + mh * 128) * KW;
    LAS unsigned char* lds = (LAS unsigned char*)shm;
    constexpr int CPR = KW / 8, KS = KW / 32;
    for (int ch = tid; ch < 128 * CPR; ch += 512) { const int row = ch / CPR, c = ch % CPR; const u32x4 v = *(const u32x4*)(D + (size_t)row * KW + c * 8);
        *(LAS u32x4*)(lds + row * (KW * 2) + ((c ^ (row & 15)) << 4)) = v; }
    __syncthreads();
    const int nct = (YST && l == 1) ? 16 : 17, hsplit = (nct + 1) / 2;
    const int t0 = half == 0 ? 0 : hsplit, t1 = half == 0 ? hsplit : nct;
    const bf16_t* HS = (const bf16_t*)(P.ws + O_HS);
    for (int ct = t0 + wv; ct < t1; ct += 8) {
        f32x4 acc[8][2];
#pragma unroll
        for (int a = 0; a < 8; ++a) { acc[a][0] = (f32x4){0.f, 0.f, 0.f, 0.f}; acc[a][1] = (f32x4){0.f, 0.f, 0.f, 0.f}; }
        const int colA = ct * 32 + r, colB = colA + 16;
        const bf16_t* pu0 = parts + E_PU + (size_t)(ssm_row(colA, 0) + (q >> 1)) * 1024 + g * 16 + (q & 1) * 8;
        const bf16_t* pu1 = parts + E_PU + (size_t)(ssm_row(colB, 0) + (q >> 1)) * 1024 + g * 16 + (q & 1) * 8;
        const bf16_t* ph0 = HS + ((size_t)g * NCOL + colA) * 256 + q * 8; const bf16_t* ph1 = HS + ((size_t)g * NCOL + colB) * 256 + q * 8;
#pragma unroll
        for (int kh = 0; kh < KS / 8; ++kh) {
            bf16x8 bq[8][2];
#pragma unroll
            for (int k8 = 0; k8 < 8; ++k8) {
                if (kh == 0) { bq[k8][0] = *(const bf16x8*)(pu0 + (size_t)k8 * 2 * 1024); bq[k8][1] = *(const bf16x8*)(pu1 + (size_t)k8 * 2 * 1024); }
                else { bq[k8][0] = *(const bf16x8*)(ph0 + k8 * 32); bq[k8][1] = *(const bf16x8*)(ph1 + k8 * 32); } }
#pragma unroll
            for (int k8 = 0; k8 < 8; ++k8) { const int ks = kh * 8 + k8;
                __builtin_amdgcn_sched_barrier(0);
#pragma unroll
                for (int a = 0; a < 8; ++a) { const bf16x8 af = *(const LAS bf16x8*)(lds + (a * 16 + r) * (KW * 2) + (((ks * 4 + q) ^ r) << 4));
                    acc[a][0] = __builtin_amdgcn_mfma_f32_16x16x32_bf16(af, bq[k8][0], acc[a][0], 0, 0, 0); acc[a][1] = __builtin_amdgcn_mfma_f32_16x16x32_bf16(af, bq[k8][1], acc[a][1], 0, 0, 0); }
            }
            __builtin_amdgcn_sched_barrier(0);
        }
        if (!YST) { float* EB = (float*)(P.ws + O_EB);
#pragma unroll
            for (int a = 0; a < 8; ++a)
#pragma unroll
                for (int b = 0; b < 2; ++b) { const int col = ct * 32 + b * 16 + r; *(f32x4*)(EB + ((size_t)g * NCOL + col) * 256 + mh * 128 + a * 16 + q * 4) = acc[a][b]; }
        } else { bf16_t* GB = (bf16_t*)(P.ws + O_GB); const f32x4 dv = *(const f32x4*)(P.ssm_d + l * 1024 + g * 16 + q * 4);
            u32x2 uq[8][2];
#pragma unroll
            for (int a = 0; a < 8; ++a)
#pragma unroll
                for (int b = 0; b < 2; ++b) { const int col = ct * 32 + b * 16 + r, t = mh * 8 + a, row = ssm_row(col, t); uq[a][b] = *(const u32x2*)(parts + E_PU + (size_t)row * 1024 + g * 16 + q * 4); }
#pragma unroll
            for (int a = 0; a < 8; ++a)
#pragma unroll
                for (int b = 0; b < 2; ++b) { const int col = ct * 32 + b * 16 + r, t = mh * 8 + a, row = ssm_row(col, t);
                    const u32x2 uu = uq[a][b];
                    const float y0 = gelu_tanh(acc[a][b][0] + dv[0] * lo_f(uu[0])), y1 = gelu_tanh(acc[a][b][1] + dv[1] * hi_f(uu[0])), y2 = gelu_tanh(acc[a][b][2] + dv[2] * lo_f(uu[1])), y3 = gelu_tanh(acc[a][b][3] + dv[3] * hi_f(uu[1]));
                    u32x2 o; o[0] = cvt_pk_bf16(y0, y1); o[1] = cvt_pk_bf16(y2, y3); *(u32x2*)(GB + (size_t)row * 1024 + g * 16 + q * 4) = o; }
        }
    }
    __syncthreads();
}


template <int MODE>
__device__ __forceinline__ void ctx_small_gemm(PREF P, unsigned char* shm) {
    constexpr int K = MODE >= 2 ? 2048 : 1024, ROWS = MODE >= 2 ? 32 : 64, CPR = K / 8, KS = K / 32, NBR = MODE == 1 ? 3 : 1;
    const int tid = tid_opaque(), bidx = bid_opaque(), lane = tid & 63, w = tid >> 6, r = lane & 15, q = lane >> 4;
    unsigned char* wl = P.ws; const bf16_t* parts = (const bf16_t*)(P.ws + O_PARTS); LAS unsigned char* lds = (LAS unsigned char*)shm;
    for (int it = bidx; it < 256; it += gridDim.x) {
        const int rb = MODE >= 2 ? (it >> 4) : (it >> 5), cb = MODE >= 2 ? (it & 15) : (it & 31);
        const int row_base = MX + rb * ROWS;
        const int rt0 = MODE == 0 ? (w >> 1) : (MODE == 1 ? 2 * (w >> 2) : (MODE == 2 ? 0 : (w >> 2))), rt1 = (MODE == 0 || MODE == 3) ? rt0 : rt0 + 1;
        const int col0 = MODE == 0 ? cb * 32 + (w & 1) * 16 : (MODE == 1 ? cb * 64 + (w & 3) * 16 : (MODE == 2 ? cb * 128 + w * 16 : cb * 64 + (w & 3) * 16));
        float msum[2][4];
#pragma unroll
        for (int t = 0; t < 2; ++t)
#pragma unroll
            for (int i = 0; i < 4; ++i) msum[t][i] = 0.f;
#pragma unroll 1
        for (int br = 0; br < NBR; ++br) {
            const bf16_t* Asrc = MODE == 0 ? (const bf16_t*)(P.ws + O_GB) : (MODE == 1 ? (const bf16_t*)(P.ws + O_AB + (size_t)br * SZ_BR) : (MODE == 2 ? (const bf16_t*)(P.ws + O_HB) : (const bf16_t*)(P.ws + O_YB)));
            for (int ch = tid; ch < ROWS * CPR; ch += 512) { const int row = ch / CPR, c = ch % CPR; const u32x4 v = *(const u32x4*)(Asrc + (size_t)(row_base + row) * K + c * 8);
                *(LAS u32x4*)(lds + row * (K * 2) + ((c ^ (row & 15)) << 4)) = v; }
            __syncthreads();
            const bf16_t* W0; const bf16_t* W1;
            if (MODE == 0) { const int oc = col0 + r; W0 = (const bf16_t*)(wl + LO_GLU) + (size_t)((oc >> 7) * 256 + (oc & 127)) * K + q * 8; W1 = W0 + (size_t)128 * K; }
            else if (MODE == 1) { W0 = (const bf16_t*)(wl + LO_PA + (size_t)br * SZ_P) + (size_t)(col0 + r) * K + q * 8; W1 = W0; }
            else if (MODE == 2) { W0 = (const bf16_t*)(wl + LO_WO) + (size_t)(col0 + r) * K + q * 8; W1 = W0; }
            else { W0 = (const bf16_t*)(wl + LO_WP) + (size_t)(col0 + r) * K + q * 8; W1 = W0; }
            f32x4 acc0 = (f32x4){0.f, 0.f, 0.f, 0.f}, acc1 = (f32x4){0.f, 0.f, 0.f, 0.f};
#pragma unroll 4
            for (int ks = 0; ks < KS; ++ks) {
                const bf16x8 a0 = *(const LAS bf16x8*)(lds + (rt0 * 16 + r) * (K * 2) + (((ks * 4 + q) ^ r) << 4));
                const bf16x8 b0 = *(const bf16x8*)(W0 + ks * 32);
                if (MODE == 0) { const bf16x8 b1 = *(const bf16x8*)(W1 + ks * 32);
                    acc0 = __builtin_amdgcn_mfma_f32_16x16x32_bf16(a0, b0, acc0, 0, 0, 0); acc1 = __builtin_amdgcn_mfma_f32_16x16x32_bf16(a0, b1, acc1, 0, 0, 0); }
                else if (MODE == 3) { acc0 = __builtin_amdgcn_mfma_f32_16x16x32_bf16(a0, b0, acc0, 0, 0, 0); }
                else { const bf16x8 a1 = *(const LAS bf16x8*)(lds + (rt1 * 16 + r) * (K * 2) + (((ks * 4 + q) ^ r) << 4));
                    acc0 = __builtin_amdgcn_mfma_f32_16x16x32_bf16(a0, b0, acc0, 0, 0, 0); acc1 = __builtin_amdgcn_mfma_f32_16x16x32_bf16(a1, b0, acc1, 0, 0, 0); }
            }
            const int col = col0 + r;
            if (MODE == 0) { bf16_t* BBo = (bf16_t*)(P.ws + O_BB); float zq[4];
#pragma unroll
                for (int i = 0; i < 4; ++i) { const int row = row_base + rt0 * 16 + q * 4 + i; zq[i] = bf2f(parts[E_PZB + (size_t)row * 1024 + col]); }
#pragma unroll
                for (int i = 0; i < 4; ++i) { const int row = row_base + rt0 * 16 + q * 4 + i; const float z = zq[i];
                    BBo[(size_t)row * 1024 + col] = (bf16_t)(cvt_pk_bf16(acc0[i] * sigmoidf_(acc1[i]) * siluf_(z), 0.f) & 0xffffu); }
            } else if (MODE == 1) {
#pragma unroll
                for (int i = 0; i < 4; ++i) { const int rowa = row_base + rt0 * 16 + q * 4 + i, rowb = row_base + rt1 * 16 + q * 4 + i;
                    msum[0][i] += acc0[i] * sigmoidf_(bf2f(parts[E_PGL + (size_t)rowa * 6144 + br * DM + col])); msum[1][i] += acc1[i] * sigmoidf_(bf2f(parts[E_PGL + (size_t)rowb * 6144 + br * DM + col])); }
            } else if (MODE == 3) { bf16_t* CBo = (bf16_t*)(P.ws + O_CB); float zq3[4];
#pragma unroll
                for (int i = 0; i < 4; ++i) { const int row = row_base + rt0 * 16 + q * 4 + i; zq3[i] = bf2f(parts[E_PZC + (size_t)row * 1024 + col]); }
#pragma unroll
                for (int i = 0; i < 4; ++i) { const int row = row_base + rt0 * 16 + q * 4 + i; const float z = zq3[i];
                    CBo[(size_t)row * 1024 + col] = (bf16_t)(cvt_pk_bf16(acc0[i] * siluf_(z), 0.f) & 0xffffu); }
            } else { bf16_t* OBo = (bf16_t*)(P.ws + O_PARTS);
#pragma unroll
                for (int i = 0; i < 4; ++i) { const int rowa = row_base + rt0 * 16 + q * 4 + i, rowb = row_base + rt1 * 16 + q * 4 + i;
                    OBo[(size_t)rowa * DM + col] = (bf16_t)(cvt_pk_bf16(acc0[i], 0.f) & 0xffffu); OBo[(size_t)rowb * DM + col] = (bf16_t)(cvt_pk_bf16(acc1[i], 0.f) & 0xffffu); }
            }
            __syncthreads();
        }
        if (MODE == 1) { bf16_t* MBo = (bf16_t*)(P.ws + O_HB); const int col = col0 + r;
#pragma unroll
            for (int i = 0; i < 4; ++i) { const int rowa = row_base + rt0 * 16 + q * 4 + i, rowb = row_base + rt1 * 16 + q * 4 + i;
                MBo[(size_t)rowa * DM + col] = (bf16_t)(cvt_pk_bf16(msum[0][i], 0.f) & 0xffffu); MBo[(size_t)rowb * DM + col] = (bf16_t)(cvt_pk_bf16(msum[1][i], 0.f) & 0xffffu); }
        }
    }
}

struct TileJob { const float* src; bf16_t* dst; int N, K, k0, n0, drow0; };
constexpr int TILES_PER_LAYER = 4736 + 512;
__device__ __forceinline__ TileJob tile_job(PREF P, int gt) {
    const int l = gt / TILES_PER_LAYER, tt = gt - l * TILES_PER_LAYER; unsigned char* wl = P.ws + l * SZ_LAYER; TileJob J; int kt, nt;
    if (tt < 3584) { J.src = P.w_in + (size_t)l * DM * INW; J.dst = (bf16_t*)(wl + LO_WIN); J.K = DM; J.N = INW; kt = tt & 15; nt = tt >> 4; J.drow0 = nt * 64; }
    else if (tt < 3584 + 768) { const int e = tt - 3584, w = e >> 8, f = e & 255; J.src = (w == 0 ? P.proj_a : (w == 1 ? P.proj_b : P.proj_c)) + (size_t)l * 1024 * DM;
        J.dst = (bf16_t*)(wl + LO_PA + (size_t)w * SZ_P); J.K = 1024; J.N = DM; kt = f & 7; nt = f >> 3; J.drow0 = nt * 64; }
    else if (tt < 4352 + 256) { const int e = tt - 4352, w = e >> 7, f = e & 127; J.src = (w == 0 ? P.glu_wa : P.glu_wb) + (size_t)l * 1024 * 1024; J.dst = (bf16_t*)(wl + LO_GLU);
        J.K = 1024; J.N = 1024; kt = f & 7; nt = f >> 3; const int n0 = nt * 64; J.drow0 = (n0 >> 7) * 256 + (n0 & 127) + w * 128; }
    else if (tt < 4608 + 128) { const int f = tt - 4608; J.src = P.fourier_w + (size_t)l * 1024 * 1024; J.dst = (bf16_t*)(wl + LO_FW); J.K = 1024; J.N = 1024; kt = f & 7; nt = f >> 3; J.drow0 = nt * 64; }
    else { const int f = tt - 4736; J.src = P.w_out + (size_t)l * DM * DM; J.dst = (bf16_t*)(wl + LO_WO); J.K = DM; J.N = DM; kt = f & 15; nt = f >> 4; J.drow0 = nt * 64; }
    J.k0 = kt * 128; J.n0 = nt * 64; return J;
}


__device__ __forceinline__ void mod_item(PREF P, int l, int nt, float* sm) {
    const int tid = tid_opaque(); float* sc = sm; float* red = sm + 3 * 2048;
    for (int i = tid; i < 3 * 2048; i += 512) { const int r = i >> 11, k = i & 2047; const float v = r < 2 ? P.c[r * 2048 + k] : P.c_ctx[k]; sc[i] = siluf_(v); }
    __syncthreads();
    const int col = tid & 63, kg = tid >> 6; const float* w = P.w_ada + (size_t)l * DM * 6144 + nt * 64 + col;
    float a0 = 0.f, a1 = 0.f, a2 = 0.f;
#pragma unroll 16
    for (int k = kg * 256; k < kg * 256 + 256; ++k) { const float wv = w[(size_t)k * 6144]; a0 += sc[k] * wv; a1 += sc[2048 + k] * wv; a2 += sc[4096 + k] * wv; }
    red[(kg * 3 + 0) * 64 + col] = a0; red[(kg * 3 + 1) * 64 + col] = a1; red[(kg * 3 + 2) * 64 + col] = a2;
    __syncthreads();
    if (tid < 192) { const int r = tid >> 6, c = tid & 63; float s = 0.f;
#pragma unroll
        for (int k = 0; k < 8; ++k) s += red[(k * 3 + r) * 64 + c];
        float* MOD = (float*)(P.ws + l * SZ_LAYER + LO_MOD); MOD[r * 6144 + nt * 64 + c] = s + P.b_ada[l * 6144 + nt * 64 + c]; }
    __syncthreads();
}

__device__ __forceinline__ void tables_item(PREF P, int it) {
    const int tid = tid_opaque(); unsigned char* tb = P.ws + O_TAB;
    if (it < 8) {
        bf16_t* T = (bf16_t*)(tb + T_CS);
        for (int e = tid; e < 64 * 256; e += 512) { const int row = it * 64 + (e >> 8), kc = e & 255, cs = row >> 8, j = row & 255; const int mm = (j * kc) & 255;
            float s, c; sincospif((float)mm * (1.0f / 128.0f), &s, &c); T[row * 256 + kc] = (bf16_t)(cvt_pk_bf16((cs ? s : c) * 0.0625f, 0.f) & 0xffffu); }
    } else if (it < 16) {
        bf16_t* T = (bf16_t*)(tb + T_DCTX); const int i8 = it - 8;
        for (int e = tid; e < 64 * 256; e += 512) { const int row = i8 * 64 + (e >> 8), t = e & 255, cs = row >> 8, k = row & 255; const int mm = (k * t) & 255;
            float s, c; sincospif((float)mm * (1.0f / 128.0f), &s, &c); T[row * 256 + t] = (bf16_t)(cvt_pk_bf16((cs ? -s : c) * 0.0625f, 0.f) & 0xffffu); }
    } else {
        bf16_t* D1 = (bf16_t*)(tb + T_D1); bf16_t* D2 = (bf16_t*)(tb + T_D2); float* TW = (float*)(tb + T_TW);
        for (int e = tid; e < 128 * 64; e += 512) { const int row = e >> 6, t1 = e & 63, cs = row >> 6, k1 = row & 63; const int mm = (k1 * t1) & 63;
            float s, c; sincospif((float)mm * (1.0f / 32.0f), &s, &c); D1[e] = (bf16_t)(cvt_pk_bf16((cs ? -s : c) * 0.125f, 0.f) & 0xffffu); }
        for (int e = tid; e < 128 * 128; e += 512) { const int row = e >> 7, col = e & 127, cso = row >> 6, k2 = row & 63, csi = col >> 6, t2 = col & 63; const int mm = (k2 * t2) & 63;
            float s, c; sincospif((float)mm * (1.0f / 32.0f), &s, &c); const float v = (cso == csi) ? c : (cso == 0 ? s : -s);
            D2[e] = (bf16_t)(cvt_pk_bf16(v * 0.125f, 0.f) & 0xffffu); }
        for (int e = tid; e < 64 * 64; e += 512) { const int k1 = e >> 6, t2 = e & 63; float s, c; sincospif((float)(k1 * t2) * (1.0f / 2048.0f), &s, &c); TW[2 * e] = c; TW[2 * e + 1] = -s; }
    }
}

__device__ __forceinline__ void ssm_build(PREF P, int l, int g, float* sm) {
    float* ap_re = sm; float* ap_im = ap_re + 2 * 17 * 64; float* bb_re = ap_im + 2 * 17 * 64; float* bb_im = bb_re + 2 * 64 * 16;
    float* cc_re = bb_im + 2 * 64 * 16; float* cc_im = cc_re + 2 * 16 * 64; float* Kk = cc_im + 2 * 16 * 64;
    const int tid = tid_opaque(); unsigned char* wl = P.ws + l * SZ_LAYER;
    if (tid < 128) {
        const int d = tid >> 6, p = tid & 63; const size_t gi = (size_t)(l * 2 + d) * 64 + g;
        const double lr = (double)P.lam_re[gi * 64 + p], li = (double)P.lam_im[gi * 64 + p], dt = exp((double)P.log_dt[gi]);
        const double a_re = exp(lr * dt) * cos(li * dt), a_im = exp(lr * dt) * sin(li * dt);
        { double pr = 1.0, pi = 0.0;
          for (int tau = 0; tau <= 16; ++tau) { ap_re[(d * 17 + tau) * 64 + p] = (float)pr; ap_im[(d * 17 + tau) * 64 + p] = (float)pi;
              if (tau == 16) { float* A16 = (float*)(wl + LO_A16); A16[((d * 64 + g) * 64 + p) * 2] = (float)pr; A16[((d * 64 + g) * 64 + p) * 2 + 1] = (float)pi; }
              const double nr = pr * a_re - pi * a_im, ni = pr * a_im + pi * a_re; pr = nr; pi = ni; } }
        const double n_re = a_re - 1.0, n_im = a_im, den = lr * lr + li * li;
        const double q_re = (n_re * lr + n_im * li) / den, q_im = (n_im * lr - n_re * li) / den;
        for (int h = 0; h < 16; ++h) { const double br = (double)P.b_re[(gi * 64 + p) * 16 + h], bi = (double)P.b_im[(gi * 64 + p) * 16 + h];
            bb_re[(d * 64 + p) * 16 + h] = (float)(q_re * br - q_im * bi); bb_im[(d * 64 + p) * 16 + h] = (float)(q_re * bi + q_im * br); }
    }
    for (int i = tid; i < 2048; i += 512) { const int d = i >> 10, rem = i & 1023; const size_t s = ((size_t)(l * 2 + d) * 64 + g) * 1024 + rem; cc_re[i] = P.c_re[s]; cc_im[i] = P.c_im[s]; }
    __syncthreads();
    { const int d = tid >> 8, tau = (tid >> 4) & 15, ho = tid & 15; float sacc[16];
#pragma unroll
      for (int hi = 0; hi < 16; ++hi) sacc[hi] = 0.f;
      for (int p = 0; p < 64; ++p) { const float cr = cc_re[(d * 16 + ho) * 64 + p], ci = cc_im[(d * 16 + ho) * 64 + p], ar = ap_re[(d * 17 + tau) * 64 + p], ai = ap_im[(d * 17 + tau) * 64 + p];
          const float wr = cr * ar - ci * ai, wi = cr * ai + ci * ar; const float* br = bb_re + (d * 64 + p) * 16; const float* bi = bb_im + (d * 64 + p) * 16;
#pragma unroll
          for (int hi = 0; hi < 16; ++hi) sacc[hi] += wr * br[hi] - wi * bi[hi]; }
#pragma unroll
      for (int hi = 0; hi < 16; ++hi) Kk[((d * 16 + tau) * 16 + ho) * 16 + hi] = sacc[hi]; }
    __syncthreads();
    bf16_t* M1 = (bf16_t*)(wl + LO_M1) + (size_t)g * 256 * 256; bf16_t* M2 = (bf16_t*)(wl + LO_M2) + (size_t)g * 256 * 512;
    for (int v = tid; v < 8192; v += 512) { const int mrow = v >> 5, k0 = (v & 31) * 8; const int d = mrow >> 7, reim = (mrow >> 6) & 1, p = mrow & 63, s = k0 >> 4, hi0 = k0 & 15;
        const int tau = d == 0 ? 15 - s : s; const float ar = ap_re[(d * 17 + tau) * 64 + p], ai = ap_im[(d * 17 + tau) * 64 + p]; float f[8];
#pragma unroll
        for (int j = 0; j < 8; ++j) { const float br = bb_re[(d * 64 + p) * 16 + hi0 + j], bi = bb_im[(d * 64 + p) * 16 + hi0 + j]; f[j] = reim == 0 ? ar * br - ai * bi : ar * bi + ai * br; }
        *(u32x4*)(M1 + (size_t)mrow * 256 + k0) = pack8(f); }
    for (int v = tid; v < 16384; v += 512) { const int r = v >> 6, k0 = (v & 63) * 8, t = r >> 4, ho = r & 15; float f[8];
        if (k0 < 256) { const int s = k0 >> 4, hi0 = k0 & 15;
#pragma unroll
            for (int j = 0; j < 8; ++j) f[j] = s < t ? Kk[(t - s) * 256 + ho * 16 + hi0 + j] : (s > t ? Kk[(16 + (s - t)) * 256 + ho * 16 + hi0 + j] : Kk[ho * 16 + hi0 + j] + Kk[16 * 256 + ho * 16 + hi0 + j]);
        } else { const int kk = k0 - 256, d = kk >> 7, reim = (kk >> 6) & 1, p0 = kk & 63, tau = d == 0 ? t + 1 : 16 - t;
#pragma unroll
            for (int j = 0; j < 8; ++j) { const int p = p0 + j; const float cr = cc_re[(d * 16 + ho) * 64 + p], ci = cc_im[(d * 16 + ho) * 64 + p], ar = ap_re[(d * 17 + tau) * 64 + p], ai = ap_im[(d * 17 + tau) * 64 + p];
                f[j] = reim == 0 ? cr * ar - ci * ai : -(cr * ai + ci * ar); } }
        *(u32x4*)(M2 + (size_t)r * 512 + k0) = pack8(f); }
    __syncthreads();
}

__device__ __forceinline__ void phase_prep(PREF P, unsigned char* shm) {
    float* sm = (float*)shm; const int b = bid_opaque(), G = gridDim.x;
    for (int it = b; it < 337; it += G) {
        if (it < 128) ssm_build(P, it >> 6, it & 63, sm);
        else if (it < 320) { const int e = it - 128; mod_item(P, e / 96, e % 96, sm); }
        else tables_item(P, it - 320);
    }
    const int total = 2 * TILES_PER_LAYER; int start, cnt;
    if (G == 256) { if (b < 64) { start = b * 38; cnt = 38; } else if (b < 81) { start = 2432 + (b - 64) * 42; cnt = 42; } else { start = 2432 + 17 * 42 + (b - 81) * 43; cnt = 43; } }
    else { cnt = (total + G - 1) / G; start = b * cnt; }
    const int end = (start + cnt) < total ? (start + cnt) : total;
    const int tid = tid_opaque(), lr = tid >> 4, lc = (tid & 15) * 4;
    if (start < end) {
        int cur = start; TileJob J = tile_job(P, cur); f32x4 v[4];
#pragma unroll
        for (int i = 0; i < 4; ++i) v[i] = *(const f32x4*)(J.src + (size_t)(J.k0 + lr + 32 * i) * J.N + J.n0 + lc);
        for (;;) {
#pragma unroll
            for (int i = 0; i < 4; ++i)
#pragma unroll
                for (int j = 0; j < 4; ++j) sm[(lr + 32 * i) * 65 + lc + j] = v[i][j];
            __syncthreads();
            const TileJob C = J; const bool more = cur + 1 < end;
            if (more) { J = tile_job(P, cur + 1);
#pragma unroll
                for (int i = 0; i < 4; ++i) v[i] = *(const f32x4*)(J.src + (size_t)(J.k0 + lr + 32 * i) * J.N + J.n0 + lc); }
            const int n = tid >> 3, kg = tid & 7;
#pragma unroll
            for (int h = 0; h < 2; ++h) { float f[8];
#pragma unroll
                for (int j = 0; j < 8; ++j) f[j] = sm[(kg * 16 + h * 8 + j) * 65 + n];
                *(u32x4*)(C.dst + (size_t)(C.drow0 + n) * C.K + C.k0 + kg * 16 + h * 8) = pack8(f); }
            __syncthreads();
            if (!more) break;
            ++cur;
        }
    }
}

__device__ __forceinline__ void phase_prenorm0(PREF P) {
    const int tidx = tid_opaque(); const int lane = tidx & 63, gw = (tidx >> 6) * (int)gridDim.x + bid_opaque(), nw = gridDim.x * 8;
    const float* MOD = (const float*)(P.ws + LO_MOD); bf16_t* HB = (bf16_t*)(P.ws + O_HB);
    for (int row = gw; row < MTOT; row += nw) {
        const float* src = row < MX ? P.x + (size_t)row * DM : P.ctx + (size_t)(row - MX) * DM; const float* md = MOD + (row < MX ? (row >> 12) : 2) * 6144;
        f32x4 v[8]; float ss = 0.f;
#pragma unroll
        for (int i = 0; i < 8; ++i) { v[i] = *(const f32x4*)(src + (i * 64 + lane) * 4); ss += v[i][0] * v[i][0] + v[i][1] * v[i][1] + v[i][2] * v[i][2] + v[i][3] * v[i][3]; }
        ss = wave_sum(ss, lane); const float rinv = rsqrtf(ss * (1.0f / DM) + RMS_EPS);
#pragma unroll
        for (int i = 0; i < 8; ++i) { const int c = (i * 64 + lane) * 4; const f32x4 g = *(const f32x4*)(P.g_pre + c), sh = *(const f32x4*)(md + c), sc = *(const f32x4*)(md + 2048 + c); float h[4];
#pragma unroll
            for (int j = 0; j < 4; ++j) h[j] = v[i][j] * rinv * g[j] * (1.0f + sc[j]) + sh[j];
            u32x2 o; o[0] = cvt_pk_bf16(h[0], h[1]); o[1] = cvt_pk_bf16(h[2], h[3]); *(u32x2*)(HB + (size_t)row * DM + c) = o; }
    }
}
__device__ __forceinline__ void phase_postnorm(PREF P, int l) {
    const int tidx = tid_opaque(); const int lane = tidx & 63, gw = (tidx >> 6) * (int)gridDim.x + bid_opaque(), nw = gridDim.x * 8;
    const float* MOD = (const float*)(P.ws + l * SZ_LAYER + LO_MOD); const float* MOD1 = (const float*)(P.ws + SZ_LAYER + LO_MOD);
    bf16_t* HB = (bf16_t*)(P.ws + O_HB); const bf16_t* OB = (const bf16_t*)(P.ws + O_PARTS); float* X1 = (float*)(P.ws + O_X1);
    const int rows = l == 0 ? MTOT : MX;
    for (int row = gw; row < rows; row += nw) {
        const int mr = row < MX ? (row >> 12) : 2; const float* md = MOD + mr * 6144;
        const float* xo = l == 0 ? (row < MX ? P.x + (size_t)row * DM : P.ctx + (size_t)(row - MX) * DM) : X1 + (size_t)row * DM;
        const bf16_t* op = OB + (size_t)row * DM;
        f32x4 o[8], xv[8]; float ss = 0.f;
#pragma unroll
        for (int i = 0; i < 8; ++i) { const u32x2 ob = *(const u32x2*)(op + (i * 64 + lane) * 4); o[i] = (f32x4){lo_f(ob[0]), hi_f(ob[0]), lo_f(ob[1]), hi_f(ob[1])}; xv[i] = *(const f32x4*)(xo + (i * 64 + lane) * 4); ss += o[i][0] * o[i][0] + o[i][1] * o[i][1] + o[i][2] * o[i][2] + o[i][3] * o[i][3]; }
        ss = wave_sum(ss, lane); const float rinv = rsqrtf(ss * (1.0f / DM) + RMS_EPS); float s2 = 0.f;
#pragma unroll
        for (int i = 0; i < 8; ++i) { const int c = (i * 64 + lane) * 4; const f32x4 gp = *(const f32x4*)(P.g_post + l * DM + c), gt = *(const f32x4*)(md + 4096 + c);
#pragma unroll
            for (int j = 0; j < 4; ++j) { xv[i][j] = xv[i][j] + gt[j] * (o[i][j] * rinv * gp[j]); s2 += xv[i][j] * xv[i][j]; }
            if (l == 0) *(f32x4*)(X1 + (size_t)row * DM + c) = xv[i]; else *(f32x4*)(P.out + (size_t)row * DM + c) = xv[i]; }
        if (l == 0) { s2 = wave_sum(s2, lane); const float r2 = rsqrtf(s2 * (1.0f / DM) + RMS_EPS); const float* m1 = MOD1 + mr * 6144;
#pragma unroll
            for (int i = 0; i < 8; ++i) { const int c = (i * 64 + lane) * 4; const f32x4 g = *(const f32x4*)(P.g_pre + DM + c), sh = *(const f32x4*)(m1 + c), sc = *(const f32x4*)(m1 + 2048 + c); float h[4];
#pragma unroll
                for (int j = 0; j < 4; ++j) h[j] = xv[i][j] * r2 * g[j] * (1.0f + sc[j]) + sh[j];
                u32x2 ov; ov[0] = cvt_pk_bf16(h[0], h[1]); ov[1] = cvt_pk_bf16(h[2], h[3]); *(u32x2*)(HB + (size_t)row * DM + c) = ov; } }
    }
}


__device__ __forceinline__ void conv_rows(PREF P, const int l, const int bsub, const int nblk, const int tidx) {
    const bf16_t* parts = (const bf16_t*)(P.ws + O_PARTS); bf16_t* AB = (bf16_t*)(P.ws + O_AB);
    const int rows = l == 0 ? MTOT : MX; const float* cw = P.conv_w + (size_t)l * 3 * 1024;
    for (int idx = bsub * 512 + tidx; idx < (rows >> 2) * 128; idx += nblk * 512) {
        const int r0 = (idx >> 7) * 4, c0 = (idx & 127) * 8; bool lv, rv;
        if (r0 < MX) { const int cp = r0 & 63; lv = cp > 0; rv = cp < 60; } else { const int t = (r0 - MX) & 255; lv = t > 0; rv = t < 252; }
        const bf16_t* pr = parts + E_PC + (size_t)r0 * 4096 + c0;
        u32x4 xr[6], cr[6], br[4], zr[4];
#pragma unroll
        for (int k = 0; k < 6; ++k) { const bool ok = (k == 0) ? lv : ((k == 5) ? rv : true);
            if (ok) { xr[k] = *(const u32x4*)(pr + (ptrdiff_t)(k - 1) * 4096 + C_XA); cr[k] = *(const u32x4*)(pr + (ptrdiff_t)(k - 1) * 4096 + C_CA); }
            else { xr[k] = (u32x4){0u, 0u, 0u, 0u}; cr[k] = (u32x4){0u, 0u, 0u, 0u}; } }
#pragma unroll
        for (int k = 0; k < 4; ++k) { br[k] = *(const u32x4*)(pr + (size_t)k * 4096 + C_BA); zr[k] = *(const u32x4*)(pr + (size_t)k * 4096 + C_ZA); }
        float w0[8], w1[8], w2[8];
#pragma unroll
        for (int j = 0; j < 8; ++j) { w0[j] = cw[c0 + j]; w1[j] = cw[1024 + c0 + j]; w2[j] = cw[2048 + c0 + j]; }
        float v[6][8];
#pragma unroll
        for (int k = 0; k < 6; ++k) { float xa[8], ca[8]; unpack8(xr[k], xa); unpack8(cr[k], ca);
#pragma unroll
            for (int j = 0; j < 8; ++j) v[k][j] = xa[j] * ca[j]; }
#pragma unroll
        for (int k = 0; k < 4; ++k) { float ba[8], za[8], o[8]; unpack8(br[k], ba); unpack8(zr[k], za);
#pragma unroll
            for (int j = 0; j < 8; ++j) { const float y = w0[j] * v[k][j] + w1[j] * v[k + 1][j] + w2[j] * v[k + 2][j]; o[j] = ba[j] * y * siluf_(za[j]); }
            *(u32x4*)(AB + (size_t)(r0 + k) * 1024 + c0) = pack8(o); }
    }
}

__device__ __forceinline__ void phase_mix1(PREF P, int l, unsigned char* shm) {
    const bf16_t* parts = (const bf16_t*)(P.ws + O_PARTS); unsigned char* wl = P.ws + l * SZ_LAYER;
    const int tidx = tid_opaque(), bidx = bid_opaque(); const int lane = tidx & 63, wv = tidx >> 6, r = lane & 15, q = lane >> 4;
    const int gw = bidx * 8 + wv, nw = gridDim.x * 8;
    for (int wi = bidx; wi < 256; wi += gridDim.x) ssm_stage_lds<256, false>(P, l, wi, shm, tidx);
    {
        bf16_t* ZB = (bf16_t*)(P.ws + O_ZB); const bf16_t* D1 = (const bf16_t*)(P.ws + O_TAB + T_D1); const float* TW = (const float*)(P.ws + O_TAB + T_TW);
        for (int it = gw; it < 2048; it += nw) {
            const int cg = it & 15, t2 = (it >> 4) & 63, b = it >> 10;
            f32x4 acc[8][4];
            lmul_g4<8>(D1, 64, 2, parts + E_PF + (size_t)(b * SEQ + t2) * 1024 + cg * 64 + r * 4, (size_t)64 * 1024, acc, lane);
            float twq[4][4][2];
#pragma unroll
            for (int a = 0; a < 4; ++a)
#pragma unroll
                for (int i = 0; i < 4; ++i) { const int k1 = a * 16 + q * 4 + i; twq[a][i][0] = TW[(k1 * 64 + t2) * 2]; twq[a][i][1] = TW[(k1 * 64 + t2) * 2 + 1]; }
#pragma unroll
            for (int a = 0; a < 4; ++a)
#pragma unroll
                for (int i = 0; i < 4; ++i) { const int k1 = a * 16 + q * 4 + i; const float twr = twq[a][i][0], twi = twq[a][i][1];
                    bf16_t* zr = ZB + ((size_t)((b * 64 + k1) * 128 + t2)) * 1024 + cg * 64 + r * 4; bf16_t* zi = zr + (size_t)64 * 1024; float vr[4], vi[4];
#pragma unroll
                    for (int nb = 0; nb < 4; ++nb) { const float re = acc[a][nb][i], im = acc[a + 4][nb][i]; vr[nb] = re * twr - im * twi; vi[nb] = re * twi + im * twr; }
                    u32x2 o; o[0] = cvt_pk_bf16(vr[0], vr[1]); o[1] = cvt_pk_bf16(vr[2], vr[3]); *(u32x2*)zr = o; o[0] = cvt_pk_bf16(vi[0], vi[1]); o[1] = cvt_pk_bf16(vi[2], vi[3]); *(u32x2*)zi = o; }
        }
    }
}


__device__ __forceinline__ void ctx_dft_item(PREF P, const int it, const int lane) {
    const int r = lane & 15, q = lane >> 4; const bf16_t* parts = (const bf16_t*)(P.ws + O_PARTS);
    bf16_t* YB = (bf16_t*)(P.ws + O_YB); const bf16_t* DC = (const bf16_t*)(P.ws + O_TAB + T_DCTX);
    const int cg = it & 15, mc = (it >> 4) & 3, b = it >> 6;
    f32x4 acc[8][4];
    lmul_g4<8>(DC + (size_t)mc * 128 * 256, 256, 8, parts + E_PF + (size_t)(MX + b * LCX) * 1024 + cg * 64 + r * 4, (size_t)1024, acc, lane);
#pragma unroll
    for (int a = 0; a < 8; ++a)
#pragma unroll
        for (int i = 0; i < 4; ++i) { const int mrow = mc * 128 + a * 16 + q * 4 + i, cs = mrow >> 8, k = mrow & 255;
            bf16_t* yp = YB + (size_t)(MX + b * LCX + k) * 2048 + cs * 1024 + cg * 64 + r * 4;
            u32x2 o; o[0] = cvt_pk_bf16(acc[a][0][i], acc[a][1][i]); o[1] = cvt_pk_bf16(acc[a][2][i], acc[a][3][i]); *(u32x2*)yp = o; }
}

__device__ __forceinline__ void phase_mix2(PREF P, int l) {
    unsigned char* wl = P.ws + l * SZ_LAYER;
    const int tidx = tid_opaque(), bidx = bid_opaque(); const int lane = tidx & 63, wv = tidx >> 6, r = lane & 15, q = lane >> 4;
    const int gw = bidx * 8 + wv, nw = gridDim.x * 8;
    if (wv == 0) {
        const float* EB = (const float*)(P.ws + O_EB); bf16_t* HS = (bf16_t*)(P.ws + O_HS); const float* A16 = (const float*)(wl + LO_A16);
        for (int it = bidx; it < 256; it += gridDim.x) {
            const int d = it & 1, g = (it >> 1) & 63, b = it >> 7, p = lane;
            const float ar = A16[((d * 64 + g) * 64 + p) * 2], ai = A16[((d * 64 + g) * 64 + p) * 2 + 1];
            float hr = 0.f, hi = 0.f;
#define SCAN_COL(j) ((j) < 16 ? 512 + b * 16 + (d ? 15 - (j) : (j)) : b * 256 + (d ? 255 - ((j) - 16) : ((j) - 16)))
#define SCAN_LOAD(er, ei, j0) _Pragma("unroll") for (int jj = 0; jj < 16; ++jj) { const int col = SCAN_COL((j0) + jj); const float* ep = EB + ((size_t)g * NCOL + col) * 256 + d * 128 + p; er[jj] = ep[0]; ei[jj] = ep[64]; }
#define SCAN_STEP(er, ei, j0) _Pragma("unroll") for (int jj = 0; jj < 16; ++jj) { const int col = SCAN_COL((j0) + jj); \
                bf16_t* hp = HS + ((size_t)g * NCOL + col) * 256 + d * 128 + p; const unsigned pk = cvt_pk_bf16(hr, hi); hp[0] = (bf16_t)(pk & 0xffffu); hp[64] = (bf16_t)(pk >> 16); \
                const float nr = ar * hr - ai * hi + er[jj], ni = ar * hi + ai * hr + ei[jj]; hr = nr; hi = ni; }
            float era[16], eia[16], erb[16], eib[16];
            SCAN_LOAD(era, eia, 0)
            for (int it2 = 0; it2 < 8; ++it2) {
                SCAN_LOAD(erb, eib, it2 * 32 + 16)
                SCAN_STEP(era, eia, it2 * 32)
                SCAN_LOAD(era, eia, it2 * 32 + 32)
                SCAN_STEP(erb, eib, it2 * 32 + 16)
            }
            SCAN_STEP(era, eia, 256)
#undef SCAN_COL
#undef SCAN_LOAD
#undef SCAN_STEP
        }
    }
    {
        const bf16_t* ZB = (const bf16_t*)(P.ws + O_ZB); bf16_t* YB = (bf16_t*)(P.ws + O_YB); const bf16_t* D2 = (const bf16_t*)(P.ws + O_TAB + T_D2);
        for (int it = gw; it < 2048; it += nw) {
            const int cg = it & 15, k1 = (it >> 4) & 63, b = it >> 10;
            f32x4 acc[8][4];
            lmul_g4<8>(D2, 128, 4, ZB + (size_t)(b * 64 + k1) * 128 * 1024 + cg * 64 + r * 4, (size_t)1024, acc, lane);
#pragma unroll
            for (int a = 0; a < 8; ++a)
#pragma unroll
                for (int i = 0; i < 4; ++i) { const int mrow = a * 16 + q * 4 + i, cs = mrow >> 6, k2 = mrow & 63;
                    bf16_t* yp = YB + (size_t)(b * SEQ + k1 + 64 * k2) * 2048 + cs * 1024 + cg * 64 + r * 4;
                    u32x2 o; o[0] = cvt_pk_bf16(acc[a][0][i], acc[a][1][i]); o[1] = cvt_pk_bf16(acc[a][2][i], acc[a][3][i]); *(u32x2*)yp = o; }
        }
    }
    if (l == 0 && wv >= 1) { for (int it = bidx * 7 + (wv - 1); it < 128; it += gridDim.x * 7) ctx_dft_item(P, it, lane); }
}

template <int ph>
__device__ __forceinline__ void run_phase(KPtr kp, unsigned char* shm) {
    asm volatile("" : "+s"(kp)); PREF P = *kp;
    LAS unsigned char* lds = (LAS unsigned char*)shm; const int G = gridDim.x, c = bid_opaque();
    if constexpr (ph == 0) { phase_prep(P, shm); return; }
    if constexpr (ph == 1) {
        phase_prenorm0(P);
        return;
    }
    constexpr int l = ph >= 2 ? ((ph - 2) >> 3) : 0, sp = ph >= 2 ? ((ph - 2) & 7) : 0; unsigned char* wl = P.ws + l * SZ_LAYER; constexpr int nM = 32, nh = l == 0 ? 4 : 0;
    const bf16_t* parts = (const bf16_t*)(P.ws + O_PARTS);
    switch (sp) {
    case 0: { EpiParts E{(bf16_t*)(P.ws + O_PARTS)};
        if (l == 0) { SchedGrid S{(const char*)(P.ws + O_HB), (const char*)(wl + LO_WIN), 32, 56, DM, DM, G, c, 4, MX, 1 << 20}; gemm_phase(lds, S, E, DM, DM, DM);
            { const int c3 = bid_opaque(); const int first = G > 224 ? 224 : 0; if (c3 >= first) { SchedWp SW{P.ws, G - first, c3 - first}; EpiWp EW{P.ws}; gemm_phase(lds, SW, EW, 256, 1024, 256); } } }
        else {
            {
                const int tq = tid_opaque(), lane = tq & 63, r = lane & 15, q = lane >> 4; const bf16_t* HB = (const bf16_t*)(P.ws + O_HB); const bf16_t* WT = (const bf16_t*)(wl + LO_WIN); bf16_t* po = (bf16_t*)(P.ws + O_PARTS);
                for (int it = c * 8 + (tq >> 6); it < 2048; it += G * 8) { const int tr = it >> 6, tc = it & 63;
                    const bf16_t* ap = HB + (size_t)(MX + tr * 16 + r) * DM + q * 8; const bf16_t* bp = WT + (size_t)(C_U + tc * 16 + r) * DM + q * 8; f32x4 a4 = (f32x4){0.f, 0.f, 0.f, 0.f};
#pragma unroll 8
                    for (int ks = 0; ks < 64; ++ks) a4 = __builtin_amdgcn_mfma_f32_16x16x32_bf16(*(const bf16x8*)(ap + ks * 32), *(const bf16x8*)(bp + ks * 32), a4, 0, 0, 0);
#pragma unroll
                    for (int i = 0; i < 4; ++i) po[E_PU + (size_t)(MX + tr * 16 + q * 4 + i) * 1024 + tc * 16 + r] = (bf16_t)(cvt_pk_bf16(a4[i], 0.f) & 0xffffu); }
            }
            SchedGrid S{(const char*)(P.ws + O_HB), (const char*)(wl + LO_WIN), 32, 56, DM, DM, G, c, 0, MX, 1 << 20}; gemm_phase(lds, S, E, DM, DM, DM); }
    } break;
    case 1: phase_mix1(P, l, shm); break;
    case 2: phase_mix2(P, l); break;
    case 3: { const int tq = tid_opaque(), c2 = bid_opaque();
        for (int wi = c2; wi < 256; wi += G) ssm_stage_lds<512, true>(P, l, wi, shm, tq);
        conv_rows(P, l, c2, G, tq);
    } break;
    case 4: {
        if (l == 0) { ctx_small_gemm<0>(P, shm); ctx_small_gemm<3>(P, shm); }
        const int nf = nM * 4;
        { const int c1 = bid_opaque(); SchedGrid S{(const char*)(P.ws + O_YB), (const char*)(wl + LO_WP), nM, 4, 2048, 2048, nf, c1, 0, MX, c1 < nf ? 1 : 0}; EpiFourier E{parts, (bf16_t*)(P.ws + O_CB)}; gemm_phase(lds, S, E, 2048, 2048, 2048); }
        { const int c2 = bid_opaque(); const int ng = nM * 8, two = 2 * (G - nf);
          int L0, dL, cn;
          if (G > nf && two <= ng) { if (c2 >= nf) { L0 = 2 * (c2 - nf); dL = 1; cn = 2; } else { L0 = two + c2; dL = nf; cn = (ng - two - c2 + nf - 1) / nf; if (cn < 0) cn = 0; } }
          else { L0 = c2; dL = G; cn = 1 << 20; }
          SchedGrid S{(const char*)(P.ws + O_GB), (const char*)(wl + LO_GLU), nM, 8, 1024, 1024, dL, L0, 0, MX, cn}; EpiGlu E{parts, (bf16_t*)(P.ws + O_BB)}; gemm_phase(lds, S, E, 1024, 1024, 1024); }
    } break;
    case 5: { if (l == 0) ctx_small_gemm<1>(P, shm);
        SchedMerge S{(const char*)(P.ws + O_AB), (const char*)(wl + LO_PA), nM, G, c, 0, MX};
        EpiMerge E{parts, (bf16_t*)(P.ws + O_HB)}; gemm_phase(lds, S, E, 1024, 1024, 1024); } break;
    case 6: { if (l == 0) ctx_small_gemm<2>(P, shm);
        SchedGrid S{(const char*)(P.ws + O_HB), (const char*)(wl + LO_WO), nM, 8, DM, DM, G, c, 0, MX, 1 << 20}; EpiStoreBf16 E{(bf16_t*)(P.ws + O_PARTS), DM}; gemm_phase(lds, S, E, DM, DM, DM); } break;
    default: phase_postnorm(P, l); break;
    }
}

#define XB_TMO      128
#define XB_XCNT(j)  (256  + 64 * (j))
#define XB_XSUB(j)  (1280 + 64 * (j))
#define XB_XGEN(j)  (2304 + 64 * (j))
#define XB_TOP      3328
#define XB_TOPGEN   3392
#define XCD_BAR_WORDS 3456
#define XB_SPIN_CAP (1u << 18)
__device__ __forceinline__ unsigned xb_ld(unsigned* p)              { return __hip_atomic_load(p, __ATOMIC_RELAXED, __HIP_MEMORY_SCOPE_AGENT); }
__device__ __forceinline__ unsigned xb_add(unsigned* p, unsigned v) { return __hip_atomic_fetch_add(p, v, __ATOMIC_RELAXED, __HIP_MEMORY_SCOPE_AGENT); }
__device__ __forceinline__ unsigned xb_xcc_id() { return (unsigned)__builtin_amdgcn_s_getreg((3 << 11) | 20) & 0xFu; }
#define XB_SPIN(cond, bar) do { unsigned _sp = 0; while (cond) { __builtin_amdgcn_s_sleep(1); \
    if ((++_sp & 255u) == 0u) { if (xb_ld(&(bar)[XB_TMO])) break; if (_sp > XB_SPIN_CAP) { atomicAdd(&(bar)[XB_TMO], 1u); break; } } } } while (0)
struct XcdBarrier { unsigned* bar; unsigned x; volatile LAS unsigned* st; };
__device__ __forceinline__ XcdBarrier xcd_barrier_post(unsigned* bar, volatile LAS unsigned* st) {
    XcdBarrier b; b.bar = bar; b.x = xb_xcc_id(); b.st = st;
    if (threadIdx.x == 0) (void)xb_add(&bar[XB_XCNT(b.x)], 1u);
    return b;
}
__device__ __forceinline__ void xcd_barrier_complete(unsigned* bar, unsigned x, unsigned& nloc, unsigned& nx) {
    const unsigned G = gridDim.x * gridDim.y * gridDim.z;
    unsigned sum, cnt, mine, sp = 0u;
    for (;;) {
        sum = 0u; cnt = 0u; mine = 0u;
#pragma unroll
        for (unsigned j = 0; j < 16; ++j) { const unsigned c = xb_ld(&bar[XB_XCNT(j)]); sum += c; cnt += (c > 0u) ? 1u : 0u; mine = (j == x) ? c : mine; }
        if (sum == G) break;
        __builtin_amdgcn_s_sleep(1);
        if ((++sp & 255u) == 0u) { if (xb_ld(&bar[XB_TMO])) break; if (sp > XB_SPIN_CAP) { atomicAdd(&bar[XB_TMO], 1u); break; } }
    }
    nloc = mine > 0u ? mine : 1u; nx = cnt > 0u ? cnt : 1u;
}
__device__ __forceinline__ void xcd_barrier(const XcdBarrier& b) {
    asm volatile("s_waitcnt vmcnt(0)" ::: "memory");
    __syncthreads();
    if (threadIdx.x == 0) {
        unsigned* bar = b.bar;
        __builtin_amdgcn_s_waitcnt(0);
        unsigned nloc = b.st[0], nx = b.st[1];
        if (nloc == 0u) { xcd_barrier_complete(bar, b.x, nloc, nx); b.st[0] = nloc; b.st[1] = nx; }
        const unsigned old = xb_add(&bar[XB_XSUB(b.x)], 1u);
        const unsigned gen = old / nloc;
        if (old + 1u == (gen + 1u) * nloc) {
            __builtin_amdgcn_fence(__ATOMIC_RELEASE, "agent");
            asm volatile("s_waitcnt vmcnt(0)" ::: "memory");
            const unsigned og = xb_add(&bar[XB_TOP], 1u);
            const unsigned tg = og / nx;
            if (og + 1u == (tg + 1u) * nx) xb_add(&bar[XB_TOPGEN], 1u);
            else XB_SPIN(xb_ld(&bar[XB_TOPGEN]) == tg, bar);
            __builtin_amdgcn_fence(__ATOMIC_ACQUIRE, "agent");
            xb_add(&bar[XB_XGEN(b.x)], 1u);
            asm volatile("s_waitcnt vmcnt(0)" ::: "memory");
        } else {
            XB_SPIN(xb_ld(&bar[XB_XGEN(b.x)]) == gen, bar);
            __builtin_amdgcn_fence(__ATOMIC_ACQUIRE, "agent");
            asm volatile("s_waitcnt vmcnt(0)" ::: "memory");
        }
    }
    __syncthreads();
}

constexpr int N_PHASES = 18;

__global__ void __launch_bounds__(512, 2) mega(Params P, int ph0, int ph1) {
    extern __shared__ __attribute__((aligned(16))) unsigned char shm[];
    __shared__ uint4 xb_words;
    if (threadIdx.x == 0) xb_words = make_uint4(0u, 0u, 0u, 0u);
    __syncthreads();
    const XcdBarrier xb = xcd_barrier_post((unsigned*)(P.ws + O_BAR), (volatile LAS unsigned*)&xb_words);
    const KPtr kp = (KPtr)__builtin_amdgcn_kernarg_segment_ptr();
#define RUN_PH(k) if (ph0 <= (k) && (k) < ph1) { if ((k) != ph0) xcd_barrier(xb); run_phase<(k)>(kp, shm); }
    RUN_PH(0) RUN_PH(1) RUN_PH(2) RUN_PH(3) RUN_PH(4) RUN_PH(5) RUN_PH(6) RUN_PH(7) RUN_PH(8) RUN_PH(9)
    RUN_PH(10) RUN_PH(11) RUN_PH(12) RUN_PH(13) RUN_PH(14) RUN_PH(15) RUN_PH(16) RUN_PH(17)
#undef RUN_PH
}

extern "C" void kernel_launch(void* const* d_in, const int* in_sizes, int n_in, void* d_out, int out_size, void* d_ws, size_t ws_size, hipStream_t stream) {
    static int grid_blocks = 0;
    if (!grid_blocks) {
        int dev = 0, cus = 0, per_cu = 0;
        hipGetDevice(&dev); hipDeviceGetAttribute(&cus, hipDeviceAttributeMultiprocessorCount, dev);
        hipFuncSetAttribute((const void*)mega, hipFuncAttributeMaxDynamicSharedMemorySize, STAGE_BYTES);
        hipOccupancyMaxActiveBlocksPerMultiprocessor(&per_cu, (const void*)mega, 512, STAGE_BYTES);
        if (per_cu < 1) { fprintf(stderr, "occupancy query says %d blocks/CU\n", per_cu); per_cu = 1; }
        grid_blocks = cus;
        if (ws_size < WS_END) { fprintf(stderr, "workspace too small: %zu < %zu\n", ws_size, (size_t)WS_END); grid_blocks = -1; }
    }
    if (grid_blocks < 0) return;
    if (hipMemsetAsync((char*)d_ws + O_BAR, 0, SZ_BAR, stream) != hipSuccess) { fprintf(stderr, "memset of barrier words failed\n"); return; }
    Params p{};
    const float** pp = (const float**)&p;
    for (int i = 0; i < 25; ++i) pp[i] = (const float*)d_in[i];
    p.out = (float*)d_out; p.ws = (unsigned char*)d_ws;
    int ph0 = 0, ph1 = N_PHASES;
    void* args[] = {&p, &ph0, &ph1};
    hipError_t e = hipLaunchCooperativeKernel((const void*)mega, dim3(grid_blocks), dim3(512), args, STAGE_BYTES, stream);
    if (e != hipSuccess) fprintf(stderr, "cooperative launch failed: %s (grid %d)\n", hipGetErrorString(e), grid_blocks);
}
```

```cpp
#include <hip/hip_runtime.h>
#include <hip/hip_cooperative_groups.h>
#include <cstdio>
namespace cg = cooperative_groups;

#define LAS __attribute__((address_space(3)))
typedef unsigned short bf16_t;
typedef short bf16x8 __attribute__((ext_vector_type(8)));
typedef float f32x4 __attribute__((ext_vector_type(4)));
typedef unsigned u32x4 __attribute__((ext_vector_type(4)));
typedef unsigned u32x2 __attribute__((ext_vector_type(2)));

constexpr int DM = 2048, NB = 2, SEQ = 4096, LCX = 256, MX = NB * SEQ, MCT = NB * LCX, MTOT = MX + MCT;
constexpr int INW = 14336;
constexpr int C_XA = 0, C_BA = 1024, C_CA = 2048, C_ZA = 3072, C_U = 4096, C_ZB = 5120, C_F = 6144, C_ZC = 7168, C_GL = 8192;
constexpr size_t E_PC = 0, E_PU = (size_t)8704 * 4096, E_PZB = E_PU + (size_t)8704 * 1024, E_PF = E_PZB + (size_t)8704 * 1024, E_PZC = E_PF + (size_t)8704 * 1024, E_PGL = E_PZC + (size_t)8704 * 1024;
constexpr int NCOL = 544;
constexpr float RMS_EPS = 1e-6f;

constexpr size_t AL(size_t x) { return (x + 255) & ~(size_t)255; }
constexpr size_t SZ_WIN = (size_t)INW * DM * 2, SZ_P = (size_t)DM * 1024 * 2, SZ_GLU = (size_t)2048 * 1024 * 2, SZ_FW = (size_t)1024 * 1024 * 2,
                 SZ_WP = (size_t)1024 * 2048 * 2, SZ_WO = (size_t)DM * DM * 2, SZ_M1 = (size_t)64 * 256 * 256 * 2, SZ_M2 = (size_t)64 * 256 * 512 * 2,
                 SZ_A16 = (size_t)2 * 64 * 64 * 2 * 4, SZ_MOD = (size_t)3 * 6144 * 4;
constexpr size_t LO_WIN = 0, LO_PA = LO_WIN + SZ_WIN, LO_PB = LO_PA + SZ_P, LO_PC = LO_PB + SZ_P, LO_GLU = LO_PC + SZ_P, LO_FW = LO_GLU + SZ_GLU,
                 LO_WP = LO_FW + SZ_FW, LO_WO = LO_WP + SZ_WP, LO_M1 = LO_WO + SZ_WO, LO_M2 = LO_M1 + SZ_M1, LO_A16 = LO_M2 + SZ_M2, LO_MOD = LO_A16 + SZ_A16,
                 SZ_LAYER = AL(LO_MOD + SZ_MOD);
constexpr size_t O_TAB = 2 * SZ_LAYER;
constexpr size_t T_CS = 0, T_D1 = T_CS + 512 * 256 * 2, T_D2 = T_D1 + 128 * 64 * 2, T_DCTX = T_D2 + 128 * 128 * 2, T_TW = T_DCTX + 512 * 256 * 2, SZ_TAB = AL(T_TW + 64 * 64 * 8);
constexpr size_t O_X1 = O_TAB + SZ_TAB, SZ_X1 = (size_t)MTOT * DM * 4;
constexpr size_t O_HB = O_X1 + SZ_X1, SZ_HB = (size_t)MTOT * DM * 2;
constexpr size_t O_PARTS = O_HB + SZ_HB, SZ_PARTS = (size_t)MTOT * INW * 2;
constexpr size_t O_AB = O_PARTS + SZ_PARTS, SZ_BR = (size_t)MTOT * 1024 * 2;
constexpr size_t O_BB = O_AB + SZ_BR, O_CB = O_BB + SZ_BR, O_GB = O_CB + SZ_BR;
constexpr size_t O_ZB = O_GB + SZ_BR, SZ_ZB = (size_t)2 * 64 * 128 * 1024 * 2;
constexpr size_t O_YB = O_ZB + SZ_ZB, SZ_YB = (size_t)MTOT * 2048 * 2;
constexpr size_t O_EB = O_YB + SZ_YB, SZ_EB = (size_t)64 * NCOL * 256 * 4;
constexpr size_t O_HS = O_EB + SZ_EB, SZ_HS = (size_t)64 * NCOL * 256 * 2;
constexpr size_t O_MP = O_ZB;
constexpr size_t O_BAR = O_HS + SZ_HS, SZ_BAR = 16384;
constexpr size_t WS_END = O_BAR + SZ_BAR;
static_assert(SZ_ZB + SZ_YB + SZ_EB >= (size_t)MTOT * DM * 4, "alias");
static_assert(SZ_PARTS >= (size_t)MTOT * DM * 4, "alias");

struct Params {
    const float *x, *c, *ctx, *c_ctx, *w_ada, *b_ada, *g_pre, *g_post, *w_in, *conv_w, *lam_re, *lam_im, *log_dt, *b_re, *b_im, *c_re, *c_im,
        *ssm_d, *glu_wa, *glu_wb, *fourier_w, *proj_a, *proj_b, *proj_c, *w_out;
    float* out; unsigned char* ws;
};
typedef const __attribute__((address_space(4))) Params* KPtr;
#define PREF const __attribute__((address_space(4))) Params&

__device__ __forceinline__ int tid_opaque() { int t = threadIdx.x; asm volatile("" : "+v"(t)); return t; }
__device__ __forceinline__ int bid_opaque() { int b = blockIdx.x; asm volatile("" : "+s"(b)); return b; }
__device__ __forceinline__ float bf2f(unsigned v) { return __uint_as_float(v << 16); }
__device__ __forceinline__ unsigned cvt_pk_bf16(float lo, float hi) { unsigned r; asm volatile("v_cvt_pk_bf16_f32 %0, %1, %2" : "=v"(r) : "v"(lo), "v"(hi)); return r; }
__device__ __forceinline__ float lo_f(unsigned u) { return __uint_as_float(u << 16); }
__device__ __forceinline__ float hi_f(unsigned u) { return __uint_as_float(u & 0xffff0000u); }
__device__ __forceinline__ float sigmoidf_(float x) { return __builtin_amdgcn_rcpf(1.0f + __expf(-x)); }
__device__ __forceinline__ float siluf_(float x) { return x * __builtin_amdgcn_rcpf(1.0f + __expf(-x)); }
__device__ __forceinline__ float gelu_tanh(float x) { const float z = 0.7978845608028654f * (x + 0.044715f * x * x * x); const float t = 1.0f - 2.0f * __builtin_amdgcn_rcpf(__expf(2.0f * z) + 1.0f); return 0.5f * x * (1.0f + t); }
__device__ __forceinline__ float wave_sum(float v, const int lane) {
#pragma unroll
    for (int o = 32; o; o >>= 1) v += __int_as_float(__builtin_amdgcn_ds_bpermute((lane ^ o) << 2, __float_as_int(v)));
    return v;
}
__device__ __forceinline__ void unpack8(const u32x4 u, float (&f)[8]) {
    f[0] = lo_f(u[0]); f[1] = hi_f(u[0]); f[2] = lo_f(u[1]); f[3] = hi_f(u[1]); f[4] = lo_f(u[2]); f[5] = hi_f(u[2]); f[6] = lo_f(u[3]); f[7] = hi_f(u[3]);
}
__device__ __forceinline__ u32x4 pack8(const float (&f)[8]) { u32x4 r; r[0] = cvt_pk_bf16(f[0], f[1]); r[1] = cvt_pk_bf16(f[2], f[3]); r[2] = cvt_pk_bf16(f[4], f[5]); r[3] = cvt_pk_bf16(f[6], f[7]); return r; }

constexpr int BM = 256, BK = 64, HALF = 128, HTB = HALF * BK * 2, STAGE_BYTES = 8 * HTB;
__device__ __forceinline__ int lds_byte(int r, int c) { const int st = (r >> 4) * 2 + (c >> 5), rr = r & 15, cc = c & 31, ob = rr * 64 + cc * 2; return st * 1024 + (ob ^ (((ob >> 9) & 1) << 5)); }
__device__ __forceinline__ void stage_rc(int b, int& R, int& C) { const int st = b / 1024, sb = b % 1024, swz = sb ^ (((sb >> 9) & 1) << 5); R = (st >> 1) * 16 + swz / 64; C = (st & 1) * 32 + (swz % 64) / 2; }
__device__ __forceinline__ int perm32(int rho) { const int n = rho >> 4, i = rho & 15; return 8 * (i >> 2) + 4 * n + (i & 3); }

struct Unit { const char* A; const char* B; int row0, pn, z, half; };

__device__ __forceinline__ void tile_of(int L, int nM, int nN, int& pm, int& pn) {
    const int nwg = nM * nN; int wgid = L;
    { const int q = nwg / 8, r = nwg % 8, xcd = wgid % 8, off = wgid / 8; wgid = (xcd < r ? xcd * (q + 1) : r * (q + 1) + (xcd - r) * q) + off; }
    const int nig = 8 * nN, gid = wgid / nig, fm = gid * 8, gsz = (nM - fm) < 8 ? (nM - fm) : 8;
    pm = fm + ((wgid % nig) % gsz); pn = (wgid % nig) / gsz;
}

template <class Sched, class Epi>
__device__ __forceinline__ void gemm_phase(LAS unsigned char* lds, const Sched& S, const Epi& E, const int K, const int lda, const int ldb) {
    const int tid = tid_opaque(), wid = __builtin_amdgcn_readfirstlane(tid >> 6), lane = tid & 63, wr = wid >> 2, wc = wid & 3, fr = lane & 15, fq = lane >> 4;
    const int nt = K / BK;
    unsigned voffA[2], voffB[2];
#pragma unroll
    for (int i = 0; i < 2; ++i) { int R, C; stage_rc(tid * 16 + i * 8192, R, C); const int Rb = (R & ~31) + perm32(R & 31);
        voffA[i] = (unsigned)(R * lda + C) * 2u; voffB[i] = (unsigned)(Rb * ldb + C) * 2u; }
    const size_t kstep = (size_t)(BK * 2);
    const size_t hstepA = (size_t)HALF * lda * 2, hstepB = (size_t)HALF * ldb * 2;
    const unsigned ldsw = (unsigned)wid * 1024u;
    const int aoff = lds_byte(wr * 64 + fr, fq * 8), boff = lds_byte(wc * 32 + fr, fq * 8);
#define PG8_SA(b, h) (((b) * 2 + (h)) * HTB)
#define PG8_SB(b, h) ((4 + (b) * 2 + (h)) * HTB)
#define PG8_STAGE(bufoff, gbase, voff) do { _Pragma("unroll") for (int _i = 0; _i < 2; ++_i) \
        __builtin_amdgcn_global_load_lds((const unsigned*)((const char*)(gbase) + (voff)[_i]), (LAS unsigned*)(lds + (bufoff) + ldsw + _i * 8192), 16, 0, 0); } while (0)
#define PG8_LDA(dst, b, h) do { _Pragma("unroll") for (int m = 0; m < 4; ++m) _Pragma("unroll") for (int k = 0; k < 2; ++k) dst[m][k] = *(const LAS bf16x8*)(lds + PG8_SA(b, h) + aoff + m * 2048 + k * 1024); } while (0)
#define PG8_LDB(dst, b, h) do { _Pragma("unroll") for (int n = 0; n < 2; ++n) _Pragma("unroll") for (int k = 0; k < 2; ++k) dst[n][k] = *(const LAS bf16x8*)(lds + PG8_SB(b, h) + boff + n * 2048 + k * 1024); } while (0)
#define PG8_MMA(ai, bj, At, Bt) do { __builtin_amdgcn_s_setprio(1); _Pragma("unroll") for (int m = 0; m < 4; ++m) _Pragma("unroll") for (int n = 0; n < 2; ++n) _Pragma("unroll") for (int k = 0; k < 2; ++k) \
        acc[ai][bj][m][n] = __builtin_amdgcn_mfma_f32_16x16x32_bf16(Bt[n][k], At[m][k], acc[ai][bj][m][n], 0, 0, 0); __builtin_amdgcn_s_setprio(0); } while (0)
#define PG8_WAIT_V(n) asm volatile("s_waitcnt vmcnt(" #n ")" ::: "memory")
#define PG8_WAIT_L(n) asm volatile("s_waitcnt lgkmcnt(" #n ")" ::: "memory")
#define PG8_BAR __builtin_amdgcn_s_barrier()
#define PG8_SCHED __builtin_amdgcn_sched_barrier(0)
    Unit cur, nxt; int ui = 0;
    if (!S.next(0, cur)) return;
    f32x4 acc[2][2][4][2];
#pragma unroll
    for (int a = 0; a < 2; ++a)
#pragma unroll
        for (int b = 0; b < 2; ++b)
#pragma unroll
            for (int m = 0; m < 4; ++m)
#pragma unroll
                for (int n = 0; n < 2; ++n) acc[a][b][m][n] = (f32x4){0.f, 0.f, 0.f, 0.f};
    bf16x8 At[4][2], B0[2][2], B1[2][2];
    const char* cA = cur.A; const char* cB = cur.B;
    PG8_STAGE(PG8_SB(0, 0), cB, voffB); PG8_STAGE(PG8_SA(0, 0), cA, voffA); PG8_STAGE(PG8_SB(0, 1), cB + hstepB, voffB); PG8_STAGE(PG8_SA(0, 1), cA + hstepA, voffA);
    if (wr == 1) PG8_BAR;
    PG8_WAIT_V(4); PG8_BAR;
    PG8_STAGE(PG8_SB(1, 0), cB + kstep, voffB); PG8_STAGE(PG8_SA(1, 0), cA + kstep, voffA); PG8_STAGE(PG8_SB(1, 1), cB + hstepB + kstep, voffB);
    PG8_WAIT_V(6); PG8_BAR;
    for (;;) {
        const bool has_next = S.next(ui + 1, nxt);
        const char* nA = has_next ? nxt.A : cA; const char* nB = has_next ? nxt.B : cB;
        const bool chalf = cur.half != 0;
        for (int t = 0; t < nt; t += 2) {
            const bool last = (t == nt - 2);
            const char* a1 = cA + (size_t)(t + 1) * kstep;
            const char* a2 = last ? nA : cA + (size_t)(t + 2) * kstep; const char* b2 = last ? nB : cB + (size_t)(t + 2) * kstep;
            const char* a3 = a2 + kstep; const char* b3 = b2 + kstep;
            PG8_LDB(B0, 0, 0); PG8_SCHED; PG8_LDA(At, 0, 0); PG8_STAGE(PG8_SA(1, 1), a1 + hstepA, voffA);
            PG8_WAIT_L(8); PG8_BAR; PG8_WAIT_L(0); PG8_MMA(0, 0, At, B0); PG8_BAR; PG8_SCHED;
            PG8_LDB(B1, 0, 1); PG8_STAGE(PG8_SB(0, 0), b2, voffB);
            PG8_BAR; PG8_WAIT_L(0); PG8_MMA(0, 1, At, B1); PG8_BAR;
            PG8_LDA(At, 0, 1); PG8_STAGE(PG8_SA(0, 0), a2, voffA);
            PG8_BAR; PG8_WAIT_L(0); if (!chalf) PG8_MMA(1, 0, At, B0); PG8_BAR; PG8_SCHED;
            PG8_STAGE(PG8_SB(0, 1), b2 + hstepB, voffB);
            PG8_WAIT_V(6); PG8_BAR; if (!chalf) PG8_MMA(1, 1, At, B1); PG8_BAR;
            PG8_LDB(B0, 1, 0); PG8_SCHED; PG8_LDA(At, 1, 0); PG8_STAGE(PG8_SA(0, 1), a2 + hstepA, voffA);
            PG8_WAIT_L(8); PG8_BAR; PG8_WAIT_L(0); PG8_MMA(0, 0, At, B0); PG8_BAR; PG8_SCHED;
            PG8_LDB(B1, 1, 1); PG8_STAGE(PG8_SB(1, 0), b3, voffB);
            PG8_BAR; PG8_WAIT_L(0); PG8_MMA(0, 1, At, B1); PG8_BAR;
            PG8_LDA(At, 1, 1); PG8_STAGE(PG8_SA(1, 0), a3, voffA);
            PG8_BAR; PG8_WAIT_L(0); if (!chalf) PG8_MMA(1, 0, At, B0); PG8_BAR; PG8_SCHED;
            PG8_STAGE(PG8_SB(1, 1), b3 + hstepB, voffB);
            PG8_WAIT_V(6); PG8_BAR; if (!chalf) PG8_MMA(1, 1, At, B1); PG8_BAR;
        }
        E(acc, cur, wr, wc, fr, fq);
        if (!has_next) break;
#pragma unroll
        for (int a = 0; a < 2; ++a)
#pragma unroll
            for (int b = 0; b < 2; ++b)
#pragma unroll
                for (int m = 0; m < 4; ++m)
#pragma unroll
                    for (int n = 0; n < 2; ++n) acc[a][b][m][n] = (f32x4){0.f, 0.f, 0.f, 0.f};
        cur = nxt; cA = nA; cB = nB; ++ui;
    }
    PG8_WAIT_V(0);
    if (wr == 0) PG8_BAR;
    PG8_BAR;
#undef PG8_SA
#undef PG8_SB
#undef PG8_STAGE
#undef PG8_LDA
#undef PG8_LDB
#undef PG8_MMA
#undef PG8_WAIT_V
#undef PG8_WAIT_L
#undef PG8_BAR
#undef PG8_SCHED
}

typedef f32x4 AccT[2][2][4][2];
#define EPI_ARGS const AccT& acc, const Unit& u, int wr, int wc, int fr, int fq
#define EPI_FOR_ROWS _Pragma("unroll") for (int ai = 0; ai < 2; ++ai) if (ai == 0 || !u.half) _Pragma("unroll") for (int m = 0; m < 4; ++m)
#define EPI_ROW (u.row0 + wr * 64 + fr + ai * 128 + m * 16)
#define EPI_COL(bj) (u.pn * 256 + wc * 32 + 8 * fq + (bj) * 128)

struct SchedGrid {
    const char* A; const char* B; int nM, nN, lda, ldb, G, c, nh, hrow0, cnt;
    __device__ __forceinline__ bool next(int i, Unit& u) const {
        const long L = (long)i * G + c; const int nfull = nM * nN; if (i >= cnt || L >= (long)nfull + nh * nN) return false;
        int pm;
        if (L < nfull) { tile_of((int)L, nM, nN, pm, u.pn); u.row0 = pm * 256; u.half = 0; }
        else { const int e = (int)L - nfull; u.pn = e % nN; u.row0 = hrow0 + (e / nN) * 128; u.half = 1; }
        u.z = 0; u.A = A + (size_t)u.row0 * lda * 2; u.B = B + (size_t)u.pn * 256 * ldb * 2; return true;
    }
};
struct SchedMerge {
    const char* A0; const char* B0; int nM, G, c, nh, hrow0;
    __device__ __forceinline__ bool next(int i, Unit& u) const {
        const int j = i / 3, br = i - 3 * j; const long L = (long)j * G + c; const int nfull = nM * 8; if (L >= (long)nfull + nh * 8) return false;
        int pm;
        if (L < nfull) { tile_of((int)L, nM, 8, pm, u.pn); u.row0 = pm * 256; u.half = 0; }
        else { const int e = (int)L - nfull; u.pn = e & 7; u.row0 = hrow0 + (e >> 3) * 128; u.half = 1; }
        u.z = br;
        u.A = A0 + (size_t)br * SZ_BR + (size_t)u.row0 * 1024 * 2; u.B = B0 + (size_t)br * SZ_P + (size_t)u.pn * 256 * 1024 * 2; return true;
    }
};
struct SchedWp {
    const unsigned char* ws; int G, c;
    __device__ __forceinline__ bool next(int i, Unit& u) const {
        const long L = (long)i * G + c; if (L >= 64) return false;
        const int l = (int)L >> 5, grp = ((int)L >> 3) & 3, pm = ((int)L >> 1) & 3; u.row0 = pm * 256; u.half = 0; u.pn = (int)L & 1; u.z = l * 4 + grp;
        u.A = (const char*)ws + l * SZ_LAYER + LO_FW + ((size_t)pm * 256 * 1024 + grp * 256) * 2;
        u.B = (const char*)ws + O_TAB + T_CS + (size_t)u.pn * 256 * 256 * 2; return true;
    }
};

struct EpiStoreBf16 { bf16_t* O; int ldc;
    __device__ __forceinline__ void operator()(EPI_ARGS) const {
        EPI_FOR_ROWS { bf16_t* rp = O + (size_t)EPI_ROW * ldc;
#pragma unroll
            for (int bj = 0; bj < 2; ++bj) { const f32x4 v0 = acc[ai][bj][m][0], v1 = acc[ai][bj][m][1]; u32x4 o;
                o[0] = cvt_pk_bf16(v0[0], v0[1]); o[1] = cvt_pk_bf16(v0[2], v0[3]); o[2] = cvt_pk_bf16(v1[0], v1[1]); o[3] = cvt_pk_bf16(v1[2], v1[3]);
                *(u32x4*)(rp + EPI_COL(bj)) = o; } }
    }
};
struct EpiParts { bf16_t* O;
    __device__ __forceinline__ void operator()(EPI_ARGS) const {
        const int c0 = u.pn * 256; size_t eb; int pitch, cl;
        if (c0 < C_U) { eb = E_PC; pitch = 4096; cl = c0; } else if (c0 < C_ZB) { eb = E_PU; pitch = 1024; cl = c0 - C_U; } else if (c0 < C_F) { eb = E_PZB; pitch = 1024; cl = c0 - C_ZB; }
        else if (c0 < C_ZC) { eb = E_PF; pitch = 1024; cl = c0 - C_F; } else if (c0 < C_GL) { eb = E_PZC; pitch = 1024; cl = c0 - C_ZC; } else { eb = E_PGL; pitch = 6144; cl = c0 - C_GL; }
        bf16_t* base = O + eb + cl + wc * 32 + 8 * fq;
        EPI_FOR_ROWS { bf16_t* rp = base + (size_t)EPI_ROW * pitch;
#pragma unroll
            for (int bj = 0; bj < 2; ++bj) { const f32x4 v0 = acc[ai][bj][m][0], v1 = acc[ai][bj][m][1]; u32x4 o;
                o[0] = cvt_pk_bf16(v0[0], v0[1]); o[1] = cvt_pk_bf16(v0[2], v0[3]); o[2] = cvt_pk_bf16(v1[0], v1[1]); o[3] = cvt_pk_bf16(v1[2], v1[3]);
                *(u32x4*)(rp + bj * 128) = o; } }
    }
};
struct EpiStoreF32 { float* O; int ldc;
    __device__ __forceinline__ void operator()(EPI_ARGS) const {
        EPI_FOR_ROWS { float* rp = O + (size_t)EPI_ROW * ldc;
#pragma unroll
            for (int bj = 0; bj < 2; ++bj) { *(f32x4*)(rp + EPI_COL(bj)) = acc[ai][bj][m][0]; *(f32x4*)(rp + EPI_COL(bj) + 4) = acc[ai][bj][m][1]; } }
    }
};
struct EpiWp { unsigned char* ws;
    __device__ __forceinline__ void operator()(EPI_ARGS) const {
        const int l = u.z >> 2, grp = u.z & 3; bf16_t* O = (bf16_t*)(ws + l * SZ_LAYER + LO_WP);
        EPI_FOR_ROWS { bf16_t* rp = O + (size_t)EPI_ROW * 2048 + u.pn * 1024 + grp * 256;
#pragma unroll
            for (int bj = 0; bj < 2; ++bj) { const f32x4 v0 = acc[ai][bj][m][0], v1 = acc[ai][bj][m][1]; u32x4 o;
                o[0] = cvt_pk_bf16(v0[0], v0[1]); o[1] = cvt_pk_bf16(v0[2], v0[3]); o[2] = cvt_pk_bf16(v1[0], v1[1]); o[3] = cvt_pk_bf16(v1[2], v1[3]);
                *(u32x4*)(rp + wc * 32 + 8 * fq + bj * 128) = o; } }
    }
};
struct EpiFourier { const bf16_t* parts; bf16_t* O;
    __device__ __forceinline__ void operator()(EPI_ARGS) const {
#pragma unroll
        for (int ai = 0; ai < 2; ++ai) if (ai == 0 || !u.half) { u32x4 zz[4][2];
#pragma unroll
            for (int m = 0; m < 4; ++m)
#pragma unroll
                for (int bj = 0; bj < 2; ++bj) zz[m][bj] = *(const u32x4*)(parts + E_PZC + (size_t)EPI_ROW * 1024 + EPI_COL(bj));
#pragma unroll
            for (int m = 0; m < 4; ++m)
#pragma unroll
                for (int bj = 0; bj < 2; ++bj) { const f32x4 v0 = acc[ai][bj][m][0], v1 = acc[ai][bj][m][1]; float z[8]; unpack8(zz[m][bj], z); float o[8];
#pragma unroll
                    for (int j = 0; j < 4; ++j) { o[j] = v0[j] * siluf_(z[j]); o[4 + j] = v1[j] * siluf_(z[4 + j]); }
                    *(u32x4*)(O + (size_t)EPI_ROW * 1024 + EPI_COL(bj)) = pack8(o); } }
    }
};
struct EpiGlu { const bf16_t* parts; bf16_t* O;
    __device__ __forceinline__ void operator()(EPI_ARGS) const {
        const int col = u.pn * 128 + wc * 32 + 8 * fq;
#pragma unroll
        for (int ai = 0; ai < 2; ++ai) if (ai == 0 || !u.half) { u32x4 zz[4];
#pragma unroll
            for (int m = 0; m < 4; ++m) zz[m] = *(const u32x4*)(parts + E_PZB + (size_t)EPI_ROW * 1024 + col);
#pragma unroll
            for (int m = 0; m < 4; ++m) { float z[8]; unpack8(zz[m], z);
                const f32x4 a0 = acc[ai][0][m][0], a1 = acc[ai][0][m][1], b0 = acc[ai][1][m][0], b1 = acc[ai][1][m][1]; float o[8];
#pragma unroll
                for (int j = 0; j < 4; ++j) { o[j] = a0[j] * z[j] * __builtin_amdgcn_rcpf((1.0f + __expf(-b0[j])) * (1.0f + __expf(-z[j]))); o[4 + j] = a1[j] * z[4 + j] * __builtin_amdgcn_rcpf((1.0f + __expf(-b1[j])) * (1.0f + __expf(-z[4 + j]))); }
                *(u32x4*)(O + (size_t)EPI_ROW * 1024 + col) = pack8(o); } }
    }
};
struct EpiMerge { const bf16_t* parts; bf16_t* MB;
    __device__ __forceinline__ void operator()(EPI_ARGS) const {
        const int br = u.z; const int nb = u.half ? 2 : 4;
        u32x4 gg[2][4], pp[2][4];
#define MRG_LOAD(slot, bidx_) { const int ai = (bidx_) >> 1, bj = (bidx_) & 1; _Pragma("unroll") for (int m = 0; m < 4; ++m) { \
            gg[slot][m] = *(const u32x4*)(parts + E_PGL + (size_t)EPI_ROW * 6144 + br * DM + EPI_COL(bj)); \
            pp[slot][m] = br > 0 ? *(const u32x4*)(MB + (size_t)EPI_ROW * DM + EPI_COL(bj)) : (u32x4){0u, 0u, 0u, 0u}; } }
#define MRG_EMIT(slot, bidx_) { const int ai = (bidx_) >> 1, bj = (bidx_) & 1; _Pragma("unroll") for (int m = 0; m < 4; ++m) { \
            const f32x4 v0 = acc[ai][bj][m][0], v1 = acc[ai][bj][m][1]; float g[8], pv[8], o[8]; unpack8(gg[slot][m], g); unpack8(pp[slot][m], pv); \
            _Pragma("unroll") for (int j = 0; j < 4; ++j) { o[j] = v0[j] * sigmoidf_(g[j]) + pv[j]; o[4 + j] = v1[j] * sigmoidf_(g[4 + j]) + pv[4 + j]; } \
            *(u32x4*)(MB + (size_t)EPI_ROW * DM + EPI_COL(bj)) = pack8(o); } }
        MRG_LOAD(0, 0)
        MRG_LOAD(1, 1)
        MRG_EMIT(0, 0)
        if (nb > 2) MRG_LOAD(0, 2)
        MRG_EMIT(1, 1)
        if (nb > 2) { MRG_LOAD(1, 3) MRG_EMIT(0, 2) MRG_EMIT(1, 3) }
#undef MRG_LOAD
#undef MRG_EMIT
    }
};

template <int MTL, int NT, class BL>
__device__ __forceinline__ void lmul_core(const bf16_t* __restrict__ D, const int ldd, const int ksteps, const BL& bl, f32x4 (&acc)[MTL][NT], const int lane) {
    const int r = lane & 15, q = lane >> 4;
    const bf16_t* dp = D + (size_t)r * ldd + q * 8;
#pragma unroll
    for (int a = 0; a < MTL; ++a)
#pragma unroll
        for (int b = 0; b < NT; ++b) acc[a][b] = (f32x4){0.f, 0.f, 0.f, 0.f};
#pragma unroll 1
    for (int ks = 0; ks < ksteps; ++ks) {
        bf16x8 bf[NT];
#pragma unroll
        for (int b = 0; b < NT; ++b) bf[b] = bl(ks, b);
#pragma unroll
        for (int a = 0; a < MTL; ++a) { const bf16x8 af = *(const bf16x8*)(dp + (size_t)a * 16 * ldd + ks * 32);
#pragma unroll
            for (int b = 0; b < NT; ++b) acc[a][b] = __builtin_amdgcn_mfma_f32_16x16x32_bf16(af, bf[b], acc[a][b], 0, 0, 0); }
    }
}
template <int MTL>
__device__ __forceinline__ void lmul_g4(const bf16_t* __restrict__ D, const int ldd, const int ksteps, const bf16_t* __restrict__ base, const size_t rs, f32x4 (&acc)[MTL][4], const int lane) {
    const int r = lane & 15, q = lane >> 4;
    const bf16_t* dp = D + (size_t)r * ldd + q * 8;
#pragma unroll
    for (int a = 0; a < MTL; ++a)
#pragma unroll
        for (int b = 0; b < 4; ++b) acc[a][b] = (f32x4){0.f, 0.f, 0.f, 0.f};
    u32x2 w[8];
    { const bf16_t* p = base + (size_t)(q * 8) * rs;
#pragma unroll
      for (int j = 0; j < 8; ++j) w[j] = *(const u32x2*)(p + (size_t)j * rs); }
#pragma unroll 1
    for (int ks = 0; ks < ksteps; ++ks) {
        u32x2 wn[8];
        if (ks + 1 < ksteps) { const bf16_t* p = base + (size_t)((ks + 1) * 32 + q * 8) * rs;
#pragma unroll
            for (int j = 0; j < 8; ++j) wn[j] = *(const u32x2*)(p + (size_t)j * rs); }
        else {
#pragma unroll
            for (int j = 0; j < 8; ++j) wn[j] = w[j]; }
        union { bf16x8 v; unsigned d[4]; } f0, f1, f2, f3;
#pragma unroll
        for (int d = 0; d < 4; ++d) { const unsigned a0 = w[2 * d][0], a1 = w[2 * d + 1][0], c0 = w[2 * d][1], c1 = w[2 * d + 1][1];
            f0.d[d] = (a0 & 0xffffu) | (a1 << 16); f1.d[d] = (a0 >> 16) | (a1 & 0xffff0000u); f2.d[d] = (c0 & 0xffffu) | (c1 << 16); f3.d[d] = (c0 >> 16) | (c1 & 0xffff0000u); }
#pragma unroll
        for (int a = 0; a < MTL; ++a) { const bf16x8 af = *(const bf16x8*)(dp + (size_t)a * 16 * ldd + ks * 32);
            acc[a][0] = __builtin_amdgcn_mfma_f32_16x16x32_bf16(af, f0.v, acc[a][0], 0, 0, 0); acc[a][1] = __builtin_amdgcn_mfma_f32_16x16x32_bf16(af, f1.v, acc[a][1], 0, 0, 0);
            acc[a][2] = __builtin_amdgcn_mfma_f32_16x16x32_bf16(af, f2.v, acc[a][2], 0, 0, 0); acc[a][3] = __builtin_amdgcn_mfma_f32_16x16x32_bf16(af, f3.v, acc[a][3], 0, 0, 0); }
#pragma unroll
        for (int j = 0; j < 8; ++j) w[j] = wn[j];
    }
}
struct BLGather { const bf16_t* base; size_t rs; int lane;
    __device__ __forceinline__ bf16x8 operator()(int ks, int b) const {
        const int q = lane >> 4; const bf16_t* p = base + (size_t)(ks * 32 + q * 8) * rs + b * 16; bf16x8 v;
#pragma unroll
        for (int j = 0; j < 8; ++j) v[j] = (short)p[(size_t)j * rs];
        return v; }
};
__device__ __forceinline__ int ssm_row(int col, int s) { return col < 512 ? ((col >> 8) * SEQ + (col & 255) * 16 + s) : (MX + ((col - 512) >> 4) * LCX + ((col - 512) & 15) * 16 + s); }
template <int KW, bool YST>
__device__ __forceinline__ void ssm_stage_lds(PREF P, const int l, const int wi, unsigned char* shm, const int tid) {
    const int lane = tid & 63, wv = tid >> 6, r = lane & 15, q = lane >> 4;
    const int g = wi >> 2, mh = (wi >> 1) & 1, half = wi & 1;
    unsigned char* wl = P.ws + l * SZ_LAYER; const bf16_t* parts = (const bf16_t*)(P.ws + O_PARTS);
    const bf16_t* D = (const bf16_t*)(wl + (YST ? LO_M2 : LO_M1)) + ((size_t)g * 256 + mh * 128) * KW;
    LAS unsigned char* lds = (LAS unsigned char*)shm;
    constexpr int CPR = KW / 8, KS = KW / 32;
    for (int ch = tid; ch < 128 * CPR; ch += 512) { const int row = ch / CPR, c = ch % CPR; const u32x4 v = *(const u32x4*)(D + (size_t)row * KW + c * 8);
        *(LAS u32x4*)(lds + row * (KW * 2) + ((c ^ (row & 15)) << 4)) = v; }
    __syncthreads();
    const int nct = (YST && l == 1) ? 16 : 17, hsplit = (nct + 1) / 2;
    const int t0 = half == 0 ? 0 : hsplit, t1 = half == 0 ? hsplit : nct;
    const bf16_t* HS = (const bf16_t*)(P.ws + O_HS);
    for (int ct = t0 + wv; ct < t1; ct += 8) {
        f32x4 acc[8][2];
#pragma unroll
        for (int a = 0; a < 8; ++a) { acc[a][0] = (f32x4){0.f, 0.f, 0.f, 0.f}; acc[a][1] = (f32x4){0.f, 0.f, 0.f, 0.f}; }
        const int colA = ct * 32 + r, colB = colA + 16;
        const bf16_t* pu0 = parts + E_PU + (size_t)(ssm_row(colA, 0) + (q >> 1)) * 1024 + g * 16 + (q & 1) * 8;
        const bf16_t* pu1 = parts + E_PU + (size_t)(ssm_row(colB, 0) + (q >> 1)) * 1024 + g * 16 + (q & 1) * 8;
        const bf16_t* ph0 = HS + ((size_t)g * NCOL + colA) * 256 + q * 8; const bf16_t* ph1 = HS + ((size_t)g * NCOL + colB) * 256 + q * 8;
#pragma unroll
        for (int kh = 0; kh < KS / 8; ++kh) {
            bf16x8 bq[8][2];
#pragma unroll
            for (int k8 = 0; k8 < 8; ++k8) {
                if (kh == 0) { bq[k8][0] = *(const bf16x8*)(pu0 + (size_t)k8 * 2 * 1024); bq[k8][1] = *(const bf16x8*)(pu1 + (size_t)k8 * 2 * 1024); }
                else { bq[k8][0] = *(const bf16x8*)(ph0 + k8 * 32); bq[k8][1] = *(const bf16x8*)(ph1 + k8 * 32); } }
#pragma unroll
            for (int k8 = 0; k8 < 8; ++k8) { const int ks = kh * 8 + k8;
                __builtin_amdgcn_sched_barrier(0);
#pragma unroll
                for (int a = 0; a < 8; ++a) { const bf16x8 af = *(const LAS bf16x8*)(lds + (a * 16 + r) * (KW * 2) + (((ks * 4 + q) ^ r) << 4));
                    acc[a][0] = __builtin_amdgcn_mfma_f32_16x16x32_bf16(af, bq[k8][0], acc[a][0], 0, 0, 0); acc[a][1] = __builtin_amdgcn_mfma_f32_16x16x32_bf16(af, bq[k8][1], acc[a][1], 0, 0, 0); }
            }
            __builtin_amdgcn_sched_barrier(0);
        }
        if (!YST) { float* EB = (float*)(P.ws + O_EB);
#pragma unroll
            for (int a = 0; a < 8; ++a)
#pragma unroll
                for (int b = 0; b < 2; ++b) { const int col = ct * 32 + b * 16 + r; *(f32x4*)(EB + ((size_t)g * NCOL + col) * 256 + mh * 128 + a * 16 + q * 4) = acc[a][b]; }
        } else { bf16_t* GB = (bf16_t*)(P.ws + O_GB); const f32x4 dv = *(const f32x4*)(P.ssm_d + l * 1024 + g * 16 + q * 4);
            u32x2 uq[8][2];
#pragma unroll
            for (int a = 0; a < 8; ++a)
#pragma unroll
                for (int b = 0; b < 2; ++b) { const int col = ct * 32 + b * 16 + r, t = mh * 8 + a, row = ssm_row(col, t); uq[a][b] = *(const u32x2*)(parts + E_PU + (size_t)row * 1024 + g * 16 + q * 4); }
#pragma unroll
            for (int a = 0; a < 8; ++a)
#pragma unroll
                for (int b = 0; b < 2; ++b) { const int col = ct * 32 + b * 16 + r, t = mh * 8 + a, row = ssm_row(col, t);
                    const u32x2 uu = uq[a][b];
                    const float y0 = gelu_tanh(acc[a][b][0] + dv[0] * lo_f(uu[0])), y1 = gelu_tanh(acc[a][b][1] + dv[1] * hi_f(uu[0])), y2 = gelu_tanh(acc[a][b][2] + dv[2] * lo_f(uu[1])), y3 = gelu_tanh(acc[a][b][3] + dv[3] * hi_f(uu[1]));
                    u32x2 o; o[0] = cvt_pk_bf16(y0, y1); o[1] = cvt_pk_bf16(y2, y3); *(u32x2*)(GB + (size_t)row * 1024 + g * 16 + q * 4) = o; }
        }
    }
    __syncthreads();
}


template <int MODE>
__device__ __forceinline__ void ctx_small_gemm(PREF P, unsigned char* shm) {
    constexpr int K = MODE >= 2 ? 2048 : 1024, ROWS = MODE >= 2 ? 32 : 64, CPR = K / 8, KS = K / 32, NBR = MODE == 1 ? 3 : 1;
    const int tid = tid_opaque(), bidx = bid_opaque(), lane = tid & 63, w = tid >> 6, r = lane & 15, q = lane >> 4;
    unsigned char* wl = P.ws; const bf16_t* parts = (const bf16_t*)(P.ws + O_PARTS); LAS unsigned char* lds = (LAS unsigned char*)shm;
    for (int it = bidx; it < 256; it += gridDim.x) {
        const int rb = MODE >= 2 ? (it >> 4) : (it >> 5), cb = MODE >= 2 ? (it & 15) : (it & 31);
        const int row_base = MX + rb * ROWS;
        const int rt0 = MODE == 0 ? (w >> 1) : (MODE == 1 ? 2 * (w >> 2) : (MODE == 2 ? 0 : (w >> 2))), rt1 = (MODE == 0 || MODE == 3) ? rt0 : rt0 + 1;
        const int col0 = MODE == 0 ? cb * 32 + (w & 1) * 16 : (MODE == 1 ? cb * 64 + (w & 3) * 16 : (MODE == 2 ? cb * 128 + w * 16 : cb * 64 + (w & 3) * 16));
        float msum[2][4];
#pragma unroll
        for (int t = 0; t < 2; ++t)
#pragma unroll
            for (int i = 0; i < 4; ++i) msum[t][i] = 0.f;
#pragma unroll 1
        for (int br = 0; br < NBR; ++br) {
            const bf16_t* Asrc = MODE == 0 ? (const bf16_t*)(P.ws + O_GB) : (MODE == 1 ? (const bf16_t*)(P.ws + O_AB + (size_t)br * SZ_BR) : (MODE == 2 ? (const bf16_t*)(P.ws + O_HB) : (const bf16_t*)(P.ws + O_YB)));
            for (int ch = tid; ch < ROWS * CPR; ch += 512) { const int row = ch / CPR, c = ch % CPR; const u32x4 v = *(const u32x4*)(Asrc + (size_t)(row_base + row) * K + c * 8);
                *(LAS u32x4*)(lds + row * (K * 2) + ((c ^ (row & 15)) << 4)) = v; }
            __syncthreads();
            const bf16_t* W0; const bf16_t* W1;
            if (MODE == 0) { const int oc = col0 + r; W0 = (const bf16_t*)(wl + LO_GLU) + (size_t)((oc >> 7) * 256 + (oc & 127)) * K + q * 8; W1 = W0 + (size_t)128 * K; }
            else if (MODE == 1) { W0 = (const bf16_t*)(wl + LO_PA + (size_t)br * SZ_P) + (size_t)(col0 + r) * K + q * 8; W1 = W0; }
            else if (MODE == 2) { W0 = (const bf16_t*)(wl + LO_WO) + (size_t)(col0 + r) * K + q * 8; W1 = W0; }
            else { W0 = (const bf16_t*)(wl + LO_WP) + (size_t)(col0 + r) * K + q * 8; W1 = W0; }
            f32x4 acc0 = (f32x4){0.f, 0.f, 0.f, 0.f}, acc1 = (f32x4){0.f, 0.f, 0.f, 0.f};
#pragma unroll 4
            for (int ks = 0; ks < KS; ++ks) {
                const bf16x8 a0 = *(const LAS bf16x8*)(lds + (rt0 * 16 + r) * (K * 2) + (((ks * 4 + q) ^ r) << 4));
                const bf16x8 b0 = *(const bf16x8*)(W0 + ks * 32);
                if (MODE == 0) { const bf16x8 b1 = *(const bf16x8*)(W1 + ks * 32);
                    acc0 = __builtin_amdgcn_mfma_f32_16x16x32_bf16(a0, b0, acc0, 0, 0, 0); acc1 = __builtin_amdgcn_mfma_f32_16x16x32_bf16(a0, b1, acc1, 0, 0, 0); }
                else if (MODE == 3) { acc0 = __builtin_amdgcn_mfma_f32_16x16x32_bf16(a0, b0, acc0, 0, 0, 0); }
                else { const bf16x8 a1 = *(const LAS bf16x8*)(lds + (rt1 * 16 + r) * (K * 2) + (((ks * 4 + q) ^ r) << 4));
                    acc0 = __builtin_amdgcn_mfma_f32_16x16x32_bf16(a0, b0, acc0, 0, 0, 0); acc1 = __builtin_amdgcn_mfma_f32_16x16x32_bf16(a1, b0, acc1, 0, 0, 0); }
            }
            const int col = col0 + r;
            if (MODE == 0) { bf16_t* BBo = (bf16_t*)(P.ws + O_BB); float zq[4];
#pragma unroll
                for (int i = 0; i < 4; ++i) { const int row = row_base + rt0 * 16 + q * 4 + i; zq[i] = bf2f(parts[E_PZB + (size_t)row * 1024 + col]); }
#pragma unroll
                for (int i = 0; i < 4; ++i) { const int row = row_base + rt0 * 16 + q * 4 + i; const float z = zq[i];
                    BBo[(size_t)row * 1024 + col] = (bf16_t)(cvt_pk_bf16(acc0[i] * sigmoidf_(acc1[i]) * siluf_(z), 0.f) & 0xffffu); }
            } else if (MODE == 1) {
#pragma unroll
                for (int i = 0; i < 4; ++i) { const int rowa = row_base + rt0 * 16 + q * 4 + i, rowb = row_base + rt1 * 16 + q * 4 + i;
                    msum[0][i] += acc0[i] * sigmoidf_(bf2f(parts[E_PGL + (size_t)rowa * 6144 + br * DM + col])); msum[1][i] += acc1[i] * sigmoidf_(bf2f(parts[E_PGL + (size_t)rowb * 6144 + br * DM + col])); }
            } else if (MODE == 3) { bf16_t* CBo = (bf16_t*)(P.ws + O_CB); float zq3[4];
#pragma unroll
                for (int i = 0; i < 4; ++i) { const int row = row_base + rt0 * 16 + q * 4 + i; zq3[i] = bf2f(parts[E_PZC + (size_t)row * 1024 + col]); }
#pragma unroll
                for (int i = 0; i < 4; ++i) { const int row = row_base + rt0 * 16 + q * 4 + i; const float z = zq3[i];
                    CBo[(size_t)row * 1024 + col] = (bf16_t)(cvt_pk_bf16(acc0[i] * siluf_(z), 0.f) & 0xffffu); }
            } else { bf16_t* OBo = (bf16_t*)(P.ws + O_PARTS);
#pragma unroll
                for (int i = 0; i < 4; ++i) { const int rowa = row_base + rt0 * 16 + q * 4 + i, rowb = row_base + rt1 * 16 + q * 4 + i;
                    OBo[(size_t)rowa * DM + col] = (bf16_t)(cvt_pk_bf16(acc0[i], 0.f) & 0xffffu); OBo[(size_t)rowb * DM + col] = (bf16_t)(cvt_pk_bf16(acc1[i], 0.f) & 0xffffu); }
            }
            __syncthreads();
        }
        if (MODE == 1) { bf16_t* MBo = (bf16_t*)(P.ws + O_HB); const int col = col0 + r;
#pragma unroll
            for (int i = 0; i < 4; ++i) { const int rowa = row_base + rt0 * 16 + q * 4 + i, rowb = row_base + rt1 * 16 + q * 4 + i;
                MBo[(size_t)rowa * DM + col] = (bf16_t)(cvt_pk_bf16(msum[0][i], 0.f) & 0xffffu); MBo[(size_t)rowb * DM + col] = (bf16_t)(cvt_pk_bf16(msum[1][i], 0.f) & 0xffffu); }
        }
    }
}

struct TileJob { const float* src; bf16_t* dst; int N, K, k0, n0, drow0; };
constexpr int TILES_PER_LAYER = 4736 + 512;
__device__ __forceinline__ TileJob tile_job(PREF P, int gt) {
    const int l = gt / TILES_PER_LAYER, tt = gt - l * TILES_PER_LAYER; unsigned char* wl = P.ws + l * SZ_LAYER; TileJob J; int kt, nt;
    if (tt < 3584) { J.src = P.w_in + (size_t)l * DM * INW; J.dst = (bf16_t*)(wl + LO_WIN); J.K = DM; J.N = INW; kt = tt & 15; nt = tt >> 4; J.drow0 = nt * 64; }
    else if (tt < 3584 + 768) { const int e = tt - 3584, w = e >> 8, f = e & 255; J.src = (w == 0 ? P.proj_a : (w == 1 ? P.proj_b : P.proj_c)) + (size_t)l * 1024 * DM;
        J.dst = (bf16_t*)(wl + LO_PA + (size_t)w * SZ_P); J.K = 1024; J.N = DM; kt = f & 7; nt = f >> 3; J.drow0 = nt * 64; }
    else if (tt < 4352 + 256) { const int e = tt - 4352, w = e >> 7, f = e & 127; J.src = (w == 0 ? P.glu_wa : P.glu_wb) + (size_t)l * 1024 * 1024; J.dst = (bf16_t*)(wl + LO_GLU);
        J.K = 1024; J.N = 1024; kt = f & 7; nt = f >> 3; const int n0 = nt * 64; J.drow0 = (n0 >> 7) * 256 + (n0 & 127) + w * 128; }
    else if (tt < 4608 + 128) { const int f = tt - 4608; J.src = P.fourier_w + (size_t)l * 1024 * 1024; J.dst = (bf16_t*)(wl + LO_FW); J.K = 1024; J.N = 1024; kt = f & 7; nt = f >> 3; J.drow0 = nt * 64; }
    else { const int f = tt - 4736; J.src = P.w_out + (size_t)l * DM * DM; J.dst = (bf16_t*)(wl + LO_WO); J.K = DM; J.N = DM; kt = f & 15; nt = f >> 4; J.drow0 = nt * 64; }
    J.k0 = kt * 128; J.n0 = nt * 64; return J;
}


__device__ __forceinline__ void mod_item(PREF P, int l, int nt, float* sm) {
    const int tid = tid_opaque(); float* sc = sm; float* red = sm + 3 * 2048;
    for (int i = tid; i < 3 * 2048; i += 512) { const int r = i >> 11, k = i & 2047; const float v = r < 2 ? P.c[r * 2048 + k] : P.c_ctx[k]; sc[i] = siluf_(v); }
    __syncthreads();
    const int col = tid & 63, kg = tid >> 6; const float* w = P.w_ada + (size_t)l * DM * 6144 + nt * 64 + col;
    float a0 = 0.f, a1 = 0.f, a2 = 0.f;
#pragma unroll 16
    for (int k = kg * 256; k < kg * 256 + 256; ++k) { const float wv = w[(size_t)k * 6144]; a0 += sc[k] * wv; a1 += sc[2048 + k] * wv; a2 += sc[4096 + k] * wv; }
    red[(kg * 3 + 0) * 64 + col] = a0; red[(kg * 3 + 1) * 64 + col] = a1; red[(kg * 3 + 2) * 64 + col] = a2;
    __syncthreads();
    if (tid < 192) { const int r = tid >> 6, c = tid & 63; float s = 0.f;
#pragma unroll
        for (int k = 0; k < 8; ++k) s += red[(k * 3 + r) * 64 + c];
        float* MOD = (float*)(P.ws + l * SZ_LAYER + LO_MOD); MOD[r * 6144 + nt * 64 + c] = s + P.b_ada[l * 6144 + nt * 64 + c]; }
    __syncthreads();
}

__device__ __forceinline__ void tables_item(PREF P, int it) {
    const int tid = tid_opaque(); unsigned char* tb = P.ws + O_TAB;
    if (it < 8) {
        bf16_t* T = (bf16_t*)(tb + T_CS);
        for (int e = tid; e < 64 * 256; e += 512) { const int row = it * 64 + (e >> 8), kc = e & 255, cs = row >> 8, j = row & 255; const int mm = (j * kc) & 255;
            float s, c; sincospif((float)mm * (1.0f / 128.0f), &s, &c); T[row * 256 + kc] = (bf16_t)(cvt_pk_bf16((cs ? s : c) * 0.0625f, 0.f) & 0xffffu); }
    } else if (it < 16) {
        bf16_t* T = (bf16_t*)(tb + T_DCTX); const int i8 = it - 8;
        for (int e = tid; e < 64 * 256; e += 512) { const int row = i8 * 64 + (e >> 8), t = e & 255, cs = row >> 8, k = row & 255; const int mm = (k * t) & 255;
            float s, c; sincospif((float)mm * (1.0f / 128.0f), &s, &c); T[row * 256 + t] = (bf16_t)(cvt_pk_bf16((cs ? -s : c) * 0.0625f, 0.f) & 0xffffu); }
    } else {
        bf16_t* D1 = (bf16_t*)(tb + T_D1); bf16_t* D2 = (bf16_t*)(tb + T_D2); float* TW = (float*)(tb + T_TW);
        for (int e = tid; e < 128 * 64; e += 512) { const int row = e >> 6, t1 = e & 63, cs = row >> 6, k1 = row & 63; const int mm = (k1 * t1) & 63;
            float s, c; sincospif((float)mm * (1.0f / 32.0f), &s, &c); D1[e] = (bf16_t)(cvt_pk_bf16((cs ? -s : c) * 0.125f, 0.f) & 0xffffu); }
        for (int e = tid; e < 128 * 128; e += 512) { const int row = e >> 7, col = e & 127, cso = row >> 6, k2 = row & 63, csi = col >> 6, t2 = col & 63; const int mm = (k2 * t2) & 63;
            float s, c; sincospif((float)mm * (1.0f / 32.0f), &s, &c); const float v = (cso == csi) ? c : (cso == 0 ? s : -s);
            D2[e] = (bf16_t)(cvt_pk_bf16(v * 0.125f, 0.f) & 0xffffu); }
        for (int e = tid; e < 64 * 64; e += 512) { const int k1 = e >> 6, t2 = e & 63; float s, c; sincospif((float)(k1 * t2) * (1.0f / 2048.0f), &s, &c); TW[2 * e] = c; TW[2 * e + 1] = -s; }
    }
}

__device__ __forceinline__ void ssm_build(PREF P, int l, int g, float* sm) {
    float* ap_re = sm; float* ap_im = ap_re + 2 * 17 * 64; float* bb_re = ap_im + 2 * 17 * 64; float* bb_im = bb_re + 2 * 64 * 16;
    float* cc_re = bb_im + 2 * 64 * 16; float* cc_im = cc_re + 2 * 16 * 64; float* Kk = cc_im + 2 * 16 * 64;
    const int tid = tid_opaque(); unsigned char* wl = P.ws + l * SZ_LAYER;
    if (tid < 128) {
        const int d = tid >> 6, p = tid & 63; const size_t gi = (size_t)(l * 2 + d) * 64 + g;
        const double lr = (double)P.lam_re[gi * 64 + p], li = (double)P.lam_im[gi * 64 + p], dt = exp((double)P.log_dt[gi]);
        const double a_re = exp(lr * dt) * cos(li * dt), a_im = exp(lr * dt) * sin(li * dt);
        { double pr = 1.0, pi = 0.0;
          for (int tau = 0; tau <= 16; ++tau) { ap_re[(d * 17 + tau) * 64 + p] = (float)pr; ap_im[(d * 17 + tau) * 64 + p] = (float)pi;
              if (tau == 16) { float* A16 = (float*)(wl + LO_A16); A16[((d * 64 + g) * 64 + p) * 2] = (float)pr; A16[((d * 64 + g) * 64 + p) * 2 + 1] = (float)pi; }
              const double nr = pr * a_re - pi * a_im, ni = pr * a_im + pi * a_re; pr = nr; pi = ni; } }
        const double n_re = a_re - 1.0, n_im = a_im, den = lr * lr + li * li;
        const double q_re = (n_re * lr + n_im * li) / den, q_im = (n_im * lr - n_re * li) / den;
        for (int h = 0; h < 16; ++h) { const double br = (double)P.b_re[(gi * 64 + p) * 16 + h], bi = (double)P.b_im[(gi * 64 + p) * 16 + h];
            bb_re[(d * 64 + p) * 16 + h] = (float)(q_re * br - q_im * bi); bb_im[(d * 64 + p) * 16 + h] = (float)(q_re * bi + q_im * br); }
    }
    for (int i = tid; i < 2048; i += 512) { const int d = i >> 10, rem = i & 1023; const size_t s = ((size_t)(l * 2 + d) * 64 + g) * 1024 + rem; cc_re[i] = P.c_re[s]; cc_im[i] = P.c_im[s]; }
    __syncthreads();
    { const int d = tid >> 8, tau = (tid >> 4) & 15, ho = tid & 15; float sacc[16];
#pragma unroll
      for (int hi = 0; hi < 16; ++hi) sacc[hi] = 0.f;
      for (int p = 0; p < 64; ++p) { const float cr = cc_re[(d * 16 + ho) * 64 + p], ci = cc_im[(d * 16 + ho) * 64 + p], ar = ap_re[(d * 17 + tau) * 64 + p], ai = ap_im[(d * 17 + tau) * 64 + p];
          const float wr = cr * ar - ci * ai, wi = cr * ai + ci * ar; const float* br = bb_re + (d * 64 + p) * 16; const float* bi = bb_im + (d * 64 + p) * 16;
#pragma unroll
          for (int hi = 0; hi < 16; ++hi) sacc[hi] += wr * br[hi] - wi * bi[hi]; }
#pragma unroll
      for (int hi = 0; hi < 16; ++hi) Kk[((d * 16 + tau) * 16 + ho) * 16 + hi] = sacc[hi]; }
    __syncthreads();
    bf16_t* M1 = (bf16_t*)(wl + LO_M1) + (size_t)g * 256 * 256; bf16_t* M2 = (bf16_t*)(wl + LO_M2) + (size_t)g * 256 * 512;
    for (int v = tid; v < 8192; v += 512) { const int mrow = v >> 5, k0 = (v & 31) * 8; const int d = mrow >> 7, reim = (mrow >> 6) & 1, p = mrow & 63, s = k0 >> 4, hi0 = k0 & 15;
        const int tau = d == 0 ? 15 - s : s; const float ar = ap_re[(d * 17 + tau) * 64 + p], ai = ap_im[(d * 17 + tau) * 64 + p]; float f[8];
#pragma unroll
        for (int j = 0; j < 8; ++j) { const float br = bb_re[(d * 64 + p) * 16 + hi0 + j], bi = bb_im[(d * 64 + p) * 16 + hi0 + j]; f[j] = reim == 0 ? ar * br - ai * bi : ar * bi + ai * br; }
        *(u32x4*)(M1 + (size_t)mrow * 256 + k0) = pack8(f); }
    for (int v = tid; v < 16384; v += 512) { const int r = v >> 6, k0 = (v & 63) * 8, t = r >> 4, ho = r & 15; float f[8];
        if (k0 < 256) { const int s = k0 >> 4, hi0 = k0 & 15;
#pragma unroll
            for (int j = 0; j < 8; ++j) f[j] = s < t ? Kk[(t - s) * 256 + ho * 16 + hi0 + j] : (s > t ? Kk[(16 + (s - t)) * 256 + ho * 16 + hi0 + j] : Kk[ho * 16 + hi0 + j] + Kk[16 * 256 + ho * 16 + hi0 + j]);
        } else { const int kk = k0 - 256, d = kk >> 7, reim = (kk >> 6) & 1, p0 = kk & 63, tau = d == 0 ? t + 1 : 16 - t;
#pragma unroll
            for (int j = 0; j < 8; ++j) { const int p = p0 + j; const float cr = cc_re[(d * 16 + ho) * 64 + p], ci = cc_im[(d * 16 + ho) * 64 + p], ar = ap_re[(d * 17 + tau) * 64 + p], ai = ap_im[(d * 17 + tau) * 64 + p];
                f[j] = reim == 0 ? cr * ar - ci * ai : -(cr * ai + ci * ar); } }
        *(u32x4*)(M2 + (size_t)r * 512 + k0) = pack8(f); }
    __syncthreads();
}

__device__ __forceinline__ void phase_prep(PREF P, unsigned char* shm) {
    float* sm = (float*)shm; const int b = bid_opaque(), G = gridDim.x;
    for (int it = b; it < 337; it += G) {
        if (it < 128) ssm_build(P, it >> 6, it & 63, sm);
        else if (it < 320) { const int e = it - 128; mod_item(P, e / 96, e % 96, sm); }
        else tables_item(P, it - 320);
    }
    const int total = 2 * TILES_PER_LAYER; int start, cnt;
    if (G == 256) { if (b < 64) { start = b * 38; cnt = 38; } else if (b < 81) { start = 2432 + (b - 64) * 42; cnt = 42; } else { start = 2432 + 17 * 42 + (b - 81) * 43; cnt = 43; } }
    else { cnt = (total + G - 1) / G; start = b * cnt; }
    const int end = (start + cnt) < total ? (start + cnt) : total;
    const int tid = tid_opaque(), lr = tid >> 4, lc = (tid & 15) * 4;
    if (start < end) {
        int cur = start; TileJob J = tile_job(P, cur); f32x4 v[4];
#pragma unroll
        for (int i = 0; i < 4; ++i) v[i] = *(const f32x4*)(J.src + (size_t)(J.k0 + lr + 32 * i) * J.N + J.n0 + lc);
        for (;;) {
#pragma unroll
            for (int i = 0; i < 4; ++i)
#pragma unroll
                for (int j = 0; j < 4; ++j) sm[(lr + 32 * i) * 65 + lc + j] = v[i][j];
            __syncthreads();
            const TileJob C = J; const bool more = cur + 1 < end;
            if (more) { J = tile_job(P, cur + 1);
#pragma unroll
                for (int i = 0; i < 4; ++i) v[i] = *(const f32x4*)(J.src + (size_t)(J.k0 + lr + 32 * i) * J.N + J.n0 + lc); }
            const int n = tid >> 3, kg = tid & 7;
#pragma unroll
            for (int h = 0; h < 2; ++h) { float f[8];
#pragma unroll
                for (int j = 0; j < 8; ++j) f[j] = sm[(kg * 16 + h * 8 + j) * 65 + n];
                *(u32x4*)(C.dst + (size_t)(C.drow0 + n) * C.K + C.k0 + kg * 16 + h * 8) = pack8(f); }
            __syncthreads();
            if (!more) break;
            ++cur;
        }
    }
}

__device__ __forceinline__ void phase_prenorm0(PREF P) {
    const int tidx = tid_opaque(); const int lane = tidx & 63, gw = (tidx >> 6) * (int)gridDim.x + bid_opaque(), nw = gridDim.x * 8;
    const float* MOD = (const float*)(P.ws + LO_MOD); bf16_t* HB = (bf16_t*)(P.ws + O_HB);
    for (int row = gw; row < MTOT; row += nw) {
        const float* src = row < MX ? P.x + (size_t)row * DM : P.ctx + (size_t)(row - MX) * DM; const float* md = MOD + (row < MX ? (row >> 12) : 2) * 6144;
        f32x4 v[8]; float ss = 0.f;
#pragma unroll
        for (int i = 0; i < 8; ++i) { v[i] = *(const f32x4*)(src + (i * 64 + lane) * 4); ss += v[i][0] * v[i][0] + v[i][1] * v[i][1] + v[i][2] * v[i][2] + v[i][3] * v[i][3]; }
        f32x4 gq[8], shq[8], scq[8];
#pragma unroll
        for (int i = 0; i < 8; ++i) { const int c = (i * 64 + lane) * 4; gq[i] = *(const f32x4*)(P.g_pre + c); shq[i] = *(const f32x4*)(md + c); scq[i] = *(const f32x4*)(md + 2048 + c); }
        ss = wave_sum(ss, lane); const float rinv = rsqrtf(ss * (1.0f / DM) + RMS_EPS);
#pragma unroll
        for (int i = 0; i < 8; ++i) { const int c = (i * 64 + lane) * 4; const f32x4 g = gq[i], sh = shq[i], sc = scq[i]; float h[4];
#pragma unroll
            for (int j = 0; j < 4; ++j) h[j] = v[i][j] * rinv * g[j] * (1.0f + sc[j]) + sh[j];
            u32x2 o; o[0] = cvt_pk_bf16(h[0], h[1]); o[1] = cvt_pk_bf16(h[2], h[3]); *(u32x2*)(HB + (size_t)row * DM + c) = o; }
    }
}
__device__ __forceinline__ void phase_postnorm(PREF P, int l) {
    const int tidx = tid_opaque(); const int lane = tidx & 63, gw = (tidx >> 6) * (int)gridDim.x + bid_opaque(), nw = gridDim.x * 8;
    const float* MOD = (const float*)(P.ws + l * SZ_LAYER + LO_MOD); const float* MOD1 = (const float*)(P.ws + SZ_LAYER + LO_MOD);
    bf16_t* HB = (bf16_t*)(P.ws + O_HB); const bf16_t* OB = (const bf16_t*)(P.ws + O_PARTS); float* X1 = (float*)(P.ws + O_X1);
    const int rows = l == 0 ? MTOT : MX;
    for (int row = gw; row < rows; row += nw) {
        const int mr = row < MX ? (row >> 12) : 2; const float* md = MOD + mr * 6144;
        const float* xo = l == 0 ? (row < MX ? P.x + (size_t)row * DM : P.ctx + (size_t)(row - MX) * DM) : X1 + (size_t)row * DM;
        const bf16_t* op = OB + (size_t)row * DM;
        f32x4 o[8], xv[8]; float ss = 0.f;
#pragma unroll
        for (int i = 0; i < 8; ++i) { const u32x2 ob = *(const u32x2*)(op + (i * 64 + lane) * 4); o[i] = (f32x4){lo_f(ob[0]), hi_f(ob[0]), lo_f(ob[1]), hi_f(ob[1])}; xv[i] = *(const f32x4*)(xo + (i * 64 + lane) * 4); ss += o[i][0] * o[i][0] + o[i][1] * o[i][1] + o[i][2] * o[i][2] + o[i][3] * o[i][3]; }
        f32x4 gpq[8], gtq[8];
#pragma unroll
        for (int i = 0; i < 8; ++i) { const int c = (i * 64 + lane) * 4; gpq[i] = *(const f32x4*)(P.g_post + l * DM + c); gtq[i] = *(const f32x4*)(md + 4096 + c); }
        ss = wave_sum(ss, lane); const float rinv = rsqrtf(ss * (1.0f / DM) + RMS_EPS); float s2 = 0.f;
#pragma unroll
        for (int i = 0; i < 8; ++i) {
#pragma unroll
            for (int j = 0; j < 4; ++j) { xv[i][j] = xv[i][j] + gtq[i][j] * (o[i][j] * rinv * gpq[i][j]); s2 += xv[i][j] * xv[i][j]; } }
        if (l == 0) { const float* m1 = MOD1 + mr * 6144; f32x4 gq[8], shq[8], scq[8];
#pragma unroll
            for (int i = 0; i < 8; ++i) { const int c = (i * 64 + lane) * 4; gq[i] = *(const f32x4*)(P.g_pre + DM + c); shq[i] = *(const f32x4*)(m1 + c); scq[i] = *(const f32x4*)(m1 + 2048 + c); }
            s2 = wave_sum(s2, lane); const float r2 = rsqrtf(s2 * (1.0f / DM) + RMS_EPS);
#pragma unroll
            for (int i = 0; i < 8; ++i) { const int c = (i * 64 + lane) * 4; *(f32x4*)(X1 + (size_t)row * DM + c) = xv[i]; float h[4];
#pragma unroll
                for (int j = 0; j < 4; ++j) h[j] = xv[i][j] * r2 * gq[i][j] * (1.0f + scq[i][j]) + shq[i][j];
                u32x2 ov; ov[0] = cvt_pk_bf16(h[0], h[1]); ov[1] = cvt_pk_bf16(h[2], h[3]); *(u32x2*)(HB + (size_t)row * DM + c) = ov; }
        } else {
#pragma unroll
            for (int i = 0; i < 8; ++i) { const int c = (i * 64 + lane) * 4; *(f32x4*)(P.out + (size_t)row * DM + c) = xv[i]; }
        }
    }
}


__device__ __forceinline__ void conv_rows(PREF P, const int l, const int bsub, const int nblk, const int tidx) {
    const bf16_t* parts = (const bf16_t*)(P.ws + O_PARTS); bf16_t* AB = (bf16_t*)(P.ws + O_AB);
    const int rows = l == 0 ? MTOT : MX; const float* cw = P.conv_w + (size_t)l * 3 * 1024;
    for (int idx = bsub * 512 + tidx; idx < (rows >> 2) * 128; idx += nblk * 512) {
        const int r0 = (idx >> 7) * 4, c0 = (idx & 127) * 8; bool lv, rv;
        if (r0 < MX) { const int cp = r0 & 63; lv = cp > 0; rv = cp < 60; } else { const int t = (r0 - MX) & 255; lv = t > 0; rv = t < 252; }
        const bf16_t* pr = parts + E_PC + (size_t)r0 * 4096 + c0;
        u32x4 xr[6], cr[6], br[4], zr[4];
#pragma unroll
        for (int k = 0; k < 6; ++k) { const bool ok = (k == 0) ? lv : ((k == 5) ? rv : true);
            if (ok) { xr[k] = *(const u32x4*)(pr + (ptrdiff_t)(k - 1) * 4096 + C_XA); cr[k] = *(const u32x4*)(pr + (ptrdiff_t)(k - 1) * 4096 + C_CA); }
            else { xr[k] = (u32x4){0u, 0u, 0u, 0u}; cr[k] = (u32x4){0u, 0u, 0u, 0u}; } }
#pragma unroll
        for (int k = 0; k < 4; ++k) { br[k] = *(const u32x4*)(pr + (size_t)k * 4096 + C_BA); zr[k] = *(const u32x4*)(pr + (size_t)k * 4096 + C_ZA); }
        float w0[8], w1[8], w2[8];
#pragma unroll
        for (int j = 0; j < 8; ++j) { w0[j] = cw[c0 + j]; w1[j] = cw[1024 + c0 + j]; w2[j] = cw[2048 + c0 + j]; }
        float v[6][8];
#pragma unroll
        for (int k = 0; k < 6; ++k) { float xa[8], ca[8]; unpack8(xr[k], xa); unpack8(cr[k], ca);
#pragma unroll
            for (int j = 0; j < 8; ++j) v[k][j] = xa[j] * ca[j]; }
#pragma unroll
        for (int k = 0; k < 4; ++k) { float ba[8], za[8], o[8]; unpack8(br[k], ba); unpack8(zr[k], za);
#pragma unroll
            for (int j = 0; j < 8; ++j) { const float y = w0[j] * v[k][j] + w1[j] * v[k + 1][j] + w2[j] * v[k + 2][j]; o[j] = ba[j] * y * siluf_(za[j]); }
            *(u32x4*)(AB + (size_t)(r0 + k) * 1024 + c0) = pack8(o); }
    }
}

__device__ __forceinline__ void phase_mix1(PREF P, int l, unsigned char* shm) {
    const bf16_t* parts = (const bf16_t*)(P.ws + O_PARTS); unsigned char* wl = P.ws + l * SZ_LAYER;
    const int tidx = tid_opaque(), bidx = bid_opaque(); const int lane = tidx & 63, wv = tidx >> 6, r = lane & 15, q = lane >> 4;
    const int gw = bidx * 8 + wv, nw = gridDim.x * 8;
    for (int wi = bidx; wi < 256; wi += gridDim.x) ssm_stage_lds<256, false>(P, l, wi, shm, tidx);
    {
        bf16_t* ZB = (bf16_t*)(P.ws + O_ZB); const bf16_t* D1 = (const bf16_t*)(P.ws + O_TAB + T_D1); const float* TW = (const float*)(P.ws + O_TAB + T_TW);
        for (int it = gw; it < 2048; it += nw) {
            const int cg = it & 15, t2 = (it >> 4) & 63, b = it >> 10;
            f32x4 acc[8][4];
            lmul_g4<8>(D1, 64, 2, parts + E_PF + (size_t)(b * SEQ + t2) * 1024 + cg * 64 + r * 4, (size_t)64 * 1024, acc, lane);
            float twq[4][4][2];
#pragma unroll
            for (int a = 0; a < 4; ++a)
#pragma unroll
                for (int i = 0; i < 4; ++i) { const int k1 = a * 16 + q * 4 + i; twq[a][i][0] = TW[(k1 * 64 + t2) * 2]; twq[a][i][1] = TW[(k1 * 64 + t2) * 2 + 1]; }
#pragma unroll
            for (int a = 0; a < 4; ++a)
#pragma unroll
                for (int i = 0; i < 4; ++i) { const int k1 = a * 16 + q * 4 + i; const float twr = twq[a][i][0], twi = twq[a][i][1];
                    bf16_t* zr = ZB + ((size_t)((b * 64 + k1) * 128 + t2)) * 1024 + cg * 64 + r * 4; bf16_t* zi = zr + (size_t)64 * 1024; float vr[4], vi[4];
#pragma unroll
                    for (int nb = 0; nb < 4; ++nb) { const float re = acc[a][nb][i], im = acc[a + 4][nb][i]; vr[nb] = re * twr - im * twi; vi[nb] = re * twi + im * twr; }
                    u32x2 o; o[0] = cvt_pk_bf16(vr[0], vr[1]); o[1] = cvt_pk_bf16(vr[2], vr[3]); *(u32x2*)zr = o; o[0] = cvt_pk_bf16(vi[0], vi[1]); o[1] = cvt_pk_bf16(vi[2], vi[3]); *(u32x2*)zi = o; }
        }
    }
}


__device__ __forceinline__ void ctx_dft_item(PREF P, const int it, const int lane) {
    const int r = lane & 15, q = lane >> 4; const bf16_t* parts = (const bf16_t*)(P.ws + O_PARTS);
    bf16_t* YB = (bf16_t*)(P.ws + O_YB); const bf16_t* DC = (const bf16_t*)(P.ws + O_TAB + T_DCTX);
    const int cg = it & 15, mc = (it >> 4) & 3, b = it >> 6;
    f32x4 acc[8][4];
    lmul_g4<8>(DC + (size_t)mc * 128 * 256, 256, 8, parts + E_PF + (size_t)(MX + b * LCX) * 1024 + cg * 64 + r * 4, (size_t)1024, acc, lane);
#pragma unroll
    for (int a = 0; a < 8; ++a)
#pragma unroll
        for (int i = 0; i < 4; ++i) { const int mrow = mc * 128 + a * 16 + q * 4 + i, cs = mrow >> 8, k = mrow & 255;
            bf16_t* yp = YB + (size_t)(MX + b * LCX + k) * 2048 + cs * 1024 + cg * 64 + r * 4;
            u32x2 o; o[0] = cvt_pk_bf16(acc[a][0][i], acc[a][1][i]); o[1] = cvt_pk_bf16(acc[a][2][i], acc[a][3][i]); *(u32x2*)yp = o; }
}

__device__ __forceinline__ void phase_mix2(PREF P, int l) {
    unsigned char* wl = P.ws + l * SZ_LAYER;
    const int tidx = tid_opaque(), bidx = bid_opaque(); const int lane = tidx & 63, wv = tidx >> 6, r = lane & 15, q = lane >> 4;
    const int gw = bidx * 8 + wv, nw = gridDim.x * 8;
    if (wv == 0) {
        const float* EB = (const float*)(P.ws + O_EB); bf16_t* HS = (bf16_t*)(P.ws + O_HS); const float* A16 = (const float*)(wl + LO_A16);
        for (int it = bidx; it < 256; it += gridDim.x) {
            const int d = it & 1, g = (it >> 1) & 63, b = it >> 7, p = lane;
            const float ar = A16[((d * 64 + g) * 64 + p) * 2], ai = A16[((d * 64 + g) * 64 + p) * 2 + 1];
            float hr = 0.f, hi = 0.f;
#define SCAN_COL(j) ((j) < 16 ? 512 + b * 16 + (d ? 15 - (j) : (j)) : b * 256 + (d ? 255 - ((j) - 16) : ((j) - 16)))
#define SCAN_LOAD(er, ei, j0) _Pragma("unroll") for (int jj = 0; jj < 16; ++jj) { const int col = SCAN_COL((j0) + jj); const float* ep = EB + ((size_t)g * NCOL + col) * 256 + d * 128 + p; er[jj] = ep[0]; ei[jj] = ep[64]; }
#define SCAN_STEP(er, ei, j0) _Pragma("unroll") for (int jj = 0; jj < 16; ++jj) { const int col = SCAN_COL((j0) + jj); \
                bf16_t* hp = HS + ((size_t)g * NCOL + col) * 256 + d * 128 + p; const unsigned pk = cvt_pk_bf16(hr, hi); hp[0] = (bf16_t)(pk & 0xffffu); hp[64] = (bf16_t)(pk >> 16); \
                const float nr = ar * hr - ai * hi + er[jj], ni = ar * hi + ai * hr + ei[jj]; hr = nr; hi = ni; }
            float era[16], eia[16], erb[16], eib[16];
            SCAN_LOAD(era, eia, 0)
            for (int it2 = 0; it2 < 8; ++it2) {
                SCAN_LOAD(erb, eib, it2 * 32 + 16)
                SCAN_STEP(era, eia, it2 * 32)
                SCAN_LOAD(era, eia, it2 * 32 + 32)
                SCAN_STEP(erb, eib, it2 * 32 + 16)
            }
            SCAN_STEP(era, eia, 256)
#undef SCAN_COL
#undef SCAN_LOAD
#undef SCAN_STEP
        }
    }
    {
        const bf16_t* ZB = (const bf16_t*)(P.ws + O_ZB); bf16_t* YB = (bf16_t*)(P.ws + O_YB); const bf16_t* D2 = (const bf16_t*)(P.ws + O_TAB + T_D2);
        for (int it = gw; it < 2048; it += nw) {
            const int cg = it & 15, k1 = (it >> 4) & 63, b = it >> 10;
            f32x4 acc[8][4];
            lmul_g4<8>(D2, 128, 4, ZB + (size_t)(b * 64 + k1) * 128 * 1024 + cg * 64 + r * 4, (size_t)1024, acc, lane);
#pragma unroll
            for (int a = 0; a < 8; ++a)
#pragma unroll
                for (int i = 0; i < 4; ++i) { const int mrow = a * 16 + q * 4 + i, cs = mrow >> 6, k2 = mrow & 63;
                    bf16_t* yp = YB + (size_t)(b * SEQ + k1 + 64 * k2) * 2048 + cs * 1024 + cg * 64 + r * 4;
                    u32x2 o; o[0] = cvt_pk_bf16(acc[a][0][i], acc[a][1][i]); o[1] = cvt_pk_bf16(acc[a][2][i], acc[a][3][i]); *(u32x2*)yp = o; }
        }
    }
    if (l == 0 && wv >= 1) { for (int it = bidx * 7 + (wv - 1); it < 128; it += gridDim.x * 7) ctx_dft_item(P, it, lane); }
}

template <int ph>
__device__ __forceinline__ void run_phase(KPtr kp, unsigned char* shm) {
    asm volatile("" : "+s"(kp)); PREF P = *kp;
    LAS unsigned char* lds = (LAS unsigned char*)shm; const int G = gridDim.x, c = bid_opaque();
    if constexpr (ph == 0) { phase_prep(P, shm); return; }
    if constexpr (ph == 1) {
        phase_prenorm0(P);
        return;
    }
    constexpr int l = ph >= 2 ? ((ph - 2) >> 3) : 0, sp = ph >= 2 ? ((ph - 2) & 7) : 0; unsigned char* wl = P.ws + l * SZ_LAYER; constexpr int nM = 32, nh = l == 0 ? 4 : 0;
    const bf16_t* parts = (const bf16_t*)(P.ws + O_PARTS);
    switch (sp) {
    case 0: { EpiParts E{(bf16_t*)(P.ws + O_PARTS)};
        if (l == 0) { SchedGrid S{(const char*)(P.ws + O_HB), (const char*)(wl + LO_WIN), 32, 56, DM, DM, G, c, 4, MX, 1 << 20}; gemm_phase(lds, S, E, DM, DM, DM);
            { const int c3 = bid_opaque(); const int first = G > 224 ? 224 : 0; if (c3 >= first) { SchedWp SW{P.ws, G - first, c3 - first}; EpiWp EW{P.ws}; gemm_phase(lds, SW, EW, 256, 1024, 256); } } }
        else {
            {
                const int tq = tid_opaque(), lane = tq & 63, r = lane & 15, q = lane >> 4; const bf16_t* HB = (const bf16_t*)(P.ws + O_HB); const bf16_t* WT = (const bf16_t*)(wl + LO_WIN); bf16_t* po = (bf16_t*)(P.ws + O_PARTS);
                for (int it = c * 8 + (tq >> 6); it < 2048; it += G * 8) { const int tr = it >> 6, tc = it & 63;
                    const bf16_t* ap = HB + (size_t)(MX + tr * 16 + r) * DM + q * 8; const bf16_t* bp = WT + (size_t)(C_U + tc * 16 + r) * DM + q * 8; f32x4 a4 = (f32x4){0.f, 0.f, 0.f, 0.f};
#pragma unroll 8
                    for (int ks = 0; ks < 64; ++ks) a4 = __builtin_amdgcn_mfma_f32_16x16x32_bf16(*(const bf16x8*)(ap + ks * 32), *(const bf16x8*)(bp + ks * 32), a4, 0, 0, 0);
#pragma unroll
                    for (int i = 0; i < 4; ++i) po[E_PU + (size_t)(MX + tr * 16 + q * 4 + i) * 1024 + tc * 16 + r] = (bf16_t)(cvt_pk_bf16(a4[i], 0.f) & 0xffffu); }
            }
            SchedGrid S{(const char*)(P.ws + O_HB), (const char*)(wl + LO_WIN), 32, 56, DM, DM, G, c, 0, MX, 1 << 20}; gemm_phase(lds, S, E, DM, DM, DM); }
    } break;
    case 1: phase_mix1(P, l, shm); break;
    case 2: phase_mix2(P, l); break;
    case 3: { const int tq = tid_opaque(), c2 = bid_opaque();
        for (int wi = c2; wi < 256; wi += G) ssm_stage_lds<512, true>(P, l, wi, shm, tq);
        conv_rows(P, l, c2, G, tq);
    } break;
    case 4: {
        if (l == 0) { ctx_small_gemm<0>(P, shm); ctx_small_gemm<3>(P, shm); }
        const int nf = nM * 4;
        { const int c1 = bid_opaque(); SchedGrid S{(const char*)(P.ws + O_YB), (const char*)(wl + LO_WP), nM, 4, 2048, 2048, nf, c1, 0, MX, c1 < nf ? 1 : 0}; EpiFourier E{parts, (bf16_t*)(P.ws + O_CB)}; gemm_phase(lds, S, E, 2048, 2048, 2048); }
        { const int c2 = bid_opaque(); const int ng = nM * 8, two = 2 * (G - nf);
          int L0, dL, cn;
          if (G > nf && two <= ng) { if (c2 >= nf) { L0 = 2 * (c2 - nf); dL = 1; cn = 2; } else { L0 = two + c2; dL = nf; cn = (ng - two - c2 + nf - 1) / nf; if (cn < 0) cn = 0; } }
          else { L0 = c2; dL = G; cn = 1 << 20; }
          SchedGrid S{(const char*)(P.ws + O_GB), (const char*)(wl + LO_GLU), nM, 8, 1024, 1024, dL, L0, 0, MX, cn}; EpiGlu E{parts, (bf16_t*)(P.ws + O_BB)}; gemm_phase(lds, S, E, 1024, 1024, 1024); }
    } break;
    case 5: { if (l == 0) ctx_small_gemm<1>(P, shm);
        SchedMerge S{(const char*)(P.ws + O_AB), (const char*)(wl + LO_PA), nM, G, c, 0, MX};
        EpiMerge E{parts, (bf16_t*)(P.ws + O_HB)}; gemm_phase(lds, S, E, 1024, 1024, 1024); } break;
    case 6: { if (l == 0) ctx_small_gemm<2>(P, shm);
        SchedGrid S{(const char*)(P.ws + O_HB), (const char*)(wl + LO_WO), nM, 8, DM, DM, G, c, 0, MX, 1 << 20}; EpiStoreBf16 E{(bf16_t*)(P.ws + O_PARTS), DM}; gemm_phase(lds, S, E, DM, DM, DM); } break;
    default: phase_postnorm(P, l); break;
    }
}

#define XB_TMO      128
#define XB_XCNT(j)  (256  + 64 * (j))
#define XB_XSUB(j)  (1280 + 64 * (j))
#define XB_XGEN(j)  (2304 + 64 * (j))
#define XB_TOP      3328
#define XB_TOPGEN   3392
#define XCD_BAR_WORDS 3456
#define XB_SPIN_CAP (1u << 18)
__device__ __forceinline__ unsigned xb_ld(unsigned* p)              { return __hip_atomic_load(p, __ATOMIC_RELAXED, __HIP_MEMORY_SCOPE_AGENT); }
__device__ __forceinline__ unsigned xb_add(unsigned* p, unsigned v) { return __hip_atomic_fetch_add(p, v, __ATOMIC_RELAXED, __HIP_MEMORY_SCOPE_AGENT); }
__device__ __forceinline__ unsigned xb_xcc_id() { return (unsigned)__builtin_amdgcn_s_getreg((3 << 11) | 20) & 0xFu; }
#define XB_SPIN(cond, bar) do { unsigned _sp = 0; while (cond) { __builtin_amdgcn_s_sleep(1); \
    if ((++_sp & 255u) == 0u) { if (xb_ld(&(bar)[XB_TMO])) break; if (_sp > XB_SPIN_CAP) { atomicAdd(&(bar)[XB_TMO], 1u); break; } } } } while (0)
struct XcdBarrier { unsigned* bar; unsigned x; volatile LAS unsigned* st; };
__device__ __forceinline__ XcdBarrier xcd_barrier_post(unsigned* bar, volatile LAS unsigned* st) {
    XcdBarrier b; b.bar = bar; b.x = xb_xcc_id(); b.st = st;
    if (threadIdx.x == 0) (void)xb_add(&bar[XB_XCNT(b.x)], 1u);
    return b;
}
__device__ __forceinline__ void xcd_barrier_complete(unsigned* bar, unsigned x, unsigned& nloc, unsigned& nx) {
    const unsigned G = gridDim.x * gridDim.y * gridDim.z;
    unsigned sum, cnt, mine, sp = 0u;
    for (;;) {
        sum = 0u; cnt = 0u; mine = 0u;
#pragma unroll
        for (unsigned j = 0; j < 16; ++j) { const unsigned c = xb_ld(&bar[XB_XCNT(j)]); sum += c; cnt += (c > 0u) ? 1u : 0u; mine = (j == x) ? c : mine; }
        if (sum == G) break;
        __builtin_amdgcn_s_sleep(1);
        if ((++sp & 255u) == 0u) { if (xb_ld(&bar[XB_TMO])) break; if (sp > XB_SPIN_CAP) { atomicAdd(&bar[XB_TMO], 1u); break; } }
    }
    nloc = mine > 0u ? mine : 1u; nx = cnt > 0u ? cnt : 1u;
}
__device__ __forceinline__ void xcd_barrier(const XcdBarrier& b) {
    asm volatile("s_waitcnt vmcnt(0)" ::: "memory");
    __syncthreads();
    if (threadIdx.x == 0) {
        unsigned* bar = b.bar;
        __builtin_amdgcn_s_waitcnt(0);
        unsigned nloc = b.st[0], nx = b.st[1];
        if (nloc == 0u) { xcd_barrier_complete(bar, b.x, nloc, nx); b.st[0] = nloc; b.st[1] = nx; }
        const unsigned old = xb_add(&bar[XB_XSUB(b.x)], 1u);
        const unsigned gen = old / nloc;
        if (old + 1u == (gen + 1u) * nloc) {
            __builtin_amdgcn_fence(__ATOMIC_RELEASE, "agent");
            asm volatile("s_waitcnt vmcnt(0)" ::: "memory");
            const unsigned og = xb_add(&bar[XB_TOP], 1u);
            const unsigned tg = og / nx;
            if (og + 1u == (tg + 1u) * nx) xb_add(&bar[XB_TOPGEN], 1u);
            else XB_SPIN(xb_ld(&bar[XB_TOPGEN]) == tg, bar);
            __builtin_amdgcn_fence(__ATOMIC_ACQUIRE, "agent");
            xb_add(&bar[XB_XGEN(b.x)], 1u);
            asm volatile("s_waitcnt vmcnt(0)" ::: "memory");
        } else {
            XB_SPIN(xb_ld(&bar[XB_XGEN(b.x)]) == gen, bar);
            __builtin_amdgcn_fence(__ATOMIC_ACQUIRE, "agent");
            asm volatile("s_waitcnt vmcnt(0)" ::: "memory");
        }
    }
    __syncthreads();
}

constexpr int N_PHASES = 18;

__global__ void __launch_bounds__(512, 2) mega(Params P, int ph0, int ph1) {
    extern __shared__ __attribute__((aligned(16))) unsigned char shm[];
    __shared__ uint4 xb_words;
    if (threadIdx.x == 0) xb_words = make_uint4(0u, 0u, 0u, 0u);
    __syncthreads();
    const XcdBarrier xb = xcd_barrier_post((unsigned*)(P.ws + O_BAR), (volatile LAS unsigned*)&xb_words);
    const KPtr kp = (KPtr)__builtin_amdgcn_kernarg_segment_ptr();
#define RUN_PH(k) if (ph0 <= (k) && (k) < ph1) { if ((k) != ph0) xcd_barrier(xb); run_phase<(k)>(kp, shm); }
    RUN_PH(0) RUN_PH(1) RUN_PH(2) RUN_PH(3) RUN_PH(4) RUN_PH(5) RUN_PH(6) RUN_PH(7) RUN_PH(8) RUN_PH(9)
    RUN_PH(10) RUN_PH(11) RUN_PH(12) RUN_PH(13) RUN_PH(14) RUN_PH(15) RUN_PH(16) RUN_PH(17)
#undef RUN_PH
}

extern "C" void kernel_launch(void* const* d_in, const int* in_sizes, int n_in, void* d_out, int out_size, void* d_ws, size_t ws_size, hipStream_t stream) {
    static int grid_blocks = 0;
    if (!grid_blocks) {
        int dev = 0, cus = 0, per_cu = 0;
        hipGetDevice(&dev); hipDeviceGetAttribute(&cus, hipDeviceAttributeMultiprocessorCount, dev);
        hipFuncSetAttribute((const void*)mega, hipFuncAttributeMaxDynamicSharedMemorySize, STAGE_BYTES);
        hipOccupancyMaxActiveBlocksPerMultiprocessor(&per_cu, (const void*)mega, 512, STAGE_BYTES);
        if (per_cu < 1) { fprintf(stderr, "occupancy query says %d blocks/CU\n", per_cu); per_cu = 1; }
        grid_blocks = cus;
        if (ws_size < WS_END) { fprintf(stderr, "workspace too small: %zu < %zu\n", ws_size, (size_t)WS_END); grid_blocks = -1; }
    }
    if (grid_blocks < 0) return;
    if (hipMemsetAsync((char*)d_ws + O_BAR, 0, SZ_BAR, stream) != hipSuccess) { fprintf(stderr, "memset of barrier words failed\n"); return; }
    Params p{};
    const float** pp = (const float**)&p;
    for (int i = 0; i < 25; ++i) pp[i] = (const float*)d_in[i];
    p.out = (float*)d_out; p.ws = (unsigned char*)d_ws;
    int ph0 = 0, ph1 = N_PHASES;
    void* args[] = {&p, &ph0, &ph1};
    hipError_t e = hipLaunchCooperativeKernel((const void*)mega, dim3(grid_blocks), dim3(512), args, STAGE_BYTES, stream);
    if (e != hipSuccess) fprintf(stderr, "cooperative launch failed: %s (grid %d)\n", hipGetErrorString(e), grid_blocks);
}
```
